# Optimizing an MI355X kernel written in HIP

```python
import math
import jax
import jax.numpy as jnp
from jax import lax
import numpy as np

D_MODEL = 1024
BATCH = 8
SEQ = 4096
DEPTH = 2

CHUNK = 64
Q_BLOCK = 128
ROPE_THETA = 10000.0
NORM_EPS = 1e-6

MLA_HEADS = 8
MLA_Q_LORA = 256
MLA_KV_LORA = 256
MLA_NOPE = 64
MLA_ROPE = 32
MLA_V = 64
MLA_QK = MLA_NOPE + MLA_ROPE

DIFF_HEADS = 4
DIFF_HD = 64
DIFF_V = 2 * DIFF_HD
DIFF_QK_W = DIFF_HEADS * 2 * DIFF_HD

EV_IN = MLA_Q_LORA + MLA_KV_LORA + MLA_ROPE + 3 * DIFF_QK_W
EV_MIX = MLA_HEADS * MLA_V + DIFF_HEADS * DIFF_V

RWKV_HEADS = 8
RWKV_HD = 64
RWKV_W = RWKV_HEADS * RWKV_HD
RWKV_DECAY_LORA = 64
RWKV_A_LORA = 64
RWKV_GATE_LORA = 128
RWKV_IN = 3 * RWKV_W + RWKV_DECAY_LORA + RWKV_A_LORA + RWKV_GATE_LORA
RWKV_GN_EPS = 64e-5

HGRN_HEADS = 4
HGRN_DK = 128
HGRN_DV = 128
HGRN_IN = 2 * HGRN_HEADS * HGRN_DK + 2 * HGRN_HEADS * HGRN_DV

OD_IN = RWKV_IN + HGRN_IN
OD_MIX = RWKV_W + HGRN_HEADS * HGRN_DV

MOE_GROUPS = 4
MOE_EXPERTS_PER_GROUP = 8
MOE_EXPERTS = MOE_GROUPS * MOE_EXPERTS_PER_GROUP
MOE_TOP_K = 2
MOE_FF = 512
MOE_BLOCK = 128

F32 = jnp.float32

kernel_name = 'hybrid_mla_diff_rwkv7_hgrn2_hmoe'


def rmsnorm(x, g, eps=NORM_EPS):
    xf = x.astype(F32)
    y = xf * lax.rsqrt(jnp.mean(xf * xf, axis=-1, keepdims=True) + eps)
    return (y * g.astype(F32)).astype(x.dtype)


def rope(x, pos):
    d = x.shape[-1]
    half = d // 2
    inv = jnp.power(ROPE_THETA, -jnp.arange(half, dtype=F32) / half)
    ang = pos.astype(F32)[:, None] * inv[None, :]
    ang = ang.reshape((ang.shape[0],) + (1,) * (x.ndim - 3) + (half,))
    cos, sin = jnp.cos(ang), jnp.sin(ang)
    xf = x.astype(F32)
    x1, x2 = xf[..., :half], xf[..., half:]
    return jnp.concatenate([x1 * cos - x2 * sin, x2 * cos + x1 * sin], axis=-1).astype(x.dtype)


def chunk_causal_attention(q, k, v):
    B, H, S, DK = q.shape
    DV = v.shape[-1]
    nb = S // Q_BLOCK
    scale = DK ** -0.5
    qb = q.reshape(B, H, nb, Q_BLOCK, DK).transpose(2, 0, 1, 3, 4)
    key_chunk = jnp.arange(S) // CHUNK

    def block(args):
        qi, bi = args
        s = jnp.einsum('bhqd,bhkd->bhqk', qi, k).astype(F32) * scale
        q_chunk = (bi * Q_BLOCK + jnp.arange(Q_BLOCK)) // CHUNK
        s = jnp.where(key_chunk[None, :] <= q_chunk[:, None], s, -jnp.inf)
        p = jax.nn.softmax(s, axis=-1).astype(v.dtype)
        return jnp.einsum('bhqk,bhkd->bhqd', p, v)

    out = lax.map(block, (qb, jnp.arange(nb)))
    return out.transpose(1, 2, 0, 3, 4).reshape(B, H, S, DV)


def _bhsd(a):
    return a.transpose(0, 2, 1, 3)


def mla_diff_mixer(u, layer_idx, q_norm, w_q_up, kv_norm, w_kv_up, lam, subln):
    B, S, _ = u.shape
    pos = jnp.arange(S)
    s1 = MLA_Q_LORA
    s2 = s1 + MLA_KV_LORA
    s3 = s2 + MLA_ROPE
    s4 = s3 + DIFF_QK_W
    s5 = s4 + DIFF_QK_W
    c_q, c_kv, k_r, dq, dk, dv = jnp.split(u, [s1, s2, s3, s4, s5], axis=-1)

    q = (rmsnorm(c_q, q_norm) @ w_q_up).reshape(B, S, MLA_HEADS, MLA_QK)
    q = jnp.concatenate([q[..., :MLA_NOPE], rope(q[..., MLA_NOPE:], pos)], axis=-1)
    kv = (rmsnorm(c_kv, kv_norm) @ w_kv_up).reshape(B, S, MLA_HEADS, MLA_NOPE + MLA_V)
    k_rope = jnp.broadcast_to(rope(k_r, pos)[:, :, None, :], (B, S, MLA_HEADS, MLA_ROPE))
    k = jnp.concatenate([kv[..., :MLA_NOPE], k_rope], axis=-1)
    v = kv[..., MLA_NOPE:]
    o_mla = _bhsd(chunk_causal_attention(_bhsd(q), _bhsd(k), _bhsd(v)))
    o_mla = o_mla.reshape(B, S, MLA_HEADS * MLA_V)

    dq = rope(dq.reshape(B, S, DIFF_HEADS, 2, DIFF_HD), pos)
    dk = rope(dk.reshape(B, S, DIFF_HEADS, 2, DIFF_HD), pos)
    dv = _bhsd(dv.reshape(B, S, DIFF_HEADS, DIFF_V))
    a1 = chunk_causal_attention(_bhsd(dq[..., 0, :]), _bhsd(dk[..., 0, :]), dv)
    a2 = chunk_causal_attention(_bhsd(dq[..., 1, :]), _bhsd(dk[..., 1, :]), dv)
    lam = lam.astype(F32)
    lam_init = 0.8 - 0.6 * math.exp(-0.3 * layer_idx)
    lam_full = jnp.exp(jnp.sum(lam[0] * lam[1])) - jnp.exp(jnp.sum(lam[2] * lam[3])) + lam_init
    o = a1.astype(F32) - lam_full * a2.astype(F32)
    o = rmsnorm(_bhsd(o), subln) * (1.0 - lam_init)
    o_diff = o.reshape(B, S, DIFF_HEADS * DIFF_V).astype(u.dtype)
    return jnp.concatenate([o_mla, o_diff.astype(o_mla.dtype)], axis=-1)


def token_shift(u, mu):
    u_prev = jnp.pad(u, ((0, 0), (1, 0), (0, 0)))[:, :-1]
    return u + (u_prev - u) * mu


def rwkv7_recurrence(r, w, k, v, a, b):
    B, S, H, N = r.shape

    def step(state, inp):
        r_t, w_t, k_t, v_t, a_t, b_t = inp
        sa = jnp.einsum('bhvk,bhk->bhv', state, a_t)
        state = (state * w_t[:, :, None, :] + sa[..., None] * b_t[:, :, None, :]
                 + v_t[..., None] * k_t[:, :, None, :])
        y = jnp.einsum('bhvk,bhk->bhv', state, r_t)
        return state, y

    xs = tuple(t.astype(F32).transpose(1, 0, 2, 3) for t in (r, w, k, v, a, b))
    _, ys = lax.scan(step, jnp.zeros((B, H, N, N), F32), xs)
    return ys.transpose(1, 0, 2, 3)


def rwkv7_mixer(u, mu, w0, w2, a0, a2, g2, k_k, k_a, r_k, ln_w, ln_b):
    B, S, _ = u.shape
    u = token_shift(u, mu)
    p1 = RWKV_W
    p2 = 2 * RWKV_W
    p3 = 3 * RWKV_W
    p4 = p3 + RWKV_DECAY_LORA
    p5 = p4 + RWKV_A_LORA
    r, k, v, xw, xa, xg = jnp.split(u, [p1, p2, p3, p4, p5], axis=-1)
    w_raw = -jax.nn.softplus(-(w0 + jnp.tanh(xw) @ w2)) - 0.5
    decay = jnp.exp(-jnp.exp(w_raw.astype(F32)))
    a = jax.nn.sigmoid((a0 + xa @ a2).astype(F32))
    g = jax.nn.sigmoid(xg) @ g2

    def heads(t):
        return t.reshape(B, S, RWKV_HEADS, RWKV_HD)

    kk = heads((k * k_k).astype(F32))
    kk = kk * lax.rsqrt(jnp.maximum(jnp.sum(kk * kk, axis=-1, keepdims=True), 1e-24))
    k = k.astype(F32) * (1.0 + (a - 1.0) * k_a.astype(F32))
    r4, k4, v4, a4 = heads(r.astype(F32)), heads(k), heads(v.astype(F32)), heads(a)
    y = rwkv7_recurrence(r4, heads(decay), k4, v4, -kk, kk * a4)
    mean = jnp.mean(y, axis=-1, keepdims=True)
    var = jnp.mean(jnp.square(y - mean), axis=-1, keepdims=True)
    y = ((y - mean) * lax.rsqrt(var + RWKV_GN_EPS)).reshape(B, S, RWKV_W)
    y = y * ln_w.astype(F32) + ln_b.astype(F32)
    bonus = jnp.sum(r4 * k4 * r_k.astype(F32), axis=-1, keepdims=True) * v4
    y = y + bonus.reshape(B, S, RWKV_W)
    return (y * g.astype(F32)).astype(u.dtype)


def hgrn2_chunkwise(q, k, v, log_f):
    B, S, H, DK = q.shape
    DV = v.shape[-1]
    nc = S // CHUNK

    def chunks(t):
        return t.astype(F32).reshape(B, nc, CHUNK, H, t.shape[-1]).transpose(1, 0, 3, 2, 4)

    causal = jnp.tril(jnp.ones((CHUNK, CHUNK), dtype=bool))[:, :, None]

    def step(state, inp):
        qc, kc, vc, gc = inp
        b = jnp.cumsum(gc, axis=2)
        o_inter = jnp.einsum('bhtd,bhde->bhte', qc * jnp.exp(b), state)
        rel = jnp.where(causal, b[:, :, :, None, :] - b[:, :, None, :, :], -jnp.inf)
        scores = jnp.einsum('bhtd,bhtsd,bhsd->bhts', qc, jnp.exp(rel), kc)
        o_intra = jnp.einsum('bhts,bhse->bhte', scores, vc)
        b_last = b[:, :, -1:, :]
        state = (jnp.exp(b_last[:, :, 0, :])[..., None] * state
                 + jnp.einsum('bhsd,bhse->bhde', kc * jnp.exp(b_last - b), vc))
        return state, o_inter + o_intra

    init = jnp.zeros((B, H, DK, DV), F32)
    _, o = lax.scan(step, init, (chunks(q), chunks(k), chunks(v), chunks(log_f)))
    return o.transpose(1, 0, 3, 2, 4).reshape(B, S, H, DV)


def hgrn2_mixer(u, lower_bound, o_norm):
    B, S, _ = u.shape
    c1 = HGRN_HEADS * HGRN_DK
    c2 = 2 * c1
    c3 = c2 + HGRN_HEADS * HGRN_DV
    q, f, i, g = jnp.split(u, [c1, c2, c3], axis=-1)
    q = jax.nn.silu(q)
    z = f.astype(F32)
    lb = lower_bound.astype(F32)
    log_f = jnp.logaddexp(jnp.log(lb), jnp.log1p(-lb) + jax.nn.log_sigmoid(z))
    key_in = (1.0 - lb) * jax.nn.sigmoid(-z)

    def heads(t, d):
        return t.reshape(B, S, HGRN_HEADS, d)

    o = hgrn2_chunkwise(heads(q, HGRN_DK), heads(key_in, HGRN_DK),
                        heads(i, HGRN_DV), heads(log_f, HGRN_DK))
    o = rmsnorm(o, o_norm.reshape(HGRN_HEADS, HGRN_DV)).reshape(B, S, HGRN_HEADS * HGRN_DV)
    return (o * jax.nn.silu(g.astype(F32))).astype(u.dtype)


def hier_moe(h, w_group, b_group, w_expert, b_expert, w_gate, w_up, w_down):
    B, S, D = h.shape
    zg = (h @ w_group + b_group).astype(F32)
    pg = jax.nn.softmax(zg, axis=-1)
    g_idx = jnp.argmax(zg, axis=-1)
    pg_top = jnp.take_along_axis(pg, g_idx[..., None], axis=-1)
    ze = (h @ w_expert + b_expert).astype(F32).reshape(B, S, MOE_GROUPS, MOE_EXPERTS_PER_GROUP)
    ze = jnp.take_along_axis(ze, g_idx[..., None, None], axis=2)[..., 0, :]
    pe = jax.nn.softmax(ze, axis=-1)
    top_v, top_i = lax.top_k(pe, MOE_TOP_K)
    top_v = top_v / jnp.sum(top_v, axis=-1, keepdims=True)
    within = jnp.sum(jax.nn.one_hot(top_i, MOE_EXPERTS_PER_GROUP, dtype=F32) * top_v[..., None], axis=-2)
    gate = jax.nn.one_hot(g_idx, MOE_GROUPS, dtype=F32)[..., :, None] * (pg_top * within)[..., None, :]
    gate = gate.reshape(B, S, MOE_EXPERTS).astype(h.dtype)
    nb = S // MOE_BLOCK
    hb = h.reshape(B, nb, MOE_BLOCK, D).transpose(1, 0, 2, 3)
    gb = gate.reshape(B, nb, MOE_BLOCK, MOE_EXPERTS).transpose(1, 0, 2, 3)

    def block(args):
        hx, gx = args
        a = jnp.einsum('bmd,edf->bmef', hx, w_gate)
        up = jnp.einsum('bmd,edf->bmef', hx, w_up)
        act = jax.nn.silu(a) * up * gx[..., None]
        return jnp.einsum('bmef,efd->bmd', act, w_down)

    y = lax.map(block, (hb, gb))
    return y.transpose(1, 0, 2, 3).reshape(B, S, D)


def setup_inputs(seed: int = 0) -> dict:
    key = jax.random.key(seed)
    keys = jax.random.split(key, 48)
    ctr = [0]

    def nxt():
        kk = keys[ctr[0]]
        ctr[0] += 1
        return kk

    def nrm(shape, scale):
        return jax.random.normal(nxt(), shape, F32) * scale

    def gain(shape):
        return 1.0 + nrm(shape, 0.02)

    n_even = (DEPTH + 1) // 2
    n_odd = DEPTH // 2
    D = D_MODEL
    return {
        'x': nrm((BATCH, SEQ, D), 1.0),
        'norm_mix': gain((DEPTH, D)),
        'norm_ffn': gain((DEPTH, D)),
        'norm_final': gain((D,)),
        'ev_w_in': nrm((n_even, D, EV_IN), D ** -0.5),
        'ev_w_out': nrm((n_even, EV_MIX, D), EV_MIX ** -0.5),
        'mla_q_norm': gain((n_even, MLA_Q_LORA)),
        'mla_w_q_up': nrm((n_even, MLA_Q_LORA, MLA_HEADS * MLA_QK), MLA_Q_LORA ** -0.5),
        'mla_kv_norm': gain((n_even, MLA_KV_LORA)),
        'mla_w_kv_up': nrm((n_even, MLA_KV_LORA, MLA_HEADS * (MLA_NOPE + MLA_V)), MLA_KV_LORA ** -0.5),
        'diff_lambda': nrm((n_even, 4, DIFF_HD), 0.1),
        'diff_subln': gain((n_even, DIFF_V)),
        'od_w_in': nrm((n_odd, D, OD_IN), D ** -0.5),
        'od_w_out': nrm((n_odd, OD_MIX, D), OD_MIX ** -0.5),
        'rwkv_mu': jax.random.uniform(nxt(), (n_odd, RWKV_IN), F32),
        'rwkv_w0': nrm((n_odd, RWKV_W), 0.5),
        'rwkv_w2': nrm((n_odd, RWKV_DECAY_LORA, RWKV_W), 0.5 * RWKV_DECAY_LORA ** -0.5),
        'rwkv_a0': nrm((n_odd, RWKV_W), 0.1),
        'rwkv_a2': nrm((n_odd, RWKV_A_LORA, RWKV_W), 0.5 * RWKV_A_LORA ** -0.5),
        'rwkv_g2': nrm((n_odd, RWKV_GATE_LORA, RWKV_W), RWKV_GATE_LORA ** -0.5),
        'rwkv_k_k': 0.85 + nrm((n_odd, RWKV_W), 0.02),
        'rwkv_k_a': 1.0 + nrm((n_odd, RWKV_W), 0.02),
        'rwkv_r_k': nrm((n_odd, RWKV_HEADS, RWKV_HD), 0.1),
        'rwkv_ln_w': gain((n_odd, RWKV_W)),
        'rwkv_ln_b': nrm((n_odd, RWKV_W), 0.02),
        'hgrn_lb': 1.0 + nrm((DEPTH, HGRN_HEADS * HGRN_DK), 0.1),
        'hgrn_o_norm': gain((n_odd, HGRN_HEADS * HGRN_DV)),
        'moe_w_group': nrm((DEPTH, D, MOE_GROUPS), D ** -0.5),
        'moe_b_group': nrm((DEPTH, MOE_GROUPS), 0.01),
        'moe_w_expert': nrm((DEPTH, D, MOE_EXPERTS), D ** -0.5),
        'moe_b_expert': nrm((DEPTH, MOE_EXPERTS), 0.01),
        'moe_w_gate': nrm((DEPTH, MOE_EXPERTS, D, MOE_FF), D ** -0.5),
        'moe_w_up': nrm((DEPTH, MOE_EXPERTS, D, MOE_FF), D ** -0.5),
        'moe_w_down': nrm((DEPTH, MOE_EXPERTS, MOE_FF, D), MOE_FF ** -0.5),
    }


def reference(x, norm_mix, norm_ffn, norm_final, ev_w_in, ev_w_out, mla_q_norm, mla_w_q_up,
              mla_kv_norm, mla_w_kv_up, diff_lambda, diff_subln, od_w_in, od_w_out, rwkv_mu,
              rwkv_w0, rwkv_w2, rwkv_a0, rwkv_a2, rwkv_g2, rwkv_k_k, rwkv_k_a, rwkv_r_k,
              rwkv_ln_w, rwkv_ln_b, hgrn_lb, hgrn_o_norm, moe_w_group, moe_b_group,
              moe_w_expert, moe_b_expert, moe_w_gate, moe_w_up, moe_w_down):
    lb_p = jax.nn.softmax(hgrn_lb.astype(F32), axis=0)
    lower_bounds = jnp.cumsum(lb_p, axis=0) - lb_p[0]
    h = x
    for l in range(DEPTH):
        i = l // 2
        hn = rmsnorm(h, norm_mix[l])
        if l % 2 == 0:
            u = hn @ ev_w_in[i]
            mixed = mla_diff_mixer(u, l, mla_q_norm[i], mla_w_q_up[i], mla_kv_norm[i],
                                   mla_w_kv_up[i], diff_lambda[i], diff_subln[i])
            h = h + (mixed.astype(h.dtype) @ ev_w_out[i]).astype(h.dtype)
        else:
            u = hn @ od_w_in[i]
            o_c = rwkv7_mixer(u[..., :RWKV_IN], rwkv_mu[i], rwkv_w0[i], rwkv_w2[i], rwkv_a0[i],
                              rwkv_a2[i], rwkv_g2[i], rwkv_k_k[i], rwkv_k_a[i], rwkv_r_k[i],
                              rwkv_ln_w[i], rwkv_ln_b[i])
            o_d = hgrn2_mixer(u[..., RWKV_IN:], lower_bounds[l], hgrn_o_norm[i])
            mixed = jnp.concatenate([o_c, o_d], axis=-1).astype(h.dtype)
            h = h + (mixed @ od_w_out[i]).astype(h.dtype)
        hf = rmsnorm(h, norm_ffn[l])
        h = h + hier_moe(hf, moe_w_group[l], moe_b_group[l], moe_w_expert[l], moe_b_expert[l],
                         moe_w_gate[l], moe_w_up[l], moe_w_down[l]).astype(h.dtype)
    return rmsnorm(h, norm_final)
```

```cpp
#include <hip/hip_runtime.h>
#include <stdint.h>
#include <stdio.h>
#include <string.h>
#include <utility>

#ifndef MEGA
#define MEGA 1
#endif

typedef unsigned short u16;
typedef short bf16x8 __attribute__((ext_vector_type(8)));
typedef short s16x4 __attribute__((ext_vector_type(4)));
typedef float f32x16 __attribute__((ext_vector_type(16)));
typedef float f32x4 __attribute__((ext_vector_type(4)));
typedef float f32x2 __attribute__((ext_vector_type(2)));
typedef unsigned u32x4 __attribute__((ext_vector_type(4)));
typedef unsigned u32x2 __attribute__((ext_vector_type(2)));
typedef _Float16 h16;

constexpr int NB = 8, SEQ = 4096, T = NB * SEQ, D = 1024;
constexpr int EV_IN = 2080, EV_INP = 2176;
constexpr int OD_IN = 3840, RW_IN = 1792;
constexpr float EPS = 1e-6f;
constexpr float LOG2E = 1.4426950408889634f;
constexpr float QSCALE_M = 0.10206207261596577f * LOG2E;
constexpr float QSCALE_D = 0.125f * LOG2E;

constexpr size_t CTRL_BYTES = 65536;
constexpr int    ROWSC_LDS = 40960;
constexpr int    RWKV_TICKET_W = 4608;
constexpr int    CONV1_CTR_W = 4672;
constexpr int    CONV0_CTR_W = 4736;
constexpr int    HGA_CTR_W = 4800, HGB_CTR_W = 4864, HGC_CTR_W = 4928;
constexpr int    PERCU_W = 8192;
constexpr int    ATTN_CTR_W = 4096;
constexpr int    CNT_W      = 4352;
constexpr int    AMAX_W     = 4992;
constexpr float  F8_TOP     = 224.f;
constexpr float  V_F8_SCALE = 16.f;
constexpr float  ACT_F8_SCALE = 16.f;
constexpr float  WQ_TOP     = 127.f;
constexpr size_t O_WIN0  = CTRL_BYTES;
constexpr size_t O_WQ    = O_WIN0  + (size_t)EV_INP * 1024 * 2;
constexpr size_t O_WKV   = O_WQ    + (size_t)768 * 256 * 2;
constexpr size_t O_WOUT0 = O_WKV   + (size_t)1024 * 256 * 2;
constexpr size_t O_WIN1  = O_WOUT0 + (size_t)1024 * 1024 * 2;
constexpr size_t O_WOUT1 = O_WIN1  + (size_t)OD_IN * 1024 * 2;
constexpr size_t O_W2T   = O_WOUT1 + (size_t)1024 * 1024 * 2;
constexpr size_t O_A2T   = O_W2T   + (size_t)512 * 64 * 2;
constexpr size_t O_G2T   = O_A2T   + (size_t)512 * 64 * 2;
constexpr size_t O_WR    = O_G2T   + (size_t)512 * 128 * 2;
constexpr size_t O_ROPED = O_WR    + (size_t)2 * 128 * 1024 * 2;
constexpr size_t O_ROPEM = O_ROPED + (size_t)4096 * 32 * 8;
constexpr size_t O_MOEW  = O_ROPEM + (size_t)4096 * 16 * 8;
constexpr size_t O_WGU   = O_MOEW;
constexpr size_t O_WD    = O_WGU + (size_t)32 * 1024 * 1024 * 2;
constexpr size_t MOEW_BYTES = (size_t)32 * 1024 * 1024 * 2 + (size_t)32 * 1024 * 512 * 2;
constexpr size_t O_A12   = O_MOEW;
constexpr size_t O_HL    = O_MOEW;
constexpr size_t O_ACT   = O_MOEW + MOEW_BYTES;
constexpr size_t O_HA    = O_ACT;
constexpr size_t O_CLAT  = O_ACT + (size_t)T * 1024 * 2;
constexpr size_t O_QM    = O_CLAT + (size_t)T * 512 * 2;
constexpr size_t O_KM    = O_QM + (size_t)T * 8 * 96 * 2;
constexpr size_t O_VTM   = O_KM + (size_t)T * 8 * 96 * 2;
constexpr size_t O_QD    = O_VTM + (size_t)T * 512 * 2;
constexpr size_t O_KD    = O_QD + (size_t)T * 512 * 2;
constexpr size_t O_VTD   = O_KD + (size_t)T * 512 * 2;
constexpr size_t ACT_L0_END = O_VTD + (size_t)T * 512 * 2;
constexpr size_t O_YRAW  = ACT_L0_END;
constexpr size_t O_ACTB  = O_ACT + (size_t)T * 1024 * 2;
constexpr size_t O_YSORT = O_ACTB + (size_t)2 * T * 512 * 2;
constexpr size_t O_SEL   = O_YSORT + (size_t)2 * T * 1024 * 2;
constexpr size_t O_GATES = O_SEL + (size_t)T * 16;
constexpr size_t O_TOKROW= O_GATES + (size_t)T * 8;
constexpr size_t O_GATEROW = O_TOKROW + (size_t)2 * T * 4;
constexpr size_t O_ROWTOK= O_GATEROW + (size_t)2 * T * 4;
constexpr size_t O_A8    = O_ACT + (size_t)260 * 1024 * 1024;
constexpr size_t O_SA8   = O_A8 + (size_t)T * 1024;
constexpr size_t O_GSROW = O_SA8 + (size_t)T * 4;
constexpr size_t O_TOK2  = O_GSROW + (size_t)2 * T * 8;
constexpr size_t O_GS2   = O_TOK2 + (size_t)32 * T * 4;
constexpr size_t O_U1R   = O_ACT + (size_t)T * 1024 * 2;
constexpr size_t O_U1H   = O_U1R + (size_t)T * RW_IN * 2;
constexpr size_t O_WD16  = O_MOEW + (size_t)2048 * 128 * 128 * 2;
constexpr size_t O_ATTSCR = ACT_L0_END + (size_t)T * 512 * 2;
constexpr size_t O_LORA  = O_U1H + (size_t)T * 2048 * 2;
constexpr size_t O_AA16  = O_ATTSCR;
constexpr size_t O_GG16  = O_AA16 + (size_t)T * 512 * 2;
constexpr size_t O_HD    = O_GG16 + (size_t)T * 512 * 2;
constexpr size_t O_SAIN  = O_HD + (size_t)2048 * 128 * 4;
constexpr size_t WS_TOTAL = O_SAIN + (size_t)T * 4;


struct Params { const float* in[34]; float* out; unsigned char* ws; int solo; int pad; };

#define WSP(type, off) ((type*)(p.ws + (off)))
#define HB(t) ((u16*)p.out + (size_t)(t) * 2048)

__device__ __forceinline__ int otid() { int z; asm volatile("v_mov_b32 %0, 0" : "=v"(z)); return (int)threadIdx.x + z; }
typedef __bf16 v2bf __attribute__((ext_vector_type(2)));
__device__ __forceinline__ unsigned cvtpk(float lo, float hi) { v2bf v = {(__bf16)lo, (__bf16)hi}; return __builtin_bit_cast(unsigned, v); }
__device__ __forceinline__ u16 f2bf(float x) { return __builtin_bit_cast(u16, (__bf16)x); }
__device__ __forceinline__ float bf2f(u16 b) { return __uint_as_float(((unsigned)b) << 16); }
__device__ __forceinline__ float bflo(unsigned w) { return __uint_as_float(w << 16); }
__device__ __forceinline__ float bfhi(unsigned w) { return __uint_as_float(w & 0xffff0000u); }
__device__ __forceinline__ f32x4 bf4_to_f32(const u32x2 w) { return (f32x4){bflo(w[0]), bfhi(w[0]), bflo(w[1]), bfhi(w[1])}; }
__device__ __forceinline__ int crow(int r, int hi) { return (r & 3) + 8 * (r >> 2) + 4 * hi; }
__device__ __forceinline__ float wave_sum(float v) {
#pragma unroll
    for (int o = 32; o; o >>= 1) v += __shfl_xor(v, o);
    return v;
}
__device__ __forceinline__ float wave_max(float v) {
#pragma unroll
    for (int o = 32; o; o >>= 1) v = fmaxf(v, __shfl_xor(v, o));
    return v;
}
__device__ __forceinline__ float sigmoidf_(float x) { return __builtin_amdgcn_rcpf(1.f + __expf(-x)); }
__device__ __forceinline__ float siluf_(float x) { return x * __builtin_amdgcn_rcpf(1.f + __expf(-x)); }
__device__ __forceinline__ float xhalf_sum(float x) { auto rr = __builtin_amdgcn_permlane32_swap(__float_as_uint(x), __float_as_uint(x), false, false); return __uint_as_float(rr[0]) + __uint_as_float(rr[1]); }
__device__ __forceinline__ float xhalf_max(float x) { auto rr = __builtin_amdgcn_permlane32_swap(__float_as_uint(x), __float_as_uint(x), false, false); return fmaxf(__uint_as_float(rr[0]), __uint_as_float(rr[1])); }
#define MFMA(a, b, c) __builtin_amdgcn_mfma_f32_32x32x16_bf16((a), (b), (c), 0, 0, 0)
typedef int i32x4v __attribute__((ext_vector_type(4)));
typedef int i32x16v __attribute__((ext_vector_type(16)));
typedef int i32x8v __attribute__((ext_vector_type(8)));
__device__ __forceinline__ float f8clamp(float v) { return fminf(fmaxf(v, -448.f), 448.f); }
__device__ __forceinline__ f32x16 mma_f8(const u32x4 alo, const u32x4 ahi, const u32x4 blo, const u32x4 bhi, const f32x16 c) {
    const i32x8v a = __builtin_shufflevector(__builtin_bit_cast(i32x4v, alo), __builtin_bit_cast(i32x4v, ahi), 0, 1, 2, 3, 4, 5, 6, 7);
    const i32x8v b = __builtin_shufflevector(__builtin_bit_cast(i32x4v, blo), __builtin_bit_cast(i32x4v, bhi), 0, 1, 2, 3, 4, 5, 6, 7);
    return __builtin_amdgcn_mfma_scale_f32_32x32x64_f8f6f4(a, b, c, 0, 0, 0, 0, 0, 0);
}
template <int MODE>
__device__ __forceinline__ f32x16 mma(const bf16x8 a, const bf16x8 b, const f32x16 c) {
    if constexpr (MODE == 0) return MFMA(a, b, c);
    else return __builtin_bit_cast(f32x16, __builtin_amdgcn_mfma_i32_32x32x32_i8(__builtin_bit_cast(i32x4v, a), __builtin_bit_cast(i32x4v, b), __builtin_bit_cast(i32x16v, c), 0, 0, 0));
}

#define XB_TMO      128
#define XB_XCNT(j)  (256  + 64 * (j))
#define XB_XSUB(j)  (1280 + 64 * (j))
#define XB_XGEN(j)  (2304 + 64 * (j))
#define XB_TOP      3328
#define XB_TOPGEN   3392
#define XCD_BAR_WORDS 3456
#define XB_SPIN_CAP (1u << 18)
#define LAS __attribute__((address_space(3)))

__device__ __forceinline__ unsigned xb_ld(unsigned* p)              { return __hip_atomic_load(p, __ATOMIC_RELAXED, __HIP_MEMORY_SCOPE_AGENT); }
__device__ __forceinline__ unsigned xb_add(unsigned* p, unsigned v) { return __hip_atomic_fetch_add(p, v, __ATOMIC_RELAXED, __HIP_MEMORY_SCOPE_AGENT); }
__device__ __forceinline__ unsigned xb_xcc_id() { return (unsigned)__builtin_amdgcn_s_getreg((3 << 11) | 20) & 0xFu; }
#define XB_SPIN(cond, bar) do { unsigned _sp = 0; while (cond) { __builtin_amdgcn_s_sleep(1); \
    if ((++_sp & 255u) == 0u) { if (xb_ld(&(bar)[XB_TMO])) break; if (_sp > XB_SPIN_CAP) { atomicAdd(&(bar)[XB_TMO], 1u); break; } } } } while (0)

struct XcdBarrier {
    unsigned* bar; unsigned x;
    volatile LAS unsigned* st;
};

__device__ __forceinline__ XcdBarrier xcd_barrier_post(unsigned* bar, volatile LAS unsigned* st) {
    XcdBarrier b; b.bar = bar; b.x = xb_xcc_id(); b.st = st;
    if (threadIdx.x == 0) (void)xb_add(&bar[XB_XCNT(b.x)], 1u);
    return b;
}
__device__ __forceinline__ void xcd_barrier_complete(unsigned* bar, unsigned x, unsigned& nloc, unsigned& nx) {
    const unsigned G = gridDim.x * gridDim.y * gridDim.z;
    unsigned sum, cnt, mine, sp = 0u;
    for (;;) {
        sum = 0u; cnt = 0u; mine = 0u;
#pragma unroll
        for (unsigned j = 0; j < 16; ++j) { const unsigned c = xb_ld(&bar[XB_XCNT(j)]); sum += c; cnt += (c > 0u) ? 1u : 0u; mine = (j == x) ? c : mine; }
        if (sum == G) break;
        __builtin_amdgcn_s_sleep(1);
        if ((++sp & 255u) == 0u) { if (xb_ld(&bar[XB_TMO])) break; if (sp > XB_SPIN_CAP) { atomicAdd(&bar[XB_TMO], 1u); break; } }
    }
    nloc = mine > 0u ? mine : 1u; nx = cnt > 0u ? cnt : 1u;
}

__device__ __forceinline__ void xcd_barrier(const XcdBarrier& b) {
    asm volatile("s_waitcnt vmcnt(0)" ::: "memory");
    __syncthreads();
    if (threadIdx.x == 0) {
        unsigned* bar = b.bar;
        __builtin_amdgcn_s_waitcnt(0);
        unsigned nloc = b.st[0], nx = b.st[1];
        if (nloc == 0u) { xcd_barrier_complete(bar, b.x, nloc, nx); b.st[0] = nloc; b.st[1] = nx; }
        const unsigned old = xb_add(&bar[XB_XSUB(b.x)], 1u);
        const unsigned gen = old / nloc;
        if (old + 1u == (gen + 1u) * nloc) {
            __builtin_amdgcn_fence(__ATOMIC_RELEASE, "agent");
            asm volatile("s_waitcnt vmcnt(0)" ::: "memory");
            const unsigned og = xb_add(&bar[XB_TOP], 1u);
            const unsigned tg = og / nx;
            if (og + 1u == (tg + 1u) * nx) xb_add(&bar[XB_TOPGEN], 1u);
            else XB_SPIN(xb_ld(&bar[XB_TOPGEN]) == tg, bar);
            __builtin_amdgcn_fence(__ATOMIC_ACQUIRE, "agent");
            xb_add(&bar[XB_XGEN(b.x)], 1u);
            asm volatile("s_waitcnt vmcnt(0)" ::: "memory");
        } else {
            XB_SPIN(xb_ld(&bar[XB_XGEN(b.x)]) == gen, bar);
            __builtin_amdgcn_fence(__ATOMIC_ACQUIRE, "agent");
            asm volatile("s_waitcnt vmcnt(0)" ::: "memory");
        }
    }
    __syncthreads();
}


constexpr int SMEM_BYTES = 75776;
constexpr int LSTR = 72;
constexpr int TILE_E = 128 * LSTR;

struct GemmRegs { u32x4 ra0[4], rb0[4], ra1[4], rb1[4]; };
#define G_LOAD(RA, RB, KT) _Pragma("unroll") for (int i = 0; i < 4; ++i) { RA[i] = *(const u32x4*)(A + aoff[i] + (KT) * 64); RB[i] = *(const u32x4*)(B + boff[i] + (KT) * 64); }
__device__ __forceinline__ void gemm_prefetch(GemmRegs& g, const u16* __restrict__ A, const unsigned (&aoff)[4], const u16* __restrict__ B, const unsigned (&boff)[4], int nk) {
    G_LOAD(g.ra0, g.rb0, 0);
    if (nk > 1) { G_LOAD(g.ra1, g.rb1, 1); }
}
template <int MODE = 0>
__device__ __forceinline__ void gemm_run(f32x16 (&acc)[2][2], GemmRegs& g, const u16* __restrict__ A, const unsigned (&aoff)[4],
                                         const u16* __restrict__ B, const unsigned (&boff)[4], int nk, u16* smem) {
    const int tid = otid(), lane = tid & 63, wid = tid >> 6, wr = wid >> 1, wc = wid & 1, l31 = lane & 31, hi = lane >> 5;
    u16* As = smem; u16* Bs = smem + 2 * TILE_E;
    const int st_off = (tid >> 3) * LSTR + (tid & 7) * 8;
    const int a_rd = (wr * 64 + l31) * LSTR + hi * 8, b_rd = (wc * 64 + l31) * LSTR + hi * 8;
#pragma unroll
    for (int m = 0; m < 2; ++m)
#pragma unroll
        for (int n = 0; n < 2; ++n)
#pragma unroll
            for (int r = 0; r < 16; ++r) acc[m][n][r] = 0.f;
#define G_STORE(RA, RB, BUF) _Pragma("unroll") for (int i = 0; i < 4; ++i) { *(u32x4*)(As + (BUF) * TILE_E + st_off + i * 32 * LSTR) = RA[i]; *(u32x4*)(Bs + (BUF) * TILE_E + st_off + i * 32 * LSTR) = RB[i]; }
    const int a_rd8 = (wr * 64 + l31) * LSTR + hi * 16, b_rd8 = (wc * 64 + l31) * LSTR + hi * 16;
    (void)a_rd8; (void)b_rd8;
#define G_STEP(BUF, ST, RA, RB, SBUF, LD, LA, LB, LKT) { const u16* Ab = As + (BUF) * TILE_E; const u16* Bb = Bs + (BUF) * TILE_E; const bool st_ = (ST), ld_ = (LD); __builtin_amdgcn_s_setprio(1); \
        if constexpr (MODE == 2) { \
            u32x4 f[2][8]; \
            { const u16* pa = Ab + a_rd8; const u16* pb = Bb + b_rd8; \
              f[0][0] = *(const u32x4*)pa; f[0][1] = *(const u32x4*)(pa + 8); f[0][2] = *(const u32x4*)(pa + 32 * LSTR); f[0][3] = *(const u32x4*)(pa + 32 * LSTR + 8); \
              f[0][4] = *(const u32x4*)pb; f[0][5] = *(const u32x4*)(pb + 8); f[0][6] = *(const u32x4*)(pb + 32 * LSTR); f[0][7] = *(const u32x4*)(pb + 32 * LSTR + 8); } \
            _Pragma("unroll") for (int s = 0; s < 2; ++s) { \
                if (s == 0) { const u16* pa = Ab + a_rd8 + 32; const u16* pb = Bb + b_rd8 + 32; \
                  f[1][0] = *(const u32x4*)pa; f[1][1] = *(const u32x4*)(pa + 8); f[1][2] = *(const u32x4*)(pa + 32 * LSTR); f[1][3] = *(const u32x4*)(pa + 32 * LSTR + 8); \
                  f[1][4] = *(const u32x4*)pb; f[1][5] = *(const u32x4*)(pb + 8); f[1][6] = *(const u32x4*)(pb + 32 * LSTR); f[1][7] = *(const u32x4*)(pb + 32 * LSTR + 8); } \
                acc[0][0] = mma_f8(f[s][0], f[s][1], f[s][4], f[s][5], acc[0][0]); acc[0][1] = mma_f8(f[s][0], f[s][1], f[s][6], f[s][7], acc[0][1]); \
                acc[1][0] = mma_f8(f[s][2], f[s][3], f[s][4], f[s][5], acc[1][0]); acc[1][1] = mma_f8(f[s][2], f[s][3], f[s][6], f[s][7], acc[1][1]); \
                __builtin_amdgcn_s_setprio(0); \
                if (st_) { _Pragma("unroll") for (int i = 2 * s; i < 2 * s + 2; ++i) { *(u32x4*)(As + (SBUF) * TILE_E + st_off + i * 32 * LSTR) = RA[i]; *(u32x4*)(Bs + (SBUF) * TILE_E + st_off + i * 32 * LSTR) = RB[i]; } } \
                if (ld_) { _Pragma("unroll") for (int i = 2 * s; i < 2 * s + 2; ++i) { LA[i] = *(const u32x4*)(A + aoff[i] + (LKT) * 64); LB[i] = *(const u32x4*)(B + boff[i] + (LKT) * 64); } } \
                __builtin_amdgcn_sched_barrier(0); if (s + 1 < 2) __builtin_amdgcn_s_setprio(1); } \
        } else { \
            bf16x8 f[2][4]; \
            f[0][0] = *(const bf16x8*)(Ab + a_rd); f[0][1] = *(const bf16x8*)(Ab + a_rd + 32 * LSTR); f[0][2] = *(const bf16x8*)(Bb + b_rd); f[0][3] = *(const bf16x8*)(Bb + b_rd + 32 * LSTR); \
            _Pragma("unroll") for (int s = 0; s < 4; ++s) { \
                if (s + 1 < 4) { f[(s + 1) & 1][0] = *(const bf16x8*)(Ab + a_rd + (s + 1) * 16); f[(s + 1) & 1][1] = *(const bf16x8*)(Ab + a_rd + 32 * LSTR + (s + 1) * 16); \
                                 f[(s + 1) & 1][2] = *(const bf16x8*)(Bb + b_rd + (s + 1) * 16); f[(s + 1) & 1][3] = *(const bf16x8*)(Bb + b_rd + 32 * LSTR + (s + 1) * 16); } \
                acc[0][0] = mma<MODE>(f[s & 1][0], f[s & 1][2], acc[0][0]); acc[0][1] = mma<MODE>(f[s & 1][0], f[s & 1][3], acc[0][1]); \
                acc[1][0] = mma<MODE>(f[s & 1][1], f[s & 1][2], acc[1][0]); acc[1][1] = mma<MODE>(f[s & 1][1], f[s & 1][3], acc[1][1]); \
                __builtin_amdgcn_s_setprio(0); \
                if (st_) { *(u32x4*)(As + (SBUF) * TILE_E + st_off + s * 32 * LSTR) = RA[s]; *(u32x4*)(Bs + (SBUF) * TILE_E + st_off + s * 32 * LSTR) = RB[s]; } \
                if (ld_) { LA[s] = *(const u32x4*)(A + aoff[s] + (LKT) * 64); LB[s] = *(const u32x4*)(B + boff[s] + (LKT) * 64); } \
                __builtin_amdgcn_sched_barrier(0); if (s + 1 < 4) __builtin_amdgcn_s_setprio(1); } \
        } __builtin_amdgcn_s_setprio(0); }
    G_STORE(g.ra0, g.rb0, 0);
    __syncthreads();
    for (int kt = 0; kt < nk; kt += 2) {
        G_STEP(0, kt + 1 < nk, g.ra1, g.rb1, 1, kt + 2 < nk, g.ra0, g.rb0, kt + 2);
        __syncthreads();
        if (kt + 1 >= nk) break;
        G_STEP(1, kt + 2 < nk, g.ra0, g.rb0, 0, kt + 3 < nk, g.ra1, g.rb1, kt + 3);
        __syncthreads();
    }
#undef G_STORE
#undef G_STEP
}
__device__ __forceinline__ void gemm_mainloop(f32x16 (&acc)[2][2], const u16* __restrict__ A, const unsigned (&aoff)[4],
                                              const u16* __restrict__ B, const unsigned (&boff)[4], int nk, u16* smem) {
    GemmRegs g; gemm_prefetch(g, A, aoff, B, boff, nk); gemm_run(acc, g, A, aoff, B, boff, nk, smem);
}
__device__ __forceinline__ void lin_off(unsigned (&off)[4], int row0, int ld, int col0) {
    const int tid = otid();
#pragma unroll
    for (int i = 0; i < 4; ++i) off[i] = (unsigned)(row0 + (tid >> 3) + 32 * i) * (unsigned)ld + (unsigned)(col0 + (tid & 7) * 8);
}
__device__ __forceinline__ bool dense_tile(int it, int C, int& rt, int& ct) {
    const int xcd = blockIdx.x & 7, slot = blockIdx.x >> 3, nslot = gridDim.x >> 3;
    const int i = slot + it * nslot;
    if (i >= 32 * C) return false;
    const int rg = i / (8 * C), rem = i - rg * 8 * C;
    ct = rem >> 3; rt = xcd * 32 + rg * 8 + (rem & 7);
    return true;
}
__device__ __forceinline__ bool moe_tile(int it, int ntl, int& rtg, int& ct) {
    const int xcd = blockIdx.x & 7, slot = blockIdx.x >> 3, nslot = gridDim.x >> 3;
    const int lo = (xcd * ntl) >> 3, hi = ((xcd + 1) * ntl) >> 3;
    const int i = slot + it * nslot;
    if (i >= (hi - lo) * 8) return false;
    rtg = lo + (i >> 3); ct = i & 7;
    return true;
}
#define WAVE_IDS const int tid = otid(), lane = tid & 63, wid = tid >> 6, wr = wid >> 1, wc = wid & 1, l31 = lane & 31, hi = lane >> 5; (void)wr; (void)wc; (void)l31; (void)hi; (void)lane; (void)wid; (void)tid

template <bool I8 = false, bool F8 = false, class SrcFn>
__device__ __forceinline__ void cvt_unit(SrcFn srcfn, int ld_src, int K, int nnt, size_t dst_mat_stride, const float* kscale, u16* dst, float* sm, int tile, float qs = 1.f) {
    const int tid = otid();
    const int nkt = K / 64, nng = (nnt + 3) >> 2, per = nkt * nng;
    {
        const int mat = tile / per, rem = tile % per, ng = rem % nng, kt = rem / nng;
        const int k = tid >> 2, c8 = (tid & 3) * 8;
        float v[4][8];
#pragma unroll
        for (int u = 0; u < 4; ++u) {
            const int nt = ng * 4 + u;
#pragma unroll
            for (int j = 0; j < 8; ++j) v[u][j] = 0.f;
            if (nt < nnt) {
                int ncols = 32; const float* src = srcfn(mat, nt, ncols);
                if (src) {
                    const float* q = src + (size_t)(kt * 64 + k) * ld_src + c8;
                    const f32x4 v0 = *(const f32x4*)q, v1 = *(const f32x4*)(q + 4);
                    v[u][0] = v0[0]; v[u][1] = v0[1]; v[u][2] = v0[2]; v[u][3] = v0[3]; v[u][4] = v1[0]; v[u][5] = v1[1]; v[u][6] = v1[2]; v[u][7] = v1[3];
                }
            }
        }
        if (kscale) { const float sc = kscale[kt * 64 + k];
#pragma unroll
            for (int u = 0; u < 4; ++u)
#pragma unroll
                for (int j = 0; j < 8; ++j) v[u][j] *= sc; }
#pragma unroll
        for (int u = 0; u < 4; ++u)
#pragma unroll
            for (int j = 0; j < 8; ++j) sm[k * 129 + u * 32 + c8 + j] = v[u][j];
        __syncthreads();
        const int kc = tid & 7;
#pragma unroll
        for (int u = 0; u < 4; ++u) {
            const int nt = ng * 4 + u, n = tid >> 3;
            if (nt < nnt) {
                float w[8];
#pragma unroll
                for (int j = 0; j < 8; ++j) w[j] = sm[(kc * 8 + j) * 129 + u * 32 + n];
                if constexpr (F8) {
                    u32x2 o; o[0] = 0u; o[1] = 0u;
                    o[0] = (unsigned)__builtin_amdgcn_cvt_pk_fp8_f32(f8clamp(w[0] * qs), f8clamp(w[1] * qs), (int)o[0], false); o[0] = (unsigned)__builtin_amdgcn_cvt_pk_fp8_f32(f8clamp(w[2] * qs), f8clamp(w[3] * qs), (int)o[0], true);
                    o[1] = (unsigned)__builtin_amdgcn_cvt_pk_fp8_f32(f8clamp(w[4] * qs), f8clamp(w[5] * qs), (int)o[1], false); o[1] = (unsigned)__builtin_amdgcn_cvt_pk_fp8_f32(f8clamp(w[6] * qs), f8clamp(w[7] * qs), (int)o[1], true);
                    *(u32x2*)((unsigned char*)dst + (size_t)mat * dst_mat_stride + (size_t)(nt * 32 + n) * K + kt * 64 + kc * 8) = o;
                } else if constexpr (I8) {
                    unsigned q[8];
#pragma unroll
                    for (int j = 0; j < 8; ++j) { int v_ = __float2int_rn(w[j] * qs); v_ = v_ < -127 ? -127 : (v_ > 127 ? 127 : v_); q[j] = (unsigned)v_ & 255u; }
                    u32x2 o; o[0] = q[0] | (q[1] << 8) | (q[2] << 16) | (q[3] << 24); o[1] = q[4] | (q[5] << 8) | (q[6] << 16) | (q[7] << 24);
                    *(u32x2*)((unsigned char*)dst + (size_t)mat * dst_mat_stride + (size_t)(nt * 32 + n) * K + kt * 64 + kc * 8) = o;
                } else {
                u32x4 o; o[0] = cvtpk(w[0], w[1]); o[1] = cvtpk(w[2], w[3]); o[2] = cvtpk(w[4], w[5]); o[3] = cvtpk(w[6], w[7]);
                *(u32x4*)(dst + (size_t)mat * dst_mat_stride + (size_t)(nt * 32 + n) * K + kt * 64 + kc * 8) = o; }
            }
        }
        __syncthreads();
    }
}

template <bool I8 = false, class SrcFn>
__device__ __forceinline__ void cvt_mat(SrcFn srcfn, int ld_src, int K, int nnt, int nmat, size_t dst_mat_stride, const float* kscale, u16* dst, float* sm, int& tile_base, float qs = 1.f) {
    const int total = (K / 64) * ((nnt + 3) >> 2) * nmat;
    for (int tile = (int)((blockIdx.x + gridDim.x - (tile_base % (int)gridDim.x)) % gridDim.x); tile < total; tile += gridDim.x)
        cvt_unit<I8>(srcfn, ld_src, K, nnt, dst_mat_stride, kscale, dst, sm, tile, qs);
    tile_base += total;
}
constexpr int MOE_CVT_UNITS = 6144;
__device__ __forceinline__ void moe_cvt_unit(const Params& p, int l, float* sm, int unit) {
    if (unit < 4096) {
        const float* wg = p.in[31] + (size_t)l * 32 * 1024 * 512; const float* wu = p.in[32] + (size_t)l * 32 * 1024 * 512;
        const float amax = fmaxf(__uint_as_float(__hip_atomic_load(WSP(unsigned, 0) + AMAX_W + l, __ATOMIC_RELAXED, __HIP_MEMORY_SCOPE_AGENT)), 1e-30f);
        cvt_unit<true>([=](int e, int nt, int&) -> const float* { const int fb = nt >> 2, q = nt & 3; const int f = fb * 64 + (q >> 1) * 32; return ((q & 1) ? wu : wg) + (size_t)e * 1024 * 512 + f; },
                 512, 1024, 32, (size_t)1024 * 1024, nullptr, WSP(u16, O_WGU), sm, unit, WQ_TOP / amax);
    } else {
        const float* wd = p.in[33] + (size_t)l * 32 * 512 * 1024;
        const float amaxd = fmaxf(__uint_as_float(__hip_atomic_load(WSP(unsigned, 0) + AMAX_W + 2 + l, __ATOMIC_RELAXED, __HIP_MEMORY_SCOPE_AGENT)), 1e-30f);
        cvt_unit<false, true>([=](int e, int nt, int&) -> const float* { return wd + (size_t)e * 512 * 1024 + nt * 32; }, 1024, 512, 32, (size_t)1024 * 512, nullptr, WSP(u16, O_WD), sm, unit - 4096, F8_TOP / amaxd);
    }
}
__device__ __forceinline__ void moe_cvt_dynamic(const Params& p, int l, float* sm, unsigned* ctr, int* bc) {
    for (;;) {
        if (otid() == 0) *bc = (int)atomicAdd(ctr, 4u);
        __syncthreads();
        const int base = *bc;
        __syncthreads();
        if (base >= MOE_CVT_UNITS) break;
        for (int u = base; u < base + 4 && u < MOE_CVT_UNITS; ++u) moe_cvt_unit(p, l, sm, u);
    }
}

__device__ __forceinline__ unsigned pack_i8x4(const f32x4 v, float q) {
    return ((unsigned)__float2int_rn(v[0] * q) & 255u) | (((unsigned)__float2int_rn(v[1] * q) & 255u) << 8) | (((unsigned)__float2int_rn(v[2] * q) & 255u) << 16) | ((unsigned)__float2int_rn(v[3] * q) << 24);
}
__device__ __forceinline__ void rownorm_rows(const float* __restrict__ src, const float* __restrict__ g, unsigned char* __restrict__ dst8, float* __restrict__ sa) {
    const int lane = otid() & 63, wv = blockIdx.x * 4 + (otid() >> 6), nw = gridDim.x * 4;
    f32x4 gv[4];
#pragma unroll
    for (int i = 0; i < 4; ++i) gv[i] = *(const f32x4*)(g + i * 256 + lane * 4);
    for (int row = wv * 2; row < T; row += nw * 2) {
        f32x4 x[2][4]; float ss[2] = {0.f, 0.f}, am[2] = {0.f, 0.f};
#pragma unroll
        for (int u = 0; u < 2; ++u)
#pragma unroll
            for (int i = 0; i < 4; ++i) x[u][i] = *(const f32x4*)(src + (size_t)(row + u) * D + i * 256 + lane * 4);
#pragma unroll
        for (int u = 0; u < 2; ++u) {
#pragma unroll
            for (int i = 0; i < 4; ++i) ss[u] += x[u][i][0] * x[u][i][0] + x[u][i][1] * x[u][i][1] + x[u][i][2] * x[u][i][2] + x[u][i][3] * x[u][i][3];
            ss[u] = wave_sum(ss[u]);
            const float rs = rsqrtf(ss[u] * (1.f / D) + EPS);
#pragma unroll
            for (int i = 0; i < 4; ++i)
#pragma unroll
                for (int c = 0; c < 4; ++c) { x[u][i][c] *= rs * gv[i][c]; am[u] = fmaxf(am[u], fabsf(x[u][i][c])); }
            am[u] = fmaxf(wave_max(am[u]), 1e-30f);
            const float qa = 127.f / am[u];
#pragma unroll
            for (int i = 0; i < 4; ++i) *(unsigned*)(dst8 + (size_t)(row + u) * D + i * 256 + lane * 4) = pack_i8x4(x[u][i], qa);
            if (lane == 0) sa[row + u] = am[u] * (1.f / 127.f);
        }
    }
}
__device__ __forceinline__ float sample_amax(const float* __restrict__ src, size_t total, float* sm) {
    const int tid = otid();
    const size_t stride = (total / 16) & ~(size_t)3;
    float m = 0.f;
    f32x4 v[16];
#pragma unroll
    for (int c = 0; c < 16; ++c) v[c] = *(const f32x4*)(src + c * stride + tid * 4);
#pragma unroll
    for (int c = 0; c < 16; ++c) m = fmaxf(fmaxf(m, fmaxf(fabsf(v[c][0]), fabsf(v[c][1]))), fmaxf(fabsf(v[c][2]), fabsf(v[c][3])));
    m = wave_max(m);
    if ((tid & 63) == 0) sm[tid >> 6] = m;
    __syncthreads();
    m = fmaxf(fmaxf(sm[0], sm[1]), fmaxf(sm[2], sm[3]));
    __syncthreads();
    return fmaxf(m, 1e-30f);
}
__device__ __forceinline__ void dequant_tile(f32x16 (&acc)[2][2], const float* sa_tile, float sw) {
    const int tid = otid(), wr = tid >> 7, hi = (tid >> 5) & 1;
#pragma unroll
    for (int m = 0; m < 2; ++m)
#pragma unroll
        for (int rg = 0; rg < 4; ++rg) {
            const f32x4 s4 = *(const f32x4*)(sa_tile + wr * 64 + m * 32 + 8 * rg + 4 * hi);
#pragma unroll
            for (int i = 0; i < 4; ++i) { const float sc = s4[i] * sw;
#pragma unroll
                for (int n = 0; n < 2; ++n) acc[m][n][4 * rg + i] = (float)__float_as_int(acc[m][n][4 * rg + i]) * sc; }
            __builtin_amdgcn_sched_barrier(0);
        }
}

__device__ __forceinline__ void phase_prologue(const Params& p, unsigned char* smem) {
    float* sm = (float*)smem;
    const int tid = otid();
    for (int i = blockIdx.x * 256 + tid; i < 4096 * 48; i += gridDim.x * 256) {
        if (i < 4096 * 32) { const int pos = i >> 5, f = i & 31; const float inv = powf(10000.f, -(float)f / 32.f); float s, c; sincosf((float)pos * inv, &s, &c); WSP(f32x2, O_ROPED)[i] = (f32x2){c, s}; }
        else { const int j = i - 4096 * 32, pos = j >> 4, f = j & 15; const float inv = powf(10000.f, -(float)f / 16.f); float s, c; sincosf((float)pos * inv, &s, &c); WSP(f32x2, O_ROPEM)[j] = (f32x2){c, s}; }
    }
    const float amax0 = sample_amax(p.in[4], (size_t)1024 * EV_IN, sm), amax1 = sample_amax(p.in[12], (size_t)1024 * OD_IN, sm);
    int tb = 0;
    { const float* w = p.in[4];
      cvt_mat<true>([=](int, int nt, int&) -> const float* { const int n = nt * 32; if (n < 512) return w + n; if (n < 2048) return w + n + 32; if (n < 2080) return w + 512 + (n - 2048); return nullptr; },
              EV_IN, 1024, EV_INP / 32, 1, 0, nullptr, WSP(u16, O_WIN0), sm, tb, WQ_TOP / amax0); }
    { const float* w = p.in[7];
      cvt_mat([=](int, int nt, int&) -> const float* { const int n = nt * 32; if (n < 512) return w + (n >> 6) * 96 + (n & 63); return w + ((n - 512) >> 5) * 96 + 64; },
              768, 256, 24, 1, 0, p.in[6], WSP(u16, O_WQ), sm, tb); }
    { const float* w = p.in[9];
      cvt_mat([=](int, int nt, int&) -> const float* { return w + nt * 32; }, 1024, 256, 32, 1, 0, p.in[8], WSP(u16, O_WKV), sm, tb); }
    { const float* w = p.in[5];
      cvt_mat([=](int, int nt, int&) -> const float* { return w + nt * 32; }, 1024, 1024, 32, 1, 0, nullptr, WSP(u16, O_WOUT0), sm, tb); }
    { const float* w = p.in[12];
      cvt_mat<true>([=](int, int nt, int&) -> const float* { return w + nt * 32; }, OD_IN, 1024, OD_IN / 32, 1, 0, nullptr, WSP(u16, O_WIN1), sm, tb, WQ_TOP / amax1); }
    { const float* w = p.in[13];
      cvt_mat([=](int, int nt, int&) -> const float* { return w + nt * 32; }, 1024, 1024, 32, 1, 0, nullptr, WSP(u16, O_WOUT1), sm, tb); }
    { const float* w = p.in[16];
      cvt_mat([=](int, int nt, int&) -> const float* { return w + nt * 32; }, 512, 64, 16, 1, 0, nullptr, WSP(u16, O_W2T), sm, tb); }
    { const float* w = p.in[18];
      cvt_mat([=](int, int nt, int&) -> const float* { return w + nt * 32; }, 512, 64, 16, 1, 0, nullptr, WSP(u16, O_A2T), sm, tb); }
    { const float* w = p.in[19];
      cvt_mat([=](int, int nt, int&) -> const float* { return w + nt * 32; }, 512, 128, 16, 1, 0, nullptr, WSP(u16, O_G2T), sm, tb); }
    { const float* we = p.in[29];
      cvt_mat([=](int mat, int, int&) -> const float* { return we + (size_t)mat * 1024 * 32; }, 32, 1024, 1, 2, (size_t)128 * 1024, nullptr, WSP(u16, O_WR), sm, tb); }
    for (int i = blockIdx.x * 256 + tid; i < 2 * 96 * 1024; i += gridDim.x * 256) {
        const int l = i / (96 * 1024), r = (i / 1024) % 96, k = i % 1024;
        const float v = (r < 4) ? p.in[27][((size_t)l * 1024 + k) * 4 + r] : 0.f;
        WSP(u16, O_WR)[((size_t)l * 128 + 32 + r) * 1024 + k] = f2bf(v);
    }
    for (int l = 0; l < 2; ++l) {
        float m = 0.f;
        for (int mt = 31; mt <= 32; ++mt) { const f32x4* src = (const f32x4*)(p.in[mt] + (size_t)l * 32 * 1024 * 512);
            for (int c = blockIdx.x * 4 + (tid >> 6); c < 2048; c += gridDim.x * 4) { const f32x4 v = src[(size_t)c * 2048 + (tid & 63)]; m = fmaxf(fmaxf(m, fmaxf(fabsf(v[0]), fabsf(v[1]))), fmaxf(fabsf(v[2]), fabsf(v[3]))); } }
        float md = 0.f;
        { const f32x4* src = (const f32x4*)(p.in[33] + (size_t)l * 32 * 512 * 1024);
            for (int c = blockIdx.x * 4 + (tid >> 6); c < 2048; c += gridDim.x * 4) { const f32x4 v = src[(size_t)c * 2048 + (tid & 63)]; md = fmaxf(fmaxf(md, fmaxf(fabsf(v[0]), fabsf(v[1]))), fmaxf(fabsf(v[2]), fabsf(v[3]))); } }
        m = wave_max(m); md = wave_max(md);
        if ((tid & 63) == 0 && __float_as_uint(m) > __hip_atomic_load(WSP(unsigned, 0) + AMAX_W + l, __ATOMIC_RELAXED, __HIP_MEMORY_SCOPE_AGENT)) atomicMax(WSP(unsigned, 0) + AMAX_W + l, __float_as_uint(m));
        if ((tid & 63) == 0 && __float_as_uint(md) > __hip_atomic_load(WSP(unsigned, 0) + AMAX_W + 2 + l, __ATOMIC_RELAXED, __HIP_MEMORY_SCOPE_AGENT)) atomicMax(WSP(unsigned, 0) + AMAX_W + 2 + l, __float_as_uint(md));
    }
    rownorm_rows(p.in[0], p.in[1], WSP(unsigned char, O_HA), WSP(float, O_SAIN));
}

__device__ __forceinline__ void epi_store_bf16(const f32x16 (&acc)[2][2], u16* dst, int ld, int row0, int col0, int l31, int hi) {
#pragma unroll
    for (int m = 0; m < 2; ++m)
#pragma unroll
        for (int n = 0; n < 2; ++n)
#pragma unroll
            for (int r = 0; r < 16; ++r) dst[(size_t)(row0 + m * 32 + crow(r, hi)) * ld + col0 + n * 32 + l31] = f2bf(acc[m][n][r]);
}
__device__ __forceinline__ void epi_store_tile_lds(const f32x16 (&acc)[2][2], u16* dst, int ld, int row0, int col0, int row_lim, u16* Cs) {
    const int tid = otid(), lane = tid & 63, wid = tid >> 6, wr = wid >> 1, wc = wid & 1, l31 = lane & 31, hi = lane >> 5;
#pragma unroll
    for (int m = 0; m < 2; ++m)
#pragma unroll
        for (int n = 0; n < 2; ++n)
#pragma unroll
            for (int r = 0; r < 16; ++r) Cs[(wr * 64 + m * 32 + crow(r, hi)) * 136 + wc * 64 + n * 32 + l31] = f2bf(acc[m][n][r]);
    __syncthreads();
#pragma unroll
    for (int i = 0; i < 8; ++i) { const int c = tid + 256 * i, row = c >> 4, cc = c & 15;
        if (row0 + row < row_lim) __builtin_nontemporal_store(*(const u32x4*)(Cs + row * 136 + cc * 8), (u32x4*)(dst + (size_t)(row0 + row) * ld + col0 + cc * 8)); }
    __syncthreads();
}
template <bool F16>
__device__ __forceinline__ void lds_put16(const f32x16 (&acc)[2][2], u16* Cs, int wr, int wc, int l31, int hi) {
#pragma unroll
    for (int m = 0; m < 2; ++m)
#pragma unroll
        for (int n = 0; n < 2; ++n)
#pragma unroll
            for (int r = 0; r < 16; ++r) { const float v = acc[m][n][r];
                Cs[(wr * 64 + m * 32 + crow(r, hi)) * 136 + wc * 64 + n * 32 + l31] = F16 ? __builtin_bit_cast(u16, (h16)v) : f2bf(v); }
}
template <int NCH, class DstFn>
__device__ __forceinline__ void lds_rows_store(const u16* Cs, DstFn dstfn) {
    const int tid = otid();
#pragma unroll
    for (int i = 0; i < (128 * NCH) / 256; ++i) { const int c = tid + 256 * i, row = c / NCH, cc = c % NCH;
        u16* d = dstfn(row, cc);
        if (d) __builtin_nontemporal_store(*(const u32x4*)(Cs + row * 136 + cc * 8), (u32x4*)d); }
}
__device__ __forceinline__ void epi_store_T(const f32x16 (&acc)[2][2], unsigned char* plane, int e0, int pos0, float sc, int l31, int hi) {
    const float s16 = sc * V_F8_SCALE;
#pragma unroll
    for (int m = 0; m < 2; ++m)
#pragma unroll
        for (int n = 0; n < 2; ++n)
#pragma unroll
            for (int rg = 0; rg < 4; ++rg) {
                int w = 0;
                w = __builtin_amdgcn_cvt_pk_fp8_f32(f8clamp(acc[m][n][4 * rg] * s16), f8clamp(acc[m][n][4 * rg + 1] * s16), w, false);
                w = __builtin_amdgcn_cvt_pk_fp8_f32(f8clamp(acc[m][n][4 * rg + 2] * s16), f8clamp(acc[m][n][4 * rg + 3] * s16), w, true);
                *(int*)(plane + (size_t)(e0 + n * 32 + l31) * SEQ + pos0 + m * 32 + 8 * rg + 4 * hi) = w;
            }
}

__device__ __forceinline__ void phase_inproj0(const Params& p, unsigned char* smem) {
    WAVE_IDS;
    const u16* A = WSP(u16, O_HA); const u16* B = WSP(u16, O_WIN0);
    const f32x2* ropeD = WSP(f32x2, O_ROPED); const f32x2* ropeM = WSP(f32x2, O_ROPEM);
    constexpr int NCT = EV_INP / 128;
    const float swinv = sample_amax(p.in[4], (size_t)1024 * EV_IN, (float*)smem) * (1.f / WQ_TOP);
    GemmRegs g; unsigned aoff[4], boff[4];
    float sareg = 0.f; float* sl = (float*)(smem + 73728);
    int rt, ct, rtn = 0, ctn = 0; bool have = dense_tile(0, NCT, rt, ct);
    if (have) { lin_off(aoff, rt * 128, 512, 0); lin_off(boff, ct * 128, 512, 0); gemm_prefetch(g, A, aoff, B, boff, 8); if (tid < 128) sareg = WSP(float, O_SAIN)[rt * 128 + tid]; }
    for (int it = 0; have; ++it) {
        const int m0 = rt * 128, n0 = ct * 128;
        f32x16 acc[2][2];
        gemm_run<1>(acc, g, A, aoff, B, boff, 8, (u16*)smem);
        if (tid < 128) sl[tid] = sareg;
        have = dense_tile(it + 1, NCT, rtn, ctn);
        if (have) { lin_off(aoff, rtn * 128, 512, 0); lin_off(boff, ctn * 128, 512, 0); gemm_prefetch(g, A, aoff, B, boff, 8); if (tid < 128) sareg = WSP(float, O_SAIN)[rtn * 128 + tid]; }
        __syncthreads();
        dequant_tile(acc, sl, swinv);
        const int row0 = m0 + wr * 64, b = m0 >> 12, pos0 = row0 & (SEQ - 1);
        if (ct < 4) {
            epi_store_tile_lds(acc, WSP(u16, O_CLAT), 512, m0, n0, T, (u16*)smem);
        } else if (ct < 12) {
            const bool isq = ct < 8; const int hh = (ct - 4) & 3;
            u16* dst = WSP(u16, isq ? O_QD : O_KD) + (size_t)((b * 4 + hh) * 2) * SEQ * 64;
            const float sc = isq ? QSCALE_D : 1.f;
#pragma unroll
            for (int m = 0; m < 2; ++m)
#pragma unroll
                for (int r = 0; r < 16; ++r) {
                    const int pos = pos0 + m * 32 + crow(r, hi);
                    const f32x2 cs = ropeD[pos * 32 + l31];
                    const float x1 = acc[m][0][r], x2 = acc[m][1][r];
                    acc[m][0][r] = (x1 * cs[0] - x2 * cs[1]) * sc; acc[m][1][r] = (x2 * cs[0] + x1 * cs[1]) * sc;
                }
            lds_put16<false>(acc, (u16*)smem, wr, wc, l31, hi);
            __syncthreads();
            { const int p0m = m0 & (SEQ - 1);
              lds_rows_store<16>((const u16*)smem, [=](int row, int cc) -> u16* { return dst + (size_t)(cc >> 3) * SEQ * 64 + (size_t)(p0m + row) * 64 + (cc & 7) * 8; }); }
            __syncthreads();
        } else if (ct < 16) {
            const int hh = ct - 12;
            epi_store_T(acc, WSP(unsigned char, O_VTD) + (size_t)(b * 4 + hh) * 128 * SEQ, wc * 64, pos0, 1.f, l31, hi);
        } else {
            if (wc == 0) {
#pragma unroll
                for (int m = 0; m < 2; ++m)
#pragma unroll
                    for (int r = 0; r < 16; ++r) {
                        const int pos = pos0 + m * 32 + crow(r, hi);
                        const float x = acc[m][0][r], y = __shfl_xor(x, 16);
                        const f32x2 cs = ropeM[pos * 16 + (l31 & 15)];
                        const float o = (l31 < 16) ? (x * cs[0] - y * cs[1]) : (x * cs[0] + y * cs[1]);
                        const u16 ob = f2bf(o);
#pragma unroll
                        for (int h8 = 0; h8 < 8; ++h8) WSP(u16, O_KM)[((size_t)(b * 8 + h8) * SEQ + pos) * 96 + 64 + l31] = ob;
                    }
            }
        }
            rt = rtn; ct = ctn;
    }
}

__device__ __forceinline__ void phase_upproj(const Params& p, unsigned char* smem) {
    WAVE_IDS;
    const u16* A = WSP(u16, O_CLAT);
    const f32x2* ropeM = WSP(f32x2, O_ROPEM);
    float* rsl = (float*)(smem + 73728);
    int rt, c14;
    for (int it = 0; dense_tile(it, 14, rt, c14); ++it) {
        const int m0 = rt * 128;
        const bool isq = c14 < 6; const int ct = isq ? c14 : c14 - 6; const int acol = isq ? 0 : 256;
        {
            const int row = tid >> 1, half = tid & 1;
            const u16* q = A + (size_t)(m0 + row) * 512 + acol + half * 128;
            float ss = 0.f;
#pragma unroll
            for (int i = 0; i < 16; ++i) { const u32x4 v = *(const u32x4*)(q + i * 8);
#pragma unroll
                for (int j = 0; j < 4; ++j) { const float a = bflo(v[j]), c = bfhi(v[j]); ss += a * a + c * c; } }
            ss += __shfl_xor(ss, 1);
            if (half == 0) rsl[row] = rsqrtf(ss * (1.f / 256.f) + EPS);
        }
        unsigned aoff[4], boff[4]; lin_off(aoff, m0, 512, acol); lin_off(boff, ct * 128, 256, 0);
        f32x16 acc[2][2];
        gemm_mainloop(acc, A, aoff, isq ? WSP(u16, O_WQ) : WSP(u16, O_WKV), boff, 4, (u16*)smem);
        const int row0 = m0 + wr * 64, b = m0 >> 12, pos0 = row0 & (SEQ - 1);
#pragma unroll
        for (int m = 0; m < 2; ++m)
#pragma unroll
            for (int r = 0; r < 16; ++r) { const float rs = rsl[wr * 64 + m * 32 + crow(r, hi)];
                acc[m][0][r] *= rs; acc[m][1][r] *= rs; }
        const int p0m = m0 & (SEQ - 1);
        if (isq) {
            if (ct < 4) {
#pragma unroll
                for (int m = 0; m < 2; ++m)
#pragma unroll
                    for (int n = 0; n < 2; ++n)
#pragma unroll
                        for (int r = 0; r < 16; ++r) acc[m][n][r] *= QSCALE_M;
                lds_put16<false>(acc, (u16*)smem, wr, wc, l31, hi);
                __syncthreads();
                u16* dst = WSP(u16, O_QM) + (size_t)(b * 8 + 2 * ct) * SEQ * 96;
                lds_rows_store<16>((const u16*)smem, [=](int row, int cc) -> u16* { return dst + (size_t)(cc >> 3) * SEQ * 96 + (size_t)(p0m + row) * 96 + (cc & 7) * 8; });
                __syncthreads();
            } else {
#pragma unroll
                for (int m = 0; m < 2; ++m)
#pragma unroll
                    for (int n = 0; n < 2; ++n)
#pragma unroll
                        for (int r = 0; r < 16; ++r) {
                            const int pos = pos0 + m * 32 + crow(r, hi);
                            const float x = acc[m][n][r], y = __shfl_xor(x, 16);
                            const f32x2 cs = ropeM[pos * 16 + (l31 & 15)];
                            acc[m][n][r] = ((l31 < 16) ? (x * cs[0] - y * cs[1]) : (x * cs[0] + y * cs[1])) * QSCALE_M;
                        }
                lds_put16<false>(acc, (u16*)smem, wr, wc, l31, hi);
                __syncthreads();
                u16* dst = WSP(u16, O_QM) + (size_t)(b * 8 + (ct - 4) * 4) * SEQ * 96 + 64;
                lds_rows_store<16>((const u16*)smem, [=](int row, int cc) -> u16* { return dst + (size_t)(cc >> 2) * SEQ * 96 + (size_t)(p0m + row) * 96 + (cc & 3) * 8; });
                __syncthreads();
            }
        } else {
            const int head = ct;
            if (wc == 1) epi_store_T(acc, WSP(unsigned char, O_VTM) + (size_t)(b * 8 + head) * 64 * SEQ, 0, pos0, 1.f, l31, hi);
            lds_put16<false>(acc, (u16*)smem, wr, wc, l31, hi);
            __syncthreads();
            u16* dst = WSP(u16, O_KM) + (size_t)(b * 8 + head) * SEQ * 96;
            lds_rows_store<8>((const u16*)smem, [=](int row, int cc) -> u16* { return dst + (size_t)(p0m + row) * 96 + cc * 8; });
            __syncthreads();
        }
        __syncthreads();
    }
}

template <int DK, int DV>
__device__ __forceinline__ void attn_core(const u16* __restrict__ Q, const u16* __restrict__ K, const unsigned char* __restrict__ Vt, int qt, f32x16 (&o)[DV / 32], float& lrun, u16* smem) {
    WAVE_IDS;
    constexpr int KS = DK + 8, VS8 = 80, KT = 64 * KS, VT8 = DV * VS8;
    constexpr int NKC = DK / 32, NVC = DV / 64, NDT = DV / 32, NKS = DK / 16;
    constexpr float THR = 8.f;
    u16* Kl = smem; unsigned char* Vl = (unsigned char*)(smem + 2 * KT);
    const int q0 = qt * 128 + wid * 32;
    const int ntw = (q0 >> 6) + 1, ntb = qt * 2 + 2;
    bf16x8 qf[NKS];
#pragma unroll
    for (int s = 0; s < NKS; ++s) qf[s] = *(const bf16x8*)(Q + (size_t)(q0 + l31) * DK + s * 16 + hi * 8);
    u32x4 rk[NKC], rv[NVC];
#pragma unroll
    for (int d = 0; d < NDT; ++d)
#pragma unroll
        for (int r = 0; r < 16; ++r) o[d][r] = 0.f;
    f32x16 negm;
#pragma unroll
    for (int r = 0; r < 16; ++r) negm[r] = 0.f;
    lrun = 0.f;
    auto gload = [&](int j) {
#pragma unroll
        for (int i = 0; i < NKC; ++i) rk[i] = *(const u32x4*)(K + (size_t)j * 64 * DK + (size_t)(tid + 256 * i) * 8);
#pragma unroll
        for (int i = 0; i < NVC; ++i) { const int c = tid + 256 * i; rv[i] = *(const u32x4*)(Vt + (size_t)(c >> 2) * SEQ + j * 64 + (c & 3) * 16); }
    };
    auto lstore = [&](int buf) {
#pragma unroll
        for (int i = 0; i < NKC; ++i) { const int c = tid + 256 * i, row = c / (DK / 8), kc = c % (DK / 8); *(u32x4*)(Kl + buf * KT + row * KS + kc * 8) = rk[i]; }
#pragma unroll
        for (int i = 0; i < NVC; ++i) { const int c = tid + 256 * i, part = c & 3;
            unsigned char* d = Vl + buf * VT8 + (c >> 2) * VS8 + part * 8;
            *(u32x2*)d = (u32x2){rv[i][0], rv[i][2]}; *(u32x2*)(d + 32) = (u32x2){rv[i][1], rv[i][3]}; }
    };
    gload(0); lstore(0); __syncthreads();
    for (int j = 0; j < ntb; ++j) {
        const int cur = j & 1;
        if (j + 1 < ntb) gload(j + 1);
        __builtin_amdgcn_sched_barrier(0);
        if (j < ntw) {
            const u16* Kb = Kl + cur * KT; const unsigned char* Vb = Vl + cur * VT8;
            f32x16 p0, p1;
            __builtin_amdgcn_s_setprio(1);
            bf16x8 kf[2][2];
#pragma unroll
            for (int s = 0; s < 2; ++s) { kf[s][0] = *(const bf16x8*)(Kb + l31 * KS + s * 16 + hi * 8); kf[s][1] = *(const bf16x8*)(Kb + (32 + l31) * KS + s * 16 + hi * 8); }
#pragma unroll
            for (int s = 0; s < NKS; ++s) {
                if (s == 0) { p0 = MFMA(kf[0][0], qf[0], negm); p1 = MFMA(kf[0][1], qf[0], negm); }
                else { p0 = MFMA(kf[s & 1][0], qf[s], p0); p1 = MFMA(kf[s & 1][1], qf[s], p1); }
                if (s + 2 < NKS) { kf[s & 1][0] = *(const bf16x8*)(Kb + l31 * KS + (s + 2) * 16 + hi * 8); kf[s & 1][1] = *(const bf16x8*)(Kb + (32 + l31) * KS + (s + 2) * 16 + hi * 8); }
                __builtin_amdgcn_sched_barrier(0);
            }
            u32x4 vf[NDT][2];
#pragma unroll
            for (int d = 0; d < NDT; ++d) { const unsigned char* vp = Vb + (d * 32 + l31) * VS8 + hi * 32; vf[d][0] = *(const u32x4*)vp; vf[d][1] = *(const u32x4*)(vp + 16); }
            __builtin_amdgcn_s_setprio(0);
            __builtin_amdgcn_sched_barrier(0);
            float mx = p0[0];
#pragma unroll
            for (int r = 1; r < 16; ++r) mx = fmaxf(mx, p0[r]);
#pragma unroll
            for (int r = 0; r < 16; ++r) mx = fmaxf(mx, p1[r]);
            mx = xhalf_max(mx);
            if (j == 0 || __any(mx > THR)) {
                const float dm = (j == 0) ? mx : fmaxf(mx, 0.f), alpha = (j == 0) ? 0.f : __builtin_amdgcn_exp2f(-dm);
                lrun *= alpha;
#pragma unroll
                for (int d = 0; d < NDT; ++d)
#pragma unroll
                    for (int r = 0; r < 16; ++r) o[d][r] *= alpha;
#pragma unroll
                for (int r = 0; r < 16; ++r) { p0[r] -= dm; p1[r] -= dm; negm[r] -= dm; }
            }
            float ps = 0.f;
#pragma unroll
            for (int r = 0; r < 16; ++r) { p0[r] = __builtin_amdgcn_exp2f(p0[r]); ps += p0[r]; }
#pragma unroll
            for (int r = 0; r < 16; ++r) { p1[r] = __builtin_amdgcn_exp2f(p1[r]); ps += p1[r]; }
            lrun += xhalf_sum(ps);
            u32x4 plo, phi;
#pragma unroll
            for (int d4 = 0; d4 < 4; ++d4) {
                int w0 = 0, w1 = 0;
                w0 = __builtin_amdgcn_cvt_pk_fp8_f32(p0[4 * d4], p0[4 * d4 + 1], w0, false); w0 = __builtin_amdgcn_cvt_pk_fp8_f32(p0[4 * d4 + 2], p0[4 * d4 + 3], w0, true);
                w1 = __builtin_amdgcn_cvt_pk_fp8_f32(p1[4 * d4], p1[4 * d4 + 1], w1, false); w1 = __builtin_amdgcn_cvt_pk_fp8_f32(p1[4 * d4 + 2], p1[4 * d4 + 3], w1, true);
                plo[d4] = (unsigned)w0; phi[d4] = (unsigned)w1;
            }
            __builtin_amdgcn_s_setprio(1);
#pragma unroll
            for (int d = 0; d < NDT; ++d) o[d] = mma_f8(vf[d][0], vf[d][1], plo, phi, o[d]);
            __builtin_amdgcn_s_setprio(0);
        }
        __builtin_amdgcn_sched_barrier(0);
        if (j + 1 < ntb) lstore(cur ^ 1);
        __syncthreads();
    }
}

__device__ __forceinline__ void phase_attn(const Params& p, unsigned char* smem) {
    WAVE_IDS;
    unsigned* ctr = WSP(unsigned, 0) + ATTN_CTR_W;
    int* bc = (int*)(smem + 73728 + 1024);
    float* sl = (float*)(smem + 73728 + 1536);
    if (tid < 64) { const float* lam = p.in[10]; float a = lam[tid] * lam[64 + tid], c = lam[128 + tid] * lam[192 + tid]; a = wave_sum(a); c = wave_sum(c);
        if (tid == 0) sl[0] = __expf(a) - __expf(c) + 0.2f; }
    __syncthreads();
    const float lamf = sl[0];
    u32x2* scr = WSP(u32x2, O_ATTSCR) + (size_t)blockIdx.x * 4096;
    for (;;) {
        if (tid == 0) *bc = (int)atomicAdd(ctr, 1u);
        __syncthreads();
        const int qi = *bc;
        __syncthreads();
        if (qi >= 3072) break;
        const int item = qi;
        const int level = item / 96, r = item - level * 96, qt = 31 - level;
        const int q0 = qt * 128 + wid * 32;
        if (r < 32) {
            const int bh = r, b = bh >> 2, hh = bh & 3;
            f32x16 o[4]; float l1;
            attn_core<64, 128>(WSP(u16, O_QD) + (size_t)(bh * 2) * SEQ * 64, WSP(u16, O_KD) + (size_t)(bh * 2) * SEQ * 64, WSP(unsigned char, O_VTD) + (size_t)bh * 128 * SEQ, qt, o, l1, (u16*)smem);
            { const float il = 1.f / (l1 * V_F8_SCALE);
#pragma unroll
              for (int d = 0; d < 4; ++d)
#pragma unroll
                  for (int rg = 0; rg < 4; ++rg) { u32x2 w; w[0] = cvtpk(o[d][4 * rg] * il, o[d][4 * rg + 1] * il); w[1] = cvtpk(o[d][4 * rg + 2] * il, o[d][4 * rg + 3] * il);
                      scr[((wid * 4 + d) * 4 + rg) * 64 + lane] = w; } }
            float l2;
            attn_core<64, 128>(WSP(u16, O_QD) + (size_t)(bh * 2 + 1) * SEQ * 64, WSP(u16, O_KD) + (size_t)(bh * 2 + 1) * SEQ * 64, WSP(unsigned char, O_VTD) + (size_t)bh * 128 * SEQ, qt, o, l2, (u16*)smem);
            const float il2 = lamf / (l2 * V_F8_SCALE);
            float ss = 0.f;
#pragma unroll
            for (int d = 0; d < 4; ++d)
#pragma unroll
                for (int rg = 0; rg < 4; ++rg) { const u32x2 w = scr[((wid * 4 + d) * 4 + rg) * 64 + lane];
                    o[d][4 * rg] = bflo(w[0]) - o[d][4 * rg] * il2; o[d][4 * rg + 1] = bfhi(w[0]) - o[d][4 * rg + 1] * il2;
                    o[d][4 * rg + 2] = bflo(w[1]) - o[d][4 * rg + 2] * il2; o[d][4 * rg + 3] = bfhi(w[1]) - o[d][4 * rg + 3] * il2;
                    ss += o[d][4 * rg] * o[d][4 * rg] + o[d][4 * rg + 1] * o[d][4 * rg + 1] + o[d][4 * rg + 2] * o[d][4 * rg + 2] + o[d][4 * rg + 3] * o[d][4 * rg + 3]; }
            ss = xhalf_sum(ss);
            const float rs = rsqrtf(ss * (1.f / 128.f) + EPS) * 0.8f;
            u16* dst = WSP(u16, O_HA) + ((size_t)b * SEQ + q0 + l31) * 1024 + 512 + hh * 128;
#pragma unroll
            for (int d = 0; d < 4; ++d)
#pragma unroll
                for (int rg = 0; rg < 4; ++rg) { const int e = d * 32 + 8 * rg + 4 * hi; const f32x4 gsub = *(const f32x4*)(p.in[11] + e);
                    u32x2 w; w[0] = cvtpk(o[d][4 * rg] * rs * gsub[0], o[d][4 * rg + 1] * rs * gsub[1]); w[1] = cvtpk(o[d][4 * rg + 2] * rs * gsub[2], o[d][4 * rg + 3] * rs * gsub[3]);
                    *(u32x2*)(dst + e) = w; }
        } else {
            const int bh = r - 32, b = bh >> 3, h8 = bh & 7;
            f32x16 o[2]; float l1;
            attn_core<96, 64>(WSP(u16, O_QM) + (size_t)bh * SEQ * 96, WSP(u16, O_KM) + (size_t)bh * SEQ * 96, WSP(unsigned char, O_VTM) + (size_t)bh * 64 * SEQ, qt, o, l1, (u16*)smem);
            const float il = 1.f / (l1 * V_F8_SCALE);
            u16* dst = WSP(u16, O_HA) + ((size_t)b * SEQ + q0 + l31) * 1024 + h8 * 64;
#pragma unroll
            for (int d = 0; d < 2; ++d)
#pragma unroll
                for (int rg = 0; rg < 4; ++rg) { u32x2 w; w[0] = cvtpk(o[d][4 * rg] * il, o[d][4 * rg + 1] * il); w[1] = cvtpk(o[d][4 * rg + 2] * il, o[d][4 * rg + 3] * il);
                    *(u32x2*)(dst + d * 32 + 8 * rg + 4 * hi) = w; }
        }
    }
}

__device__ __forceinline__ void phase_outproj(const Params& p, unsigned char* smem, int l) {
    WAVE_IDS;
    const u16* A = WSP(u16, O_HA); const u16* B = WSP(u16, l == 0 ? O_WOUT0 : O_WOUT1);
    const float* res = p.in[0];
    float* Cs = (float*)smem;
    GemmRegs g; unsigned aoff[4], boff[4];
    int rt, ct, rtn = 0, ctn = 0; bool have = dense_tile(0, 8, rt, ct);
    if (have) { lin_off(aoff, rt * 128, 1024, 0); lin_off(boff, ct * 128, 1024, 0); gemm_prefetch(g, A, aoff, B, boff, 16); }
    for (int it = 0; have; ++it) {
        const int m0 = rt * 128, n0 = ct * 128;
        f32x16 acc[2][2];
        gemm_run(acc, g, A, aoff, B, boff, 16, (u16*)smem);
        have = dense_tile(it + 1, 8, rtn, ctn);
        if (have) { lin_off(aoff, rtn * 128, 1024, 0); lin_off(boff, ctn * 128, 1024, 0); gemm_prefetch(g, A, aoff, B, boff, 16); }
#pragma unroll
        for (int m = 0; m < 2; ++m)
#pragma unroll
            for (int n = 0; n < 2; ++n)
#pragma unroll
                for (int r = 0; r < 16; ++r) Cs[(wr * 64 + m * 32 + crow(r, hi)) * 132 + wc * 64 + n * 32 + l31] = acc[m][n][r];
        __syncthreads();
#pragma unroll
        for (int i = 0; i < 16; ++i) { const int c = tid + 256 * i, row = c >> 5, c4 = (c & 31) * 4;
            const f32x4 rv = l == 0 ? *(const f32x4*)(res + (size_t)(m0 + row) * D + n0 + c4) : bf4_to_f32(*(const u32x2*)(HB(m0 + row) + n0 + c4));
            const f32x4 hv = rv + *(const f32x4*)(Cs + row * 132 + c4);
            u32x2 o; o[0] = cvtpk(hv[0], hv[1]); o[1] = cvtpk(hv[2], hv[3]);
            *(u32x2*)(HB(m0 + row) + n0 + c4) = o; }
        __syncthreads();
            rt = rtn; ct = ctn;
    }
}

__device__ __forceinline__ void phase_route(const Params& p, unsigned char* smem, int l) {
    WAVE_IDS;
    const u16* A = WSP(u16, O_HA); const u16* B = WSP(u16, O_WR) + (size_t)l * 128 * 1024;
    float* lg = (float*)smem;
    int* lc = (int*)(smem + 73728 + 1664);
    float* sarow = (float*)(smem + 73728);
    unsigned* cnt = WSP(unsigned, 0) + CNT_W + l * 64;
    const float* g = p.in[2] + l * 1024;
    int rt, ct0;
    for (int it = 0; dense_tile(it, 1, rt, ct0); ++it) {
        const int m0 = rt * 128;
        {
            f32x4 gv[4];
#pragma unroll
            for (int i = 0; i < 4; ++i) gv[i] = *(const f32x4*)(g + i * 256 + lane * 4);
            constexpr int RB = 4;
            for (int r2 = 0; r2 < 32; r2 += RB) {
                const int row = m0 + wid * 32 + r2;
                f32x4 x[RB][4]; float ss[RB];
#pragma unroll
                for (int u = 0; u < RB; ++u)
#pragma unroll
                    for (int i = 0; i < 4; ++i) x[u][i] = bf4_to_f32(*(const u32x2*)(HB(row + u) + i * 256 + lane * 4));
#pragma unroll
                for (int u = 0; u < RB; ++u) {
                    ss[u] = 0.f;
#pragma unroll
                    for (int i = 0; i < 4; ++i) ss[u] += x[u][i][0] * x[u][i][0] + x[u][i][1] * x[u][i][1] + x[u][i][2] * x[u][i][2] + x[u][i][3] * x[u][i][3];
                }
#pragma unroll
                for (int o = 32; o; o >>= 1)
#pragma unroll
                    for (int u = 0; u < RB; ++u) ss[u] += __shfl_xor(ss[u], o);
                float am[RB];
#pragma unroll
                for (int u = 0; u < RB; ++u) {
                    const float rs = rsqrtf(ss[u] * (1.f / D) + EPS);
                    am[u] = 0.f;
#pragma unroll
                    for (int i = 0; i < 4; ++i) {
#pragma unroll
                        for (int c = 0; c < 4; ++c) { x[u][i][c] *= rs * gv[i][c]; am[u] = fmaxf(am[u], fabsf(x[u][i][c])); }
                        u32x2 o; o[0] = cvtpk(x[u][i][0], x[u][i][1]); o[1] = cvtpk(x[u][i][2], x[u][i][3]);
                        *(u32x2*)(WSP(u16, O_HA) + (size_t)(row + u) * D + i * 256 + lane * 4) = o; }
                }
#pragma unroll
                for (int o = 32; o; o >>= 1)
#pragma unroll
                    for (int u = 0; u < RB; ++u) am[u] = fmaxf(am[u], __shfl_xor(am[u], o));
#pragma unroll
                for (int u = 0; u < RB; ++u) {
                    const float amx = fmaxf(am[u], 1e-30f);
                    const float qa = 127.f / amx;
#pragma unroll
                    for (int i = 0; i < 4; ++i) { unsigned q[4];
#pragma unroll
                        for (int c = 0; c < 4; ++c) q[c] = (unsigned)__float2int_rn(x[u][i][c] * qa) & 255u;
                        *(unsigned*)(WSP(unsigned char, O_A8) + (size_t)(row + u) * D + i * 256 + lane * 4) = q[0] | (q[1] << 8) | (q[2] << 16) | (q[3] << 24); }
                    if (lane == 0) sarow[row + u - m0] = amx * (1.f / 127.f);
                }
            }
            __syncthreads();
        }
        unsigned aoff[4], boff[4]; lin_off(aoff, m0, 1024, 0); lin_off(boff, 0, 1024, 0);
        f32x16 acc[2][2];
        gemm_mainloop(acc, A, aoff, B, boff, 16, (u16*)smem);
        if (wc == 0) {
#pragma unroll
            for (int m = 0; m < 2; ++m)
#pragma unroll
                for (int r = 0; r < 16; ++r) { const int row = wr * 64 + m * 32 + crow(r, hi);
                    lg[row * 37 + l31] = acc[m][0][r]; if (l31 < 4) lg[row * 37 + 32 + l31] = acc[m][1][r]; }
        }
        if (tid < 32) lc[tid] = 0;
        __syncthreads();
        int ea = 0, eb = 0, la = 0, lb = 0; float gw0 = 0.f, gw1 = 0.f;
        if (tid < 128) {
            const float* z = lg + tid * 37;
            float zg[4]; int gsel = 0;
#pragma unroll
            for (int i = 0; i < 4; ++i) zg[i] = z[32 + i] + p.in[28][l * 4 + i];
#pragma unroll
            for (int i = 1; i < 4; ++i) if (zg[i] > zg[gsel]) gsel = i;
            float den = 0.f;
#pragma unroll
            for (int i = 0; i < 4; ++i) den += __expf(zg[i] - zg[gsel]);
            const float pg = 1.f / den;
            float ze[8];
#pragma unroll
            for (int i = 0; i < 8; ++i) ze[i] = z[gsel * 8 + i] + p.in[30][l * 32 + gsel * 8 + i];
            int i0 = 0;
#pragma unroll
            for (int i = 1; i < 8; ++i) if (ze[i] > ze[i0]) i0 = i;
            int i1 = (i0 == 0) ? 1 : 0;
#pragma unroll
            for (int i = 0; i < 8; ++i) if (i != i0 && ze[i] > ze[i1]) i1 = i;
            const float e1 = __expf(ze[i1] - ze[i0]);
            const float w0 = pg / (1.f + e1), w1 = pg * e1 / (1.f + e1);
            ea = gsel * 8 + i0; eb = gsel * 8 + i1;
            la = atomicAdd(&lc[ea], 1); lb = atomicAdd(&lc[eb], 1);
            gw0 = w0; gw1 = w1;
        }
        __syncthreads();
        if (tid < 32) { const int c = lc[tid]; lc[32 + tid] = c ? (int)atomicAdd(&cnt[tid], (unsigned)c) : 0; }
        __syncthreads();
        if (tid < 128) { const int pa = lc[32 + ea] + la, pb = lc[32 + eb] + lb, t = m0 + tid; const float sa = sarow[tid];
            WSP(int4, O_SEL)[t] = make_int4(ea, pa, eb, pb);
            WSP(int, O_TOK2)[(size_t)ea * T + pa] = t; WSP(int, O_TOK2)[(size_t)eb * T + pb] = t;
            WSP(f32x2, O_GS2)[(size_t)ea * T + pa] = (f32x2){gw0, sa}; WSP(f32x2, O_GS2)[(size_t)eb * T + pb] = (f32x2){gw1, sa}; }
        __syncthreads();
    }
    moe_cvt_dynamic(p, l, (float*)smem, WSP(unsigned, 0) + (l == 0 ? CONV0_CTR_W : CONV1_CTR_W), (int*)(smem + 73728 + 1024));
}

__device__ __forceinline__ void expert_offsets(const Params& p, int l, int* offs) {
    if (otid() < 32) offs[128 + otid()] = (int)__hip_atomic_load(WSP(unsigned, 0) + CNT_W + l * 64 + otid(), __ATOMIC_RELAXED, __HIP_MEMORY_SCOPE_AGENT);
    __syncthreads();
    if (otid() == 0) { int a = 0, tl = 0;
        for (int e = 0; e < 32; ++e) { offs[e] = a; offs[64 + e] = tl; const int c = offs[128 + e]; a += c; tl += (c + 127) >> 7; }
        offs[32] = a; offs[64 + 32] = tl; }
    __syncthreads();
}

__device__ __forceinline__ void phase_lists(const Params& p, unsigned char* smem, int l) {
    int* offs = (int*)(smem + 73728);
    expert_offsets(p, l, offs);
    for (int t = blockIdx.x * 256 + otid(); t < T; t += gridDim.x * 256) {
        const int4 s = WSP(int4, O_SEL)[t]; const f32x2 g = WSP(f32x2, O_GATES)[t];
        const int r0 = offs[s.x] + s.y, r1 = offs[s.z] + s.w;
        WSP(int, O_TOKROW)[r0] = t; WSP(int, O_TOKROW)[r1] = t;
        WSP(float, O_GATEROW)[r0] = g[0]; WSP(float, O_GATEROW)[r1] = g[1];
        const float sa = WSP(float, O_SA8)[t];
        WSP(f32x2, O_GSROW)[r0] = (f32x2){g[0], sa}; WSP(f32x2, O_GSROW)[r1] = (f32x2){g[1], sa};
        WSP(int, O_ROWTOK)[2 * t] = r0; WSP(int, O_ROWTOK)[2 * t + 1] = r1;
    }
}

__device__ __forceinline__ void phase_moe1(const Params& p, unsigned char* smem, int l) {
    WAVE_IDS;
    int* offs = (int*)(smem + 73728);
    expert_offsets(p, l, offs);
    const int ntl = offs[64 + 32];
    const u16* A = WSP(u16, O_A8);
    const float swinv = fmaxf(__uint_as_float(__hip_atomic_load(WSP(unsigned, 0) + AMAX_W + l, __ATOMIC_RELAXED, __HIP_MEMORY_SCOPE_AGENT)), 1e-30f) * (1.f / WQ_TOP);
    GemmRegs g; unsigned aoff[4], boff[4];
    f32x2 gsreg = {0.f, 0.f}; f32x2* gl = (f32x2*)(smem + ROWSC_LDS);
    auto setup = [&](int it_, int& rtg_, int& ct_, int& e_, int& rbeg_, int& rend_) -> bool {
        if (!moe_tile(it_, ntl, rtg_, ct_)) return false;
        e_ = 0; while (offs[64 + e_ + 1] <= rtg_) ++e_;
        rbeg_ = offs[e_] + (rtg_ - offs[64 + e_]) * 128; rend_ = offs[e_ + 1];
#pragma unroll
        for (int i = 0; i < 4; ++i) { int r = rbeg_ + (tid >> 3) + 32 * i; r = r < rend_ ? r : rend_ - 1; aoff[i] = (unsigned)WSP(int, O_TOK2)[(size_t)e_ * T + (r - offs[e_])] * 512u + (tid & 7) * 8; }
        lin_off(boff, ct_ * 128, 512, 0);
        gemm_prefetch(g, A, aoff, WSP(u16, O_WGU) + (size_t)e_ * 1024 * 512, boff, 8);
        if (tid < 128) gsreg = WSP(f32x2, O_GS2)[(size_t)e_ * T + (rbeg_ - offs[e_]) + tid];
        return true; };
    int rtg, ct, e, rbeg, rend, rtgn = 0, ctn = 0, en = 0, rbegn = 0, rendn = 0;
    bool have = setup(0, rtg, ct, e, rbeg, rend);
    for (int it = 0; have; ++it) {
        f32x16 acc[2][2];
        gemm_run<1>(acc, g, A, aoff, WSP(u16, O_WGU) + (size_t)e * 1024 * 512, boff, 8, (u16*)smem);
        if (tid < 128) gl[tid] = gsreg;
        have = setup(it + 1, rtgn, ctn, en, rbegn, rendn);
        __syncthreads();
        { u16* Cs = (u16*)smem;
#pragma unroll
          for (int m = 0; m < 2; ++m)
#pragma unroll
              for (int rg = 0; rg < 4; ++rg) {
                  const int lr0 = wr * 64 + m * 32 + 8 * rg + 4 * hi;
                  const f32x4* gp = (const f32x4*)(gl + lr0);
                  const f32x4 g01 = gp[0], g23 = gp[1];
#pragma unroll
                  for (int i = 0; i < 4; ++i) { const float gt = i == 0 ? g01[0] : (i == 1 ? g01[2] : (i == 2 ? g23[0] : g23[2])); const float sc = (i == 0 ? g01[1] : (i == 1 ? g01[3] : (i == 2 ? g23[1] : g23[3]))) * swinv;
                      const float a = (float)__float_as_int(acc[m][0][4 * rg + i]) * sc, u = (float)__float_as_int(acc[m][1][4 * rg + i]) * sc;
                      ((unsigned char*)Cs)[(lr0 + i) * 272 + wc * 32 + l31] = (unsigned char)(__builtin_amdgcn_cvt_pk_fp8_f32(f8clamp(siluf_(a) * u * gt * ACT_F8_SCALE), 0.f, 0, false) & 0xff); }
                  __builtin_amdgcn_sched_barrier(0);
              }
          __syncthreads();
          u16* dst = WSP(u16, O_ACTB) + (size_t)rbeg * 256 + ct * 32; const int nvalid = rend - rbeg;
          lds_rows_store<4>((const u16*)smem, [=](int row, int cc) -> u16* { return row < nvalid ? dst + (size_t)row * 256 + cc * 8 : nullptr; });
          __syncthreads(); }
            rtg = rtgn; ct = ctn; e = en; rbeg = rbegn; rend = rendn;
    }
}

__device__ __forceinline__ void phase_moe2(const Params& p, unsigned char* smem, int l) {
    WAVE_IDS;
    int* offs = (int*)(smem + 73728);
    expert_offsets(p, l, offs);
    const int ntl = offs[64 + 32];
    const u16* A = WSP(u16, O_ACTB);
    const float sdq = fmaxf(__uint_as_float(__hip_atomic_load(WSP(unsigned, 0) + AMAX_W + 2 + l, __ATOMIC_RELAXED, __HIP_MEMORY_SCOPE_AGENT)), 1e-30f) * (1.f / (F8_TOP * ACT_F8_SCALE));
    GemmRegs g; unsigned aoff[4], boff[4];
    auto setup = [&](int it_, int& rtg_, int& ct_, int& e_, int& rbeg_, int& rend_) -> bool {
        if (!moe_tile(it_, ntl, rtg_, ct_)) return false;
        e_ = 0; while (offs[64 + e_ + 1] <= rtg_) ++e_;
        rbeg_ = offs[e_] + (rtg_ - offs[64 + e_]) * 128; rend_ = offs[e_ + 1];
#pragma unroll
        for (int i = 0; i < 4; ++i) { int r = rbeg_ + (tid >> 3) + 32 * i; r = r < rend_ ? r : rend_ - 1; aoff[i] = (unsigned)r * 256u + (tid & 7) * 8; }
        lin_off(boff, ct_ * 128, 256, 0);
        gemm_prefetch(g, A, aoff, WSP(u16, O_WD) + (size_t)e_ * 1024 * 256, boff, 4);
        return true; };
    int rtg, ct, e, rbeg, rend, rtgn = 0, ctn = 0, en = 0, rbegn = 0, rendn = 0;
    bool have = setup(0, rtg, ct, e, rbeg, rend);
    for (int it = 0; have; ++it) {
        f32x16 acc[2][2];
        gemm_run<2>(acc, g, A, aoff, WSP(u16, O_WD) + (size_t)e * 1024 * 256, boff, 4, (u16*)smem);
        have = setup(it + 1, rtgn, ctn, en, rbegn, rendn);
#pragma unroll
        for (int m = 0; m < 2; ++m)
#pragma unroll
            for (int n = 0; n < 2; ++n)
#pragma unroll
                for (int r = 0; r < 16; ++r) acc[m][n][r] *= sdq;
        epi_store_tile_lds(acc, WSP(u16, O_YSORT), 1024, rbeg, ct * 128, rend, (u16*)smem);
            rtg = rtgn; ct = ctn; e = en; rbeg = rbegn; rend = rendn;
    }
}

__device__ __forceinline__ void phase_combine(const Params& p, unsigned char* smem, int l) {
    int* offs = (int*)(smem + 73728);
    expert_offsets(p, l, offs);
    const int lane = otid() & 63, wv = blockIdx.x * 4 + (otid() >> 6), nw = gridDim.x * 4;
    const float* g = (l == 0) ? (p.in[1] + 1024) : p.in[3];
    f32x4 gv[4];
#pragma unroll
    for (int i = 0; i < 4; ++i) gv[i] = *(const f32x4*)(g + i * 256 + lane * 4);
    const u16* ys = WSP(u16, O_YSORT);
    for (int t0 = wv * 2; t0 < T; t0 += nw * 2) {
        const int4 s0 = WSP(int4, O_SEL)[t0], s1 = WSP(int4, O_SEL)[t0 + 1];
        const int4 rr = make_int4(offs[s0.x] + s0.y, offs[s0.z] + s0.w, offs[s1.x] + s1.y, offs[s1.z] + s1.w);
        f32x4 x[2][4]; u32x2 ya[2][4], yb[2][4];
#pragma unroll
        for (int u = 0; u < 2; ++u) {
            const int r0 = u ? rr.z : rr.x, r1 = u ? rr.w : rr.y;
#pragma unroll
            for (int i = 0; i < 4; ++i) {
                x[u][i] = bf4_to_f32(*(const u32x2*)(HB(t0 + u) + i * 256 + lane * 4));
                ya[u][i] = *(const u32x2*)(ys + (size_t)r0 * 1024 + i * 256 + lane * 4); yb[u][i] = *(const u32x2*)(ys + (size_t)r1 * 1024 + i * 256 + lane * 4);
            }
        }
#pragma unroll
        for (int u = 0; u < 2; ++u) {
            const int t = t0 + u; float ss = 0.f;
#pragma unroll
            for (int i = 0; i < 4; ++i) {
                const u32x2 a = ya[u][i], c = yb[u][i];
                x[u][i][0] += bflo(a[0]) + bflo(c[0]); x[u][i][1] += bfhi(a[0]) + bfhi(c[0]); x[u][i][2] += bflo(a[1]) + bflo(c[1]); x[u][i][3] += bfhi(a[1]) + bfhi(c[1]);
                ss += x[u][i][0] * x[u][i][0] + x[u][i][1] * x[u][i][1] + x[u][i][2] * x[u][i][2] + x[u][i][3] * x[u][i][3];
            }
            ss = wave_sum(ss);
            const float rs = rsqrtf(ss * (1.f / D) + EPS);
            if (l == 0) {
#pragma unroll
                for (int i = 0; i < 4; ++i) { u32x2 o; o[0] = cvtpk(x[u][i][0], x[u][i][1]); o[1] = cvtpk(x[u][i][2], x[u][i][3]); *(u32x2*)(HB(t) + i * 256 + lane * 4) = o; }
                float am = 0.f;
#pragma unroll
                for (int i = 0; i < 4; ++i)
#pragma unroll
                    for (int c = 0; c < 4; ++c) { x[u][i][c] *= rs * gv[i][c]; am = fmaxf(am, fabsf(x[u][i][c])); }
                am = fmaxf(wave_max(am), 1e-30f);
                const float qa = 127.f / am;
#pragma unroll
                for (int i = 0; i < 4; ++i) *(unsigned*)(WSP(unsigned char, O_HA) + (size_t)t * D + i * 256 + lane * 4) = pack_i8x4(x[u][i], qa);
                if (lane == 0) WSP(float, O_SAIN)[t] = am * (1.f / 127.f);
            } else {
#pragma unroll
                for (int i = 0; i < 4; ++i) { f32x4 o; o[0] = x[u][i][0] * rs * gv[i][0]; o[1] = x[u][i][1] * rs * gv[i][1]; o[2] = x[u][i][2] * rs * gv[i][2]; o[3] = x[u][i][3] * rs * gv[i][3];
                    *(f32x4*)(p.out + (size_t)t * D + i * 256 + lane * 4) = o; }
            }
        }
    }
}

__device__ __forceinline__ void phase_inproj1(const Params& p, unsigned char* smem) {
    WAVE_IDS;
    const u16* A = WSP(u16, O_HA); const u16* B = WSP(u16, O_WIN1);
    const float swinv = sample_amax(p.in[12], (size_t)1024 * OD_IN, (float*)smem) * (1.f / WQ_TOP);
    GemmRegs g; unsigned aoff[4], boff[4];
    float sareg = 0.f; float* sl = (float*)(smem + 73728);
    int rt, ct, rtn = 0, ctn = 0; bool have = dense_tile(0, 30, rt, ct);
    if (have) { lin_off(aoff, rt * 128, 512, 0); lin_off(boff, ct * 128, 512, 0); gemm_prefetch(g, A, aoff, B, boff, 8); if (tid < 128) sareg = WSP(float, O_SAIN)[rt * 128 + tid]; }
    for (int it = 0; have; ++it) {
        const int m0 = rt * 128, n0 = ct * 128;
        f32x16 acc[2][2];
        gemm_run<1>(acc, g, A, aoff, B, boff, 8, (u16*)smem);
        if (tid < 128) sl[tid] = sareg;
        have = dense_tile(it + 1, 30, rtn, ctn);
        if (have) { lin_off(aoff, rtn * 128, 512, 0); lin_off(boff, ctn * 128, 512, 0); gemm_prefetch(g, A, aoff, B, boff, 8); if (tid < 128) sareg = WSP(float, O_SAIN)[rtn * 128 + tid]; }
        __syncthreads();
        dequant_tile(acc, sl, swinv);
        if (ct < 14) epi_store_tile_lds(acc, WSP(u16, O_U1R), RW_IN, m0, n0, T, (u16*)smem);
        else epi_store_tile_lds(acc, WSP(u16, O_U1H), 2048, m0, n0 - RW_IN, T, (u16*)smem);
            rt = rtn; ct = ctn;
    }
}

__device__ __forceinline__ float hgrn_lb(const Params& p, int col) { const float x0 = p.in[25][col], x1 = p.in[25][512 + col]; return 1.f / (1.f + __expf(x0 - x1)); }

__device__ __forceinline__ void phase_hgrnA(const Params& p, unsigned char* smem) {
    WAVE_IDS;
    float* bc = (float*)smem;
    u16* Kst = (u16*)(smem + 33280);
    u16* Vtl = (u16*)(smem + 33280 + 18432);
    const u16* U = WSP(u16, O_U1H);
    int* qb = (int*)(smem + 73728 + 1024);
    for (;;) {
        if (tid == 0) *qb = (int)atomicAdd(WSP(unsigned, 0) + HGA_CTR_W, 1u);
        __syncthreads();
        const int item = *qb;
        __syncthreads();
        if (item >= 2048) break;
        const int c = item & 63, bh = item >> 6, b = bh >> 2, hh = bh & 3, t0 = b * SEQ + c * 64;
#pragma unroll
        for (int i = 0; i < 4; ++i) {
            const int ch = tid + 256 * i, t = ch >> 4, d8 = (ch & 15) * 8;
            const u32x4 zv = *(const u32x4*)(U + (size_t)(t0 + t) * 2048 + 512 + hh * 128 + d8);
            const u32x4 v = *(const u32x4*)(U + (size_t)(t0 + t) * 2048 + 1024 + hh * 128 + d8);
#pragma unroll
            for (int q = 0; q < 4; ++q) {
                const float lb0 = hgrn_lb(p, hh * 128 + d8 + 2 * q), lb1 = hgrn_lb(p, hh * 128 + d8 + 2 * q + 1);
                bc[t * 129 + d8 + 2 * q] = __logf(lb0 + (1.f - lb0) * sigmoidf_(bflo(zv[q])));
                bc[t * 129 + d8 + 2 * q + 1] = __logf(lb1 + (1.f - lb1) * sigmoidf_(bfhi(zv[q])));
                Vtl[(d8 + 2 * q) * LSTR + t] = (u16)(v[q] & 0xffff); Vtl[(d8 + 2 * q + 1) * LSTR + t] = (u16)(v[q] >> 16);
            }
        }
        __syncthreads();
        { const int d = tid & 127, half = tid >> 7; float run = 0.f;
          for (int t = half * 32; t < half * 32 + 32; ++t) { run += bc[t * 129 + d]; bc[t * 129 + d] = run; }
          __syncthreads();
          if (half) { const float add = bc[31 * 129 + d]; for (int t = 32; t < 64; ++t) bc[t * 129 + d] += add; }
          __syncthreads();
          if (tid < 128) WSP(float, O_HD)[(size_t)item * 128 + d] = __expf(bc[63 * 129 + d]); }
#pragma unroll
        for (int i = 0; i < 4; ++i) {
            const int ch = tid + 256 * i, t = ch >> 4, d8 = (ch & 15) * 8;
            const u32x4 zv = *(const u32x4*)(U + (size_t)(t0 + t) * 2048 + 512 + hh * 128 + d8);
#pragma unroll
            for (int q = 0; q < 4; ++q) {
                const int d0 = d8 + 2 * q;
                const float lb0 = hgrn_lb(p, hh * 128 + d0), lb1 = hgrn_lb(p, hh * 128 + d0 + 1);
                const float f0 = lb0 + (1.f - lb0) * sigmoidf_(bflo(zv[q])), f1 = lb1 + (1.f - lb1) * sigmoidf_(bfhi(zv[q]));
                Kst[d0 * LSTR + t] = f2bf((1.f - f0) * __expf(bc[63 * 129 + d0] - bc[t * 129 + d0]));
                Kst[(d0 + 1) * LSTR + t] = f2bf((1.f - f1) * __expf(bc[63 * 129 + d0 + 1] - bc[t * 129 + d0 + 1]));
            }
        }
        __syncthreads();
        f32x16 acc[2][2];
#pragma unroll
        for (int m = 0; m < 2; ++m)
#pragma unroll
            for (int n = 0; n < 2; ++n)
#pragma unroll
                for (int r = 0; r < 16; ++r) acc[m][n][r] = 0.f;
#pragma unroll
        for (int s = 0; s < 4; ++s) {
            const bf16x8 a0 = *(const bf16x8*)(Vtl + (wr * 64 + l31) * LSTR + s * 16 + hi * 8), a1 = *(const bf16x8*)(Vtl + (wr * 64 + 32 + l31) * LSTR + s * 16 + hi * 8);
            const bf16x8 b0 = *(const bf16x8*)(Kst + (wc * 64 + l31) * LSTR + s * 16 + hi * 8), b1 = *(const bf16x8*)(Kst + (wc * 64 + 32 + l31) * LSTR + s * 16 + hi * 8);
            acc[0][0] = MFMA(a0, b0, acc[0][0]); acc[0][1] = MFMA(a0, b1, acc[0][1]); acc[1][0] = MFMA(a1, b0, acc[1][0]); acc[1][1] = MFMA(a1, b1, acc[1][1]);
        }
        __syncthreads();
        epi_store_tile_lds(acc, WSP(u16, O_HL) + (size_t)item * 128 * 128, 128, 0, 0, 128, (u16*)smem);
    }
}
__device__ __forceinline__ void phase_hgrnB(const Params& p, unsigned char* smem) {
    int* qb = (int*)(smem + 73728 + 1024);
    for (;;) {
        if (otid() == 0) *qb = (int)atomicAdd(WSP(unsigned, 0) + HGB_CTR_W, 1u);
        __syncthreads();
        const int chunk = *qb;
        __syncthreads();
        if (chunk >= 512) break;
        const int id = chunk * 256 + otid();
        {
        const int bh = id >> 12, q = id & 4095, e = q >> 5, d4 = (q & 31) * 4;
        u16* base = WSP(u16, O_HL) + (size_t)bh * 64 * 16384 + e * 128 + d4;
        const float* dec = WSP(float, O_HD) + (size_t)bh * 64 * 128 + d4;
        float s0 = 0.f, s1 = 0.f, s2 = 0.f, s3 = 0.f;
        for (int c0 = 0; c0 < 64; c0 += 8) {
            u32x2 lv[8]; f32x4 dv[8];
#pragma unroll
            for (int i = 0; i < 8; ++i) { lv[i] = *(const u32x2*)(base + (size_t)(c0 + i) * 16384); dv[i] = *(const f32x4*)(dec + (size_t)(c0 + i) * 128); }
#pragma unroll
            for (int i = 0; i < 8; ++i) {
                u32x2 o; o[0] = cvtpk(s0, s1); o[1] = cvtpk(s2, s3);
                *(u32x2*)(base + (size_t)(c0 + i) * 16384) = o;
                s0 = dv[i][0] * s0 + bflo(lv[i][0]); s1 = dv[i][1] * s1 + bfhi(lv[i][0]); s2 = dv[i][2] * s2 + bflo(lv[i][1]); s3 = dv[i][3] * s3 + bfhi(lv[i][1]);
            }
        }
    }
    }
}
__device__ __forceinline__ void phase_hgrnC(const Params& p, unsigned char* smem) {
    WAVE_IDS;
    float* ssq = (float*)smem;
    u16* Qt = (u16*)(smem + 1024);
    u16* Kt = (u16*)(smem + 1024 + 17408);
    u16* Vtl = (u16*)(smem + 1024 + 34816);
    float* bc = (float*)(smem + 1024 + 34816);
    const u16* U = WSP(u16, O_U1H);
    int* qb = (int*)(smem + 73728 + 1024);
    for (;;) {
        if (tid == 0) *qb = (int)atomicAdd(WSP(unsigned, 0) + HGC_CTR_W, 1u);
        __syncthreads();
        const int item = *qb;
        __syncthreads();
        if (item >= 2048) break;
        const int c = item & 63, bh = item >> 6, b = bh >> 2, hh = bh & 3, t0 = b * SEQ + c * 64;
#pragma unroll
        for (int i = 0; i < 4; ++i) {
            const int ch = tid + 256 * i, t = ch >> 4, d8 = (ch & 15) * 8;
            const u32x4 zv = *(const u32x4*)(U + (size_t)(t0 + t) * 2048 + 512 + hh * 128 + d8);
#pragma unroll
            for (int q = 0; q < 4; ++q) {
                const float lb0 = hgrn_lb(p, hh * 128 + d8 + 2 * q), lb1 = hgrn_lb(p, hh * 128 + d8 + 2 * q + 1);
                bc[t * 129 + d8 + 2 * q] = __logf(lb0 + (1.f - lb0) * sigmoidf_(bflo(zv[q])));
                bc[t * 129 + d8 + 2 * q + 1] = __logf(lb1 + (1.f - lb1) * sigmoidf_(bfhi(zv[q])));
            }
        }
        __syncthreads();
        { const int d = tid & 127, half = tid >> 7; float run = 0.f;
          for (int t = half * 32; t < half * 32 + 32; ++t) { run += bc[t * 129 + d]; bc[t * 129 + d] = run; }
          __syncthreads();
          if (half) { const float add = bc[31 * 129 + d]; for (int t = 32; t < 64; ++t) bc[t * 129 + d] += add; }
          __syncthreads(); }
        u32x4 vreg[4];
#pragma unroll
        for (int i = 0; i < 4; ++i) {
            const int ch = tid + 256 * i, t = ch >> 4, d8 = (ch & 15) * 8;
            const u32x4 zv = *(const u32x4*)(U + (size_t)(t0 + t) * 2048 + 512 + hh * 128 + d8);
            const u32x4 qv = *(const u32x4*)(U + (size_t)(t0 + t) * 2048 + hh * 128 + d8);
            vreg[i] = *(const u32x4*)(U + (size_t)(t0 + t) * 2048 + 1024 + hh * 128 + d8);
            u32x4 qo, ko;
#pragma unroll
            for (int q = 0; q < 4; ++q) {
                const int d0 = d8 + 2 * q;
                const float lb0 = hgrn_lb(p, hh * 128 + d0), lb1 = hgrn_lb(p, hh * 128 + d0 + 1);
                const float f0 = lb0 + (1.f - lb0) * sigmoidf_(bflo(zv[q])), f1 = lb1 + (1.f - lb1) * sigmoidf_(bfhi(zv[q]));
                const float b0 = bc[t * 129 + d0], b1 = bc[t * 129 + d0 + 1];
                qo[q] = cvtpk(siluf_(bflo(qv[q])) * __expf(b0), siluf_(bfhi(qv[q])) * __expf(b1));
                ko[q] = cvtpk((1.f - f0) * __expf(-b0), (1.f - f1) * __expf(-b1));
            }
            *(u32x4*)(Qt + t * 136 + d8) = qo; *(u32x4*)(Kt + t * 136 + d8) = ko;
        }
        __syncthreads();
#pragma unroll
        for (int i = 0; i < 4; ++i) {
            const int ch = tid + 256 * i, t = ch >> 4, e8 = (ch & 15) * 8;
#pragma unroll
            for (int q = 0; q < 4; ++q) { Vtl[(e8 + 2 * q) * 68 + t] = (u16)(vreg[i][q] & 0xffff); Vtl[(e8 + 2 * q + 1) * 68 + t] = (u16)(vreg[i][q] >> 16); }
        }
        __syncthreads();
        f32x16 pt[2][2];
#pragma unroll
        for (int a = 0; a < 2; ++a)
#pragma unroll
            for (int c2 = 0; c2 < 2; ++c2)
#pragma unroll
                for (int r = 0; r < 16; ++r) pt[a][c2][r] = 0.f;
#pragma unroll
        for (int s = 0; s < 8; ++s) {
            const bf16x8 k0 = *(const bf16x8*)(Kt + l31 * 136 + s * 16 + hi * 8), k1 = *(const bf16x8*)(Kt + (32 + l31) * 136 + s * 16 + hi * 8);
            const bf16x8 q0 = *(const bf16x8*)(Qt + l31 * 136 + s * 16 + hi * 8), q1 = *(const bf16x8*)(Qt + (32 + l31) * 136 + s * 16 + hi * 8);
            pt[0][0] = MFMA(k0, q0, pt[0][0]); pt[0][1] = MFMA(k0, q1, pt[0][1]); pt[1][0] = MFMA(k1, q0, pt[1][0]); pt[1][1] = MFMA(k1, q1, pt[1][1]);
        }
        bf16x8 pb[2][4];
#pragma unroll
        for (int tt = 0; tt < 2; ++tt)
#pragma unroll
            for (int st = 0; st < 2; ++st) {
                float v[16];
#pragma unroll
                for (int r = 0; r < 16; ++r) { const int sidx = st * 32 + crow(r, hi), tidx = tt * 32 + l31; v[r] = (sidx <= tidx) ? pt[st][tt][r] : 0.f; }
                u32x4 w; w[0] = cvtpk(v[0], v[1]); w[1] = cvtpk(v[2], v[3]); w[2] = cvtpk(v[4], v[5]); w[3] = cvtpk(v[6], v[7]); pb[tt][st * 2] = __builtin_bit_cast(bf16x8, w);
                w[0] = cvtpk(v[8], v[9]); w[1] = cvtpk(v[10], v[11]); w[2] = cvtpk(v[12], v[13]); w[3] = cvtpk(v[14], v[15]); pb[tt][st * 2 + 1] = __builtin_bit_cast(bf16x8, w);
            }
        f32x16 o[2];
#pragma unroll
        for (int r = 0; r < 16; ++r) { o[0][r] = 0.f; o[1][r] = 0.f; }
        const u16* ST = WSP(u16, O_HL) + (size_t)item * 16384 + (size_t)(wid * 32 + l31) * 128;
#pragma unroll
        for (int s = 0; s < 8; ++s) {
            const bf16x8 a = *(const bf16x8*)(ST + s * 16 + hi * 8);
            const bf16x8 q0 = *(const bf16x8*)(Qt + l31 * 136 + s * 16 + hi * 8), q1 = *(const bf16x8*)(Qt + (32 + l31) * 136 + s * 16 + hi * 8);
            o[0] = MFMA(a, q0, o[0]); o[1] = MFMA(a, q1, o[1]);
        }
#pragma unroll
        for (int s = 0; s < 4; ++s) {
            const u16* vp = Vtl + (wid * 32 + l31) * 68 + 16 * s + 4 * hi;
            const u32x2 lo = *(const u32x2*)vp, h2 = *(const u32x2*)(vp + 8);
            const u32x4 w = {lo[0], lo[1], h2[0], h2[1]};
            o[0] = MFMA(__builtin_bit_cast(bf16x8, w), pb[0][s], o[0]); o[1] = MFMA(__builtin_bit_cast(bf16x8, w), pb[1][s], o[1]);
        }
#pragma unroll
        for (int tt = 0; tt < 2; ++tt) { float s2 = 0.f;
#pragma unroll
            for (int r = 0; r < 16; ++r) s2 += o[tt][r] * o[tt][r];
            s2 = xhalf_sum(s2);
            if (hi == 0) ssq[wid * 64 + tt * 32 + l31] = s2; }
        __syncthreads();
#pragma unroll
        for (int tt = 0; tt < 2; ++tt) {
            const int t = tt * 32 + l31;
            const float rs = rsqrtf((ssq[t] + ssq[64 + t] + ssq[128 + t] + ssq[192 + t]) * (1.f / 128.f) + EPS);
#pragma unroll
            for (int rg = 0; rg < 4; ++rg) {
                const int e = wid * 32 + 8 * rg + 4 * hi;
                const u32x2 gv = *(const u32x2*)(U + (size_t)(t0 + t) * 2048 + 1536 + hh * 128 + e);
                const f32x4 on = *(const f32x4*)(p.in[26] + hh * 128 + e);
                u32x2 w; w[0] = cvtpk(o[tt][4 * rg] * rs * on[0] * siluf_(bflo(gv[0])), o[tt][4 * rg + 1] * rs * on[1] * siluf_(bfhi(gv[0])));
                w[1] = cvtpk(o[tt][4 * rg + 2] * rs * on[2] * siluf_(bflo(gv[1])), o[tt][4 * rg + 3] * rs * on[3] * siluf_(bfhi(gv[1])));
                *(u32x2*)(WSP(u16, O_HA) + (size_t)(t0 + t) * 1024 + 512 + hh * 128 + e) = w;
            }
        }
        __syncthreads();
    }
}

__device__ __forceinline__ void phase_rwkv_prep(const Params& p) {
    const int lane = otid() & 63, wv = blockIdx.x * 4 + (otid() >> 6), nw = gridDim.x * 4;
    const u16* U = WSP(u16, O_U1R); const float* mu = p.in[14];
    for (int t = wv; t < T; t += nw) {
        const bool first = (t & (SEQ - 1)) == 0;
        { const int c = 1536 + lane * 4;
          const u32x2 a = *(const u32x2*)(U + (size_t)t * RW_IN + c); u32x2 pv = {0u, 0u}; if (!first) pv = *(const u32x2*)(U + (size_t)(t - 1) * RW_IN + c);
          const f32x4 m = *(const f32x4*)(mu + c);
          float x[4] = {bflo(a[0]), bfhi(a[0]), bflo(a[1]), bfhi(a[1])}; const float q[4] = {bflo(pv[0]), bfhi(pv[0]), bflo(pv[1]), bfhi(pv[1])};
#pragma unroll
          for (int j = 0; j < 4; ++j) { x[j] = x[j] + (q[j] - x[j]) * m[j];
              if (lane < 16) x[j] = tanhf(x[j]); else if (lane >= 32) x[j] = sigmoidf_(x[j]); }
          u32x2 o; o[0] = cvtpk(x[0], x[1]); o[1] = cvtpk(x[2], x[3]);
          *(u32x2*)(WSP(u16, O_LORA) + (size_t)t * 256 + lane * 4) = o; }
    }
}
__device__ __forceinline__ void phase_rwkv_lora(const Params& p, unsigned char* smem) {
    WAVE_IDS;
    const u16* A = WSP(u16, O_LORA);
    int rt, c12;
    for (int it = 0; dense_tile(it, 12, rt, c12); ++it) {
        const int which = c12 >> 2, ct = c12 & 3, m0 = rt * 128, n0 = ct * 128;
        unsigned aoff[4], boff[4];
        lin_off(aoff, m0, 256, which == 0 ? 0 : (which == 1 ? 64 : 128));
        const int K = which == 2 ? 128 : 64;
        lin_off(boff, n0, K, 0);
        f32x16 acc[2][2];
        gemm_mainloop(acc, A, aoff, WSP(u16, which == 0 ? O_W2T : (which == 1 ? O_A2T : O_G2T)), boff, K / 64, (u16*)smem);
        u16* dst = WSP(u16, which == 0 ? O_WD16 : (which == 1 ? O_AA16 : O_GG16));
#pragma unroll
        for (int m = 0; m < 2; ++m)
#pragma unroll
            for (int n = 0; n < 2; ++n) {
                const int col = n0 + wc * 64 + n * 32 + l31;
                const float bias = which == 0 ? p.in[15][col] : (which == 1 ? p.in[17][col] : 0.f);
#pragma unroll
                for (int r = 0; r < 16; ++r) {
                    float v = acc[m][n][r] + bias;
                    if (which == 0) v = __expf(-0.6065306597f * sigmoidf_(v));
                    else if (which == 1) v = sigmoidf_(v);
                    acc[m][n][r] = v;
                }
            }
        lds_put16<true>(acc, (u16*)smem, wr, wc, l31, hi);
        __syncthreads();
        lds_rows_store<16>((const u16*)smem, [=](int row, int cc) -> u16* { return dst + (size_t)(m0 + row) * 512 + n0 + cc * 8; });
        __syncthreads();
    }
}
#define DPP_ADD(x, ctrl) x += __builtin_bit_cast(float, __builtin_amdgcn_update_dpp(0, __builtin_bit_cast(int, x), ctrl, 0xf, 0xf, false))
__device__ __forceinline__ void sum32x2(float& a, float& b) {
    DPP_ADD(a, 0x128); DPP_ADD(b, 0x128); DPP_ADD(a, 0x124); DPP_ADD(b, 0x124);
    DPP_ADD(a, 0x122); DPP_ADD(b, 0x122); DPP_ADD(a, 0x121); DPP_ADD(b, 0x121);
    auto ra = __builtin_amdgcn_permlane16_swap(__float_as_uint(a), __float_as_uint(a), false, false);
    auto rb = __builtin_amdgcn_permlane16_swap(__float_as_uint(b), __float_as_uint(b), false, false);
    a = __uint_as_float(ra[0]) + __uint_as_float(ra[1]); b = __uint_as_float(rb[0]) + __uint_as_float(rb[1]);
}
__device__ __forceinline__ void sum16x2(float& a, float& b) {
    DPP_ADD(a, 0x128); DPP_ADD(b, 0x128); DPP_ADD(a, 0x124); DPP_ADD(b, 0x124);
    DPP_ADD(a, 0x122); DPP_ADD(b, 0x122); DPP_ADD(a, 0x121); DPP_ADD(b, 0x121);
}
__device__ __forceinline__ float sum16(float a) { DPP_ADD(a, 0x128); DPP_ADD(a, 0x124); DPP_ADD(a, 0x122); DPP_ADD(a, 0x121); return a; }
template <bool INNER>
__device__ __forceinline__ void phase_rwkv_rec(const Params& p, unsigned char* smem, const XcdBarrier& bar) {
    const int tid = otid(), lane = tid & 63, wid = tid >> 6, rowl = lane >> 4, j = lane & 15;
    constexpr int CH = 16;
    constexpr int BUF = CH * 6 * 64 * 4;
    int* bcast = (int*)(smem + 2 * BUF);
    unsigned* ctrl = WSP(unsigned, 0);
    if (INNER && p.solo) {
        phase_hgrnA(p, smem); xcd_barrier(bar); phase_hgrnB(p, smem); xcd_barrier(bar); phase_hgrnC(p, smem);
    }
    if (tid == 0) {
        const unsigned hw = (unsigned)__builtin_amdgcn_s_getreg((7 << 11) | (8 << 6) | 4);
        const unsigned key = (((unsigned)__builtin_amdgcn_s_getreg((3 << 11) | 20) & 0xFu) << 8) | (hw & 0xffu);
        bcast[0] = (int)atomicAdd(&ctrl[PERCU_W + key], 1u);
    }
    __syncthreads();
    const bool worker = bcast[0] == 0 || (INNER && p.solo);
    __syncthreads();
    if (!worker) {
        if (INNER) { phase_hgrnA(p, smem); xcd_barrier(bar); phase_hgrnB(p, smem); xcd_barrier(bar); phase_hgrnC(p, smem); }
        return;
    }
    int nbar = (INNER && p.solo) ? 2 : 0;
    __builtin_amdgcn_s_setprio(3);
    const u16* U = WSP(u16, O_U1R); const float* mu = p.in[14];
    for (;;) {
        if (tid == 0) bcast[0] = (int)atomicAdd(&ctrl[RWKV_TICKET_W], 1u);
        __syncthreads();
        const int item = bcast[0];
        __syncthreads();
        if (item >= 256) break;
        const int bh = item >> 2, rgp = item & 3, b = bh >> 3, h8 = bh & 7;
        const int row = rgp * 16 + wid * 4 + rowl;
        const size_t tb0 = (size_t)b * SEQ;
        const int ss_ = tid >> 4, k4 = (tid & 15) * 4;
        float mrv[4], mkv[4], mvv[4], kav[4], kkv[4];
#pragma unroll
        for (int q = 0; q < 4; ++q) { mrv[q] = mu[h8 * 64 + k4 + q]; mkv[q] = mu[512 + h8 * 64 + k4 + q]; mvv[q] = mu[1024 + h8 * 64 + k4 + q]; kav[q] = p.in[21][h8 * 64 + k4 + q]; kkv[q] = p.in[20][h8 * 64 + k4 + q]; }
        u32x2 r_c, k_c, v_c, r_p, k_p, v_p, w_c, a_c;
        auto sload = [&](int ch) {
            const int tl = ch * CH + ss_; const size_t t = tb0 + tl;
            const u16* ur = U + t * RW_IN + h8 * 64 + k4;
            r_c = *(const u32x2*)ur; k_c = *(const u32x2*)(ur + 512); v_c = *(const u32x2*)(ur + 1024);
            r_p = (u32x2){0u, 0u}; k_p = r_p; v_p = r_p;
            if (tl > 0) { r_p = *(const u32x2*)(ur - RW_IN); k_p = *(const u32x2*)(ur - RW_IN + 512); v_p = *(const u32x2*)(ur - RW_IN + 1024); }
            w_c = *(const u32x2*)(WSP(h16, O_WD16) + t * 512 + h8 * 64 + k4);
            a_c = *(const u32x2*)(WSP(h16, O_AA16) + t * 512 + h8 * 64 + k4);
        };
        auto swrite = [&](int buf) {
            const h16* wh = (const h16*)&w_c; const h16* ah = (const h16*)&a_c;
            float* bb = (float*)(smem + buf * BUF) + ss_ * 384 + k4;
            float rr[4], kk_[4], vv[4];
#pragma unroll
            for (int q = 0; q < 2; ++q) {
                float x0 = bflo(r_c[q]), x1 = bfhi(r_c[q]); rr[2 * q] = x0 + (bflo(r_p[q]) - x0) * mrv[2 * q]; rr[2 * q + 1] = x1 + (bfhi(r_p[q]) - x1) * mrv[2 * q + 1];
                x0 = bflo(k_c[q]); x1 = bfhi(k_c[q]); kk_[2 * q] = x0 + (bflo(k_p[q]) - x0) * mkv[2 * q]; kk_[2 * q + 1] = x1 + (bfhi(k_p[q]) - x1) * mkv[2 * q + 1];
                x0 = bflo(v_c[q]); x1 = bfhi(v_c[q]); vv[2 * q] = x0 + (bflo(v_p[q]) - x0) * mvv[2 * q]; vv[2 * q + 1] = x1 + (bfhi(v_p[q]) - x1) * mvv[2 * q + 1];
            }
            float kn[4]; float ssq = 0.f;
#pragma unroll
            for (int q = 0; q < 4; ++q) { kn[q] = kk_[q] * kkv[q]; ssq += kn[q] * kn[q]; }
            ssq = sum16(ssq);
            const float rn = rsqrtf(fmaxf(ssq, 1e-24f));
            f32x4 ow, on, ob, ok;
#pragma unroll
            for (int q = 0; q < 4; ++q) { const float a = (float)ah[q], n = kn[q] * rn; ow[q] = (float)wh[q]; on[q] = -n; ob[q] = n * a; ok[q] = kk_[q] * (1.f + (a - 1.f) * kav[q]); }
            *(f32x4*)(bb) = ow; *(f32x4*)(bb + 64) = on; *(f32x4*)(bb + 128) = ob; *(f32x4*)(bb + 192) = ok;
            *(f32x4*)(bb + 256) = (f32x4){rr[0], rr[1], rr[2], rr[3]}; *(f32x4*)(bb + 320) = (f32x4){vv[0], vv[1], vv[2], vv[3]};
        };
        sload(0); swrite(0);
        __syncthreads();
        f32x4 S = {0.f, 0.f, 0.f, 0.f};
        float ykeep = 0.f;
        for (int ch = 0; ch < SEQ / CH; ++ch) {
            const int cur = ch & 1;
            if (INNER && nbar < 2 && ch == (nbar == 0 ? 75 : 155)) { xcd_barrier(bar); ++nbar; }
            if (ch + 1 < SEQ / CH) sload(ch + 1);
            __builtin_amdgcn_sched_barrier(0);
            const float* bb = (const float*)(smem + cur * BUF) + j * 4;
            const float* vs = (const float*)(smem + cur * BUF) + 320 + row;
#define RW_LOAD(W, N, B_, K_, R, V, S_) { const float* q = bb + (S_) * 384; W = *(const f32x4*)q; N = *(const f32x4*)(q + 64); B_ = *(const f32x4*)(q + 128); K_ = *(const f32x4*)(q + 192); R = *(const f32x4*)(q + 256); V = vs[(S_) * 384]; }
#define RW_STEP(W, N, B_, K_, R, V, S_) { \
                float pa = S[0] * N[0]; pa = fmaf(S[1], N[1], pa); pa = fmaf(S[2], N[2], pa); pa = fmaf(S[3], N[3], pa); \
                if ((S_) > 0) { sum16x2(pa, pbk); ykeep = (j == (S_) - 1) ? pbk : ykeep; } else pa = sum16(pa); \
                S[0] = fmaf(pa, B_[0], fmaf(S[0], W[0], V * K_[0])); S[1] = fmaf(pa, B_[1], fmaf(S[1], W[1], V * K_[1])); \
                S[2] = fmaf(pa, B_[2], fmaf(S[2], W[2], V * K_[2])); S[3] = fmaf(pa, B_[3], fmaf(S[3], W[3], V * K_[3])); \
                pbk = S[0] * R[0]; pbk = fmaf(S[1], R[1], pbk); pbk = fmaf(S[2], R[2], pbk); pbk = fmaf(S[3], R[3], pbk); }
            f32x4 aw, an, ab, ak, ar, bw, bn, bb_, bk, br; float av, bv, pbk = 0.f;
            RW_LOAD(aw, an, ab, ak, ar, av, 0);
#pragma unroll
            for (int s = 0; s < CH; s += 2) {
                RW_LOAD(bw, bn, bb_, bk, br, bv, s + 1);
                RW_STEP(aw, an, ab, ak, ar, av, s);
                if (s + 2 < CH) { RW_LOAD(aw, an, ab, ak, ar, av, s + 2); }
                RW_STEP(bw, bn, bb_, bk, br, bv, s + 1);
            }
            pbk = sum16(pbk); ykeep = (j == CH - 1) ? pbk : ykeep;
            WSP(u16, O_YRAW)[(tb0 + ch * CH + j) * 512 + h8 * 64 + row] = f2bf(ykeep);
            __builtin_amdgcn_sched_barrier(0);
            if (ch + 1 < SEQ / CH) swrite(cur ^ 1);
            __syncthreads();
        }
    }
    __builtin_amdgcn_s_setprio(0);
    if (INNER) { while (nbar < 2) { xcd_barrier(bar); ++nbar; } }
}
__device__ __forceinline__ void phase_rwkv_fin(const Params& p) {
    const int lane = otid() & 63, wv = blockIdx.x * 4 + (otid() >> 6), nw = gridDim.x * 4;
    const u16* U = WSP(u16, O_U1R); const float* mu = p.in[14];
    const int c = lane * 8;
    float lw[8], lbv[8], rk[8], ka[8], mr[8], mk[8], mv[8];
#pragma unroll
    for (int q = 0; q < 8; ++q) { lw[q] = p.in[23][c + q]; lbv[q] = p.in[24][c + q]; rk[q] = p.in[22][c + q]; ka[q] = p.in[21][c + q]; mr[q] = mu[c + q]; mk[q] = mu[512 + c + q]; mv[q] = mu[1024 + c + q]; }
    for (int t = wv; t < T; t += nw) {
        const bool first = (t & (SEQ - 1)) == 0;
        const u16* ur = U + (size_t)t * RW_IN + c;
        const u32x4 r_c = *(const u32x4*)ur, k_c = *(const u32x4*)(ur + 512), v_c = *(const u32x4*)(ur + 1024);
        u32x4 r_p = {0u, 0u, 0u, 0u}, k_p = r_p, v_p = r_p;
        if (!first) { r_p = *(const u32x4*)(ur - RW_IN); k_p = *(const u32x4*)(ur - RW_IN + 512); v_p = *(const u32x4*)(ur - RW_IN + 1024); }
        const u32x4 a_c = *(const u32x4*)(WSP(h16, O_AA16) + (size_t)t * 512 + c), g_c = *(const u32x4*)(WSP(h16, O_GG16) + (size_t)t * 512 + c);
        const u32x4 y_c = *(const u32x4*)(WSP(u16, O_YRAW) + (size_t)t * 512 + c);
        const h16* ah = (const h16*)&a_c; const h16* gh = (const h16*)&g_c;
        float y[8], vv[8]; float sm = 0.f, bon = 0.f;
#pragma unroll
        for (int q = 0; q < 4; ++q) {
            y[2 * q] = bflo(y_c[q]); y[2 * q + 1] = bfhi(y_c[q]); sm += y[2 * q] + y[2 * q + 1];
            float x0 = bflo(r_c[q]), x1 = bfhi(r_c[q]); const float r0 = x0 + (bflo(r_p[q]) - x0) * mr[2 * q], r1 = x1 + (bfhi(r_p[q]) - x1) * mr[2 * q + 1];
            x0 = bflo(k_c[q]); x1 = bfhi(k_c[q]); float k0 = x0 + (bflo(k_p[q]) - x0) * mk[2 * q], k1 = x1 + (bfhi(k_p[q]) - x1) * mk[2 * q + 1];
            k0 *= 1.f + ((float)ah[2 * q] - 1.f) * ka[2 * q]; k1 *= 1.f + ((float)ah[2 * q + 1] - 1.f) * ka[2 * q + 1];
            x0 = bflo(v_c[q]); x1 = bfhi(v_c[q]); vv[2 * q] = x0 + (bflo(v_p[q]) - x0) * mv[2 * q]; vv[2 * q + 1] = x1 + (bfhi(v_p[q]) - x1) * mv[2 * q + 1];
            bon += r0 * k0 * rk[2 * q] + r1 * k1 * rk[2 * q + 1];
        }
        sm += __shfl_xor(sm, 1); sm += __shfl_xor(sm, 2); sm += __shfl_xor(sm, 4);
        bon += __shfl_xor(bon, 1); bon += __shfl_xor(bon, 2); bon += __shfl_xor(bon, 4);
        const float mean = sm * (1.f / 64.f);
        float var = 0.f;
#pragma unroll
        for (int q = 0; q < 8; ++q) { const float dd = y[q] - mean; var += dd * dd; }
        var += __shfl_xor(var, 1); var += __shfl_xor(var, 2); var += __shfl_xor(var, 4);
        const float rs = rsqrtf(var * (1.f / 64.f) + 64e-5f);
        float o[8];
#pragma unroll
        for (int q = 0; q < 8; ++q) o[q] = ((y[q] - mean) * rs * lw[q] + lbv[q] + bon * vv[q]) * (float)gh[q];
        u32x4 w; w[0] = cvtpk(o[0], o[1]); w[1] = cvtpk(o[2], o[3]); w[2] = cvtpk(o[4], o[5]); w[3] = cvtpk(o[6], o[7]);
        *(u32x4*)(WSP(u16, O_HA) + (size_t)t * 1024 + c) = w;
    }
}

#ifndef REPEAT_MASK
#define REPEAT_MASK 0
#endif
#if MEGA
constexpr int NPHASE = 19;
#else
constexpr int NPHASE = 24;
#endif
template <int PH> __device__ __forceinline__ void run_phase(const Params& p, unsigned char* smem, const XcdBarrier& bar) {
    if constexpr (PH == 0) phase_prologue(p, smem);
    else if constexpr (PH == 1) phase_inproj0(p, smem);
    else if constexpr (PH == 2) phase_upproj(p, smem);
    else if constexpr (PH == 3) phase_attn(p, smem);
    else if constexpr (PH == 4) phase_outproj(p, smem, 0);
    else if constexpr (PH == 5) phase_route(p, smem, 0);
    else if constexpr (PH == 6) phase_moe1(p, smem, 0);
    else if constexpr (PH == 7) phase_moe2(p, smem, 0);
    else if constexpr (PH == 8) phase_combine(p, smem, 0);
    else if constexpr (PH == 9) phase_inproj1(p, smem);
    else if constexpr (PH == 10) phase_rwkv_prep(p);
    else if constexpr (PH == 11) phase_rwkv_lora(p, smem);
#if MEGA
    else if constexpr (PH == 12) phase_rwkv_rec<true>(p, smem, bar);
    else if constexpr (PH == 13) phase_rwkv_fin(p);
    else if constexpr (PH == 14) phase_outproj(p, smem, 1);
    else if constexpr (PH == 15) phase_route(p, smem, 1);
    else if constexpr (PH == 16) phase_moe1(p, smem, 1);
    else if constexpr (PH == 17) phase_moe2(p, smem, 1);
    else if constexpr (PH == 18) phase_combine(p, smem, 1);
#else
    else if constexpr (PH == 13) phase_hgrnA(p, smem);
    else if constexpr (PH == 14) phase_hgrnB(p, smem);
    else if constexpr (PH == 15) phase_hgrnC(p, smem);
    else if constexpr (PH == 16) phase_rwkv_rec<false>(p, smem, bar);
    else if constexpr (PH == 17) phase_rwkv_fin(p);
    else if constexpr (PH == 18) phase_outproj(p, smem, 1);
    else if constexpr (PH == 19) phase_route(p, smem, 1);
    else if constexpr (PH == 20) phase_lists(p, smem, 1);
    else if constexpr (PH == 21) phase_moe1(p, smem, 1);
    else if constexpr (PH == 22) phase_moe2(p, smem, 1);
    else if constexpr (PH == 23) phase_combine(p, 1);
#endif
}

template <int PH> __global__ void __launch_bounds__(256, 2) k_phase(Params p) {
    __shared__ __attribute__((aligned(16))) unsigned char smem[SMEM_BYTES];
    run_phase<PH>(p, smem);
}


#if MEGA
template <int PH> __device__ __forceinline__ void run_all(const Params& p, unsigned char* smem, const XcdBarrier& bar) {
    run_phase<PH>(p, smem, bar);
    if constexpr (((REPEAT_MASK >> PH) & 1) != 0) { xcd_barrier(bar); run_phase<PH>(p, smem, bar); }
    if constexpr (PH + 1 < NPHASE) { xcd_barrier(bar); run_all<PH + 1>(p, smem, bar); }
}
__global__ void __launch_bounds__(256, 2) k_mega(Params p) {
    __shared__ __attribute__((aligned(16))) unsigned char smem[SMEM_BYTES];
    __shared__ uint4 xb_words;
    if (threadIdx.x == 0) xb_words = make_uint4(0u, 0u, 0u, 0u);
    __syncthreads();
    XcdBarrier bar = xcd_barrier_post((unsigned*)p.ws, (volatile LAS unsigned*)&xb_words);
    run_all<0>(p, smem, bar);
}
#endif
template <int PH> static void launch_phase(const Params& p, hipStream_t stream) {
    hipLaunchKernelGGL((k_phase<PH>), dim3(512), dim3(256), 0, stream, p);
}
template <int... I> static void launch_all(const Params& p, hipStream_t stream, std::integer_sequence<int, I...>) { (launch_phase<I>(p, stream), ...); }

extern "C" void kernel_launch(void* const* d_in, const int* in_sizes, int n_in, void* d_out, int out_size, void* d_ws, size_t ws_size, hipStream_t stream) {
    Params p;
    memset(&p, 0, sizeof(p));
    for (int i = 0; i < 34; ++i) p.in[i] = (const float*)d_in[i];
    p.out = (float*)d_out; p.ws = (unsigned char*)d_ws;
    if (ws_size < WS_TOTAL) { fprintf(stderr, "workspace too small: %zu < %zu\n", ws_size, (size_t)WS_TOTAL); return; }
    (void)hipMemsetAsync(d_ws, 0, CTRL_BYTES, stream);
#if MEGA
    static int grid = 0, solo = 0;
    if (!grid) {
        int dev = 0, cus = 0, per_cu = 0;
        (void)hipGetDevice(&dev);
        (void)hipDeviceGetAttribute(&cus, hipDeviceAttributeMultiprocessorCount, dev);
        (void)hipOccupancyMaxActiveBlocksPerMultiprocessor(&per_cu, k_mega, 256, 0);
        if (per_cu > 2) per_cu = 2;
        if (per_cu < 1) per_cu = 1;
        grid = cus * per_cu;
        if (grid > 512) grid = 512;
        solo = per_cu < 2;
    }
    p.solo = solo;
    hipLaunchKernelGGL(k_mega, dim3(grid), dim3(256), 0, stream, p);
#else
    launch_all(p, stream, std::make_integer_sequence<int, NPHASE>{});
#endif
}
```

```cpp
#include <hip/hip_runtime.h>
#include <stdint.h>
#include <stdio.h>
#include <string.h>
#include <utility>

#ifndef MEGA
#define MEGA 1
#endif

typedef unsigned short u16;
typedef short bf16x8 __attribute__((ext_vector_type(8)));
typedef short s16x4 __attribute__((ext_vector_type(4)));
typedef float f32x16 __attribute__((ext_vector_type(16)));
typedef float f32x4 __attribute__((ext_vector_type(4)));
typedef float f32x2 __attribute__((ext_vector_type(2)));
typedef unsigned u32x4 __attribute__((ext_vector_type(4)));
typedef unsigned u32x2 __attribute__((ext_vector_type(2)));
typedef _Float16 h16;

constexpr int NB = 8, SEQ = 4096, T = NB * SEQ, D = 1024;
constexpr int EV_IN = 2080, EV_INP = 2176;
constexpr int OD_IN = 3840, RW_IN = 1792;
constexpr float EPS = 1e-6f;
constexpr float LOG2E = 1.4426950408889634f;
constexpr float QSCALE_M = 0.10206207261596577f * LOG2E;
constexpr float QSCALE_D = 0.125f * LOG2E;

constexpr size_t CTRL_BYTES = 65536;
constexpr int    ROWSC_LDS = 40960;
constexpr int    RWKV_TICKET_W = 4608;
constexpr int    CONV1_CTR_W = 4672;
constexpr int    CONV0_CTR_W = 4736;
constexpr int    HGA_CTR_W = 4800, HGB_CTR_W = 4864, HGC_CTR_W = 4928;
constexpr int    PERCU_W = 8192;
constexpr int    ATTN_CTR_W = 4096;
constexpr int    CNT_W      = 4352;
constexpr int    AMAX_W     = 4992;
constexpr float  F8_TOP     = 224.f;
constexpr float  V_F8_SCALE = 16.f;
constexpr float  ACT_F8_SCALE = 16.f;
constexpr float  WQ_TOP     = 127.f;
constexpr size_t O_WIN0  = CTRL_BYTES;
constexpr size_t O_WQ    = O_WIN0  + (size_t)EV_INP * 1024 * 2;
constexpr size_t O_WKV   = O_WQ    + (size_t)768 * 256 * 2;
constexpr size_t O_WOUT0 = O_WKV   + (size_t)1024 * 256 * 2;
constexpr size_t O_WIN1  = O_WOUT0 + (size_t)1024 * 1024 * 2;
constexpr size_t O_WOUT1 = O_WIN1  + (size_t)OD_IN * 1024 * 2;
constexpr size_t O_W2T   = O_WOUT1 + (size_t)1024 * 1024 * 2;
constexpr size_t O_A2T   = O_W2T   + (size_t)512 * 64 * 2;
constexpr size_t O_G2T   = O_A2T   + (size_t)512 * 64 * 2;
constexpr size_t O_WR    = O_G2T   + (size_t)512 * 128 * 2;
constexpr size_t O_ROPED = O_WR    + (size_t)2 * 128 * 1024 * 2;
constexpr size_t O_ROPEM = O_ROPED + (size_t)4096 * 32 * 8;
constexpr size_t O_MOEW  = O_ROPEM + (size_t)4096 * 16 * 8;
constexpr size_t O_WGU   = O_MOEW;
constexpr size_t O_WD    = O_WGU + (size_t)32 * 1024 * 1024 * 2;
constexpr size_t MOEW_BYTES = (size_t)32 * 1024 * 1024 * 2 + (size_t)32 * 1024 * 512 * 2;
constexpr size_t O_A12   = O_MOEW;
constexpr size_t O_HL    = O_MOEW;
constexpr size_t O_ACT   = O_MOEW + MOEW_BYTES;
constexpr size_t O_HA    = O_ACT;
constexpr size_t O_CLAT  = O_ACT + (size_t)T * 1024 * 2;
constexpr size_t O_QM    = O_CLAT + (size_t)T * 512 * 2;
constexpr size_t O_KM    = O_QM + (size_t)T * 8 * 96 * 2;
constexpr size_t O_VTM   = O_KM + (size_t)T * 8 * 96 * 2;
constexpr size_t O_QD    = O_VTM + (size_t)T * 512 * 2;
constexpr size_t O_KD    = O_QD + (size_t)T * 512 * 2;
constexpr size_t O_VTD   = O_KD + (size_t)T * 512 * 2;
constexpr size_t ACT_L0_END = O_VTD + (size_t)T * 512 * 2;
constexpr size_t O_YRAW  = ACT_L0_END;
constexpr size_t O_ACTB  = O_ACT + (size_t)T * 1024 * 2;
constexpr size_t O_YSORT = O_ACTB + (size_t)2 * T * 512 * 2;
constexpr size_t O_SEL   = O_YSORT + (size_t)2 * T * 1024 * 2;
constexpr size_t O_GATES = O_SEL + (size_t)T * 16;
constexpr size_t O_TOKROW= O_GATES + (size_t)T * 8;
constexpr size_t O_GATEROW = O_TOKROW + (size_t)2 * T * 4;
constexpr size_t O_ROWTOK= O_GATEROW + (size_t)2 * T * 4;
constexpr size_t O_A8    = O_ACT + (size_t)260 * 1024 * 1024;
constexpr size_t O_SA8   = O_A8 + (size_t)T * 1024;
constexpr size_t O_GSROW = O_SA8 + (size_t)T * 4;
constexpr size_t O_TOK2  = O_GSROW + (size_t)2 * T * 8;
constexpr size_t O_GS2   = O_TOK2 + (size_t)32 * T * 4;
constexpr size_t O_U1R   = O_ACT + (size_t)T * 1024 * 2;
constexpr size_t O_U1H   = O_U1R + (size_t)T * RW_IN * 2;
constexpr size_t O_WD16  = O_MOEW + (size_t)2048 * 128 * 128 * 2;
constexpr size_t O_ATTSCR = ACT_L0_END + (size_t)T * 512 * 2;
constexpr size_t O_LORA  = O_U1H + (size_t)T * 2048 * 2;
constexpr size_t O_AA16  = O_ATTSCR;
constexpr size_t O_GG16  = O_AA16 + (size_t)T * 512 * 2;
constexpr size_t O_HD    = O_GG16 + (size_t)T * 512 * 2;
constexpr size_t O_SAIN  = O_HD + (size_t)2048 * 128 * 4;
constexpr size_t WS_TOTAL = O_SAIN + (size_t)T * 4;


struct Params { const float* in[34]; float* out; unsigned char* ws; int solo; int pad; };

#define WSP(type, off) ((type*)(p.ws + (off)))
#define HB(t) ((u16*)p.out + (size_t)(t) * 2048)

__device__ __forceinline__ int otid() { int z; asm volatile("v_mov_b32 %0, 0" : "=v"(z)); return (int)threadIdx.x + z; }
typedef __bf16 v2bf __attribute__((ext_vector_type(2)));
__device__ __forceinline__ unsigned cvtpk(float lo, float hi) { v2bf v = {(__bf16)lo, (__bf16)hi}; return __builtin_bit_cast(unsigned, v); }
__device__ __forceinline__ u16 f2bf(float x) { return __builtin_bit_cast(u16, (__bf16)x); }
__device__ __forceinline__ float bf2f(u16 b) { return __uint_as_float(((unsigned)b) << 16); }
__device__ __forceinline__ float bflo(unsigned w) { return __uint_as_float(w << 16); }
__device__ __forceinline__ float bfhi(unsigned w) { return __uint_as_float(w & 0xffff0000u); }
__device__ __forceinline__ f32x4 bf4_to_f32(const u32x2 w) { return (f32x4){bflo(w[0]), bfhi(w[0]), bflo(w[1]), bfhi(w[1])}; }
__device__ __forceinline__ int crow(int r, int hi) { return (r & 3) + 8 * (r >> 2) + 4 * hi; }
__device__ __forceinline__ float wave_sum(float v) {
#pragma unroll
    for (int o = 32; o; o >>= 1) v += __shfl_xor(v, o);
    return v;
}
__device__ __forceinline__ float wave_max(float v) {
#pragma unroll
    for (int o = 32; o; o >>= 1) v = fmaxf(v, __shfl_xor(v, o));
    return v;
}
__device__ __forceinline__ float sigmoidf_(float x) { return __builtin_amdgcn_rcpf(1.f + __expf(-x)); }
__device__ __forceinline__ float siluf_(float x) { return x * __builtin_amdgcn_rcpf(1.f + __expf(-x)); }
__device__ __forceinline__ float xhalf_sum(float x) { auto rr = __builtin_amdgcn_permlane32_swap(__float_as_uint(x), __float_as_uint(x), false, false); return __uint_as_float(rr[0]) + __uint_as_float(rr[1]); }
__device__ __forceinline__ float xhalf_max(float x) { auto rr = __builtin_amdgcn_permlane32_swap(__float_as_uint(x), __float_as_uint(x), false, false); return fmaxf(__uint_as_float(rr[0]), __uint_as_float(rr[1])); }
#define MFMA(a, b, c) __builtin_amdgcn_mfma_f32_32x32x16_bf16((a), (b), (c), 0, 0, 0)
typedef int i32x4v __attribute__((ext_vector_type(4)));
typedef int i32x16v __attribute__((ext_vector_type(16)));
typedef int i32x8v __attribute__((ext_vector_type(8)));
__device__ __forceinline__ float f8clamp(float v) { return fminf(fmaxf(v, -448.f), 448.f); }
__device__ __forceinline__ f32x16 mma_f8(const u32x4 alo, const u32x4 ahi, const u32x4 blo, const u32x4 bhi, const f32x16 c) {
    const i32x8v a = __builtin_shufflevector(__builtin_bit_cast(i32x4v, alo), __builtin_bit_cast(i32x4v, ahi), 0, 1, 2, 3, 4, 5, 6, 7);
    const i32x8v b = __builtin_shufflevector(__builtin_bit_cast(i32x4v, blo), __builtin_bit_cast(i32x4v, bhi), 0, 1, 2, 3, 4, 5, 6, 7);
    return __builtin_amdgcn_mfma_scale_f32_32x32x64_f8f6f4(a, b, c, 0, 0, 0, 0, 0, 0);
}
template <int MODE>
__device__ __forceinline__ f32x16 mma(const bf16x8 a, const bf16x8 b, const f32x16 c) {
    if constexpr (MODE == 0) return MFMA(a, b, c);
    else return __builtin_bit_cast(f32x16, __builtin_amdgcn_mfma_i32_32x32x32_i8(__builtin_bit_cast(i32x4v, a), __builtin_bit_cast(i32x4v, b), __builtin_bit_cast(i32x16v, c), 0, 0, 0));
}

#define XB_TMO      128
#define XB_XCNT(j)  (256  + 64 * (j))
#define XB_XSUB(j)  (1280 + 64 * (j))
#define XB_XGEN(j)  (2304 + 64 * (j))
#define XB_TOP      3328
#define XB_TOPGEN   3392
#define XCD_BAR_WORDS 3456
#define XB_SPIN_CAP (1u << 18)
#define LAS __attribute__((address_space(3)))

__device__ __forceinline__ unsigned xb_ld(unsigned* p)              { return __hip_atomic_load(p, __ATOMIC_RELAXED, __HIP_MEMORY_SCOPE_AGENT); }
__device__ __forceinline__ unsigned xb_add(unsigned* p, unsigned v) { return __hip_atomic_fetch_add(p, v, __ATOMIC_RELAXED, __HIP_MEMORY_SCOPE_AGENT); }
__device__ __forceinline__ unsigned xb_xcc_id() { return (unsigned)__builtin_amdgcn_s_getreg((3 << 11) | 20) & 0xFu; }
#define XB_SPIN(cond, bar) do { unsigned _sp = 0; while (cond) { __builtin_amdgcn_s_sleep(1); \
    if ((++_sp & 255u) == 0u) { if (xb_ld(&(bar)[XB_TMO])) break; if (_sp > XB_SPIN_CAP) { atomicAdd(&(bar)[XB_TMO], 1u); break; } } } } while (0)

struct XcdBarrier {
    unsigned* bar; unsigned x;
    volatile LAS unsigned* st;
};

__device__ __forceinline__ XcdBarrier xcd_barrier_post(unsigned* bar, volatile LAS unsigned* st) {
    XcdBarrier b; b.bar = bar; b.x = xb_xcc_id(); b.st = st;
    if (threadIdx.x == 0) (void)xb_add(&bar[XB_XCNT(b.x)], 1u);
    return b;
}
__device__ __forceinline__ void xcd_barrier_complete(unsigned* bar, unsigned x, unsigned& nloc, unsigned& nx) {
    const unsigned G = gridDim.x * gridDim.y * gridDim.z;
    unsigned sum, cnt, mine, sp = 0u;
    for (;;) {
        sum = 0u; cnt = 0u; mine = 0u;
#pragma unroll
        for (unsigned j = 0; j < 16; ++j) { const unsigned c = xb_ld(&bar[XB_XCNT(j)]); sum += c; cnt += (c > 0u) ? 1u : 0u; mine = (j == x) ? c : mine; }
        if (sum == G) break;
        __builtin_amdgcn_s_sleep(1);
        if ((++sp & 255u) == 0u) { if (xb_ld(&bar[XB_TMO])) break; if (sp > XB_SPIN_CAP) { atomicAdd(&bar[XB_TMO], 1u); break; } }
    }
    nloc = mine > 0u ? mine : 1u; nx = cnt > 0u ? cnt : 1u;
}

__device__ __forceinline__ void xcd_barrier(const XcdBarrier& b) {
    asm volatile("s_waitcnt vmcnt(0)" ::: "memory");
    __syncthreads();
    if (threadIdx.x == 0) {
        unsigned* bar = b.bar;
        __builtin_amdgcn_s_waitcnt(0);
        unsigned nloc = b.st[0], nx = b.st[1];
        if (nloc == 0u) { xcd_barrier_complete(bar, b.x, nloc, nx); b.st[0] = nloc; b.st[1] = nx; }
        const unsigned old = xb_add(&bar[XB_XSUB(b.x)], 1u);
        const unsigned gen = old / nloc;
        if (old + 1u == (gen + 1u) * nloc) {
            __builtin_amdgcn_fence(__ATOMIC_RELEASE, "agent");
            asm volatile("s_waitcnt vmcnt(0)" ::: "memory");
            const unsigned og = xb_add(&bar[XB_TOP], 1u);
            const unsigned tg = og / nx;
            if (og + 1u == (tg + 1u) * nx) xb_add(&bar[XB_TOPGEN], 1u);
            else XB_SPIN(xb_ld(&bar[XB_TOPGEN]) == tg, bar);
            __builtin_amdgcn_fence(__ATOMIC_ACQUIRE, "agent");
            xb_add(&bar[XB_XGEN(b.x)], 1u);
            asm volatile("s_waitcnt vmcnt(0)" ::: "memory");
        } else {
            XB_SPIN(xb_ld(&bar[XB_XGEN(b.x)]) == gen, bar);
            __builtin_amdgcn_fence(__ATOMIC_ACQUIRE, "agent");
            asm volatile("s_waitcnt vmcnt(0)" ::: "memory");
        }
    }
    __syncthreads();
}


constexpr int SMEM_BYTES = 75776;
constexpr int LSTR = 72;
constexpr int TILE_E = 128 * LSTR;

struct GemmRegs { u32x4 ra0[4], rb0[4], ra1[4], rb1[4]; };
#define G_LOAD(RA, RB, KT) _Pragma("unroll") for (int i = 0; i < 4; ++i) { RA[i] = *(const u32x4*)(A + aoff[i] + (KT) * 64); RB[i] = *(const u32x4*)(B + boff[i] + (KT) * 64); }
__device__ __forceinline__ void gemm_prefetch(GemmRegs& g, const u16* __restrict__ A, const unsigned (&aoff)[4], const u16* __restrict__ B, const unsigned (&boff)[4], int nk) {
    G_LOAD(g.ra0, g.rb0, 0);
    if (nk > 1) { G_LOAD(g.ra1, g.rb1, 1); }
}
template <int MODE = 0>
__device__ __forceinline__ void gemm_run(f32x16 (&acc)[2][2], GemmRegs& g, const u16* __restrict__ A, const unsigned (&aoff)[4],
                                         const u16* __restrict__ B, const unsigned (&boff)[4], int nk, u16* smem) {
    const int tid = otid(), lane = tid & 63, wid = tid >> 6, wr = wid >> 1, wc = wid & 1, l31 = lane & 31, hi = lane >> 5;
    u16* As = smem; u16* Bs = smem + 2 * TILE_E;
    const int st_off = (tid >> 3) * LSTR + (tid & 7) * 8;
    const int a_rd = (wr * 64 + l31) * LSTR + hi * 8, b_rd = (wc * 64 + l31) * LSTR + hi * 8;
#pragma unroll
    for (int m = 0; m < 2; ++m)
#pragma unroll
        for (int n = 0; n < 2; ++n)
#pragma unroll
            for (int r = 0; r < 16; ++r) acc[m][n][r] = 0.f;
#define G_STORE(RA, RB, BUF) _Pragma("unroll") for (int i = 0; i < 4; ++i) { *(u32x4*)(As + (BUF) * TILE_E + st_off + i * 32 * LSTR) = RA[i]; *(u32x4*)(Bs + (BUF) * TILE_E + st_off + i * 32 * LSTR) = RB[i]; }
    const int a_rd8 = (wr * 64 + l31) * LSTR + hi * 16, b_rd8 = (wc * 64 + l31) * LSTR + hi * 16;
    (void)a_rd8; (void)b_rd8;
#define G_STEP(BUF, ST, RA, RB, SBUF, LD, LA, LB, LKT) { const u16* Ab = As + (BUF) * TILE_E; const u16* Bb = Bs + (BUF) * TILE_E; const bool st_ = (ST), ld_ = (LD); __builtin_amdgcn_s_setprio(1); \
        if constexpr (MODE == 2) { \
            u32x4 f[2][8]; \
            { const u16* pa = Ab + a_rd8; const u16* pb = Bb + b_rd8; \
              f[0][0] = *(const u32x4*)pa; f[0][1] = *(const u32x4*)(pa + 8); f[0][2] = *(const u32x4*)(pa + 32 * LSTR); f[0][3] = *(const u32x4*)(pa + 32 * LSTR + 8); \
              f[0][4] = *(const u32x4*)pb; f[0][5] = *(const u32x4*)(pb + 8); f[0][6] = *(const u32x4*)(pb + 32 * LSTR); f[0][7] = *(const u32x4*)(pb + 32 * LSTR + 8); } \
            _Pragma("unroll") for (int s = 0; s < 2; ++s) { \
                if (s == 0) { const u16* pa = Ab + a_rd8 + 32; const u16* pb = Bb + b_rd8 + 32; \
                  f[1][0] = *(const u32x4*)pa; f[1][1] = *(const u32x4*)(pa + 8); f[1][2] = *(const u32x4*)(pa + 32 * LSTR); f[1][3] = *(const u32x4*)(pa + 32 * LSTR + 8); \
                  f[1][4] = *(const u32x4*)pb; f[1][5] = *(const u32x4*)(pb + 8); f[1][6] = *(const u32x4*)(pb + 32 * LSTR); f[1][7] = *(const u32x4*)(pb + 32 * LSTR + 8); } \
                acc[0][0] = mma_f8(f[s][0], f[s][1], f[s][4], f[s][5], acc[0][0]); acc[0][1] = mma_f8(f[s][0], f[s][1], f[s][6], f[s][7], acc[0][1]); \
                acc[1][0] = mma_f8(f[s][2], f[s][3], f[s][4], f[s][5], acc[1][0]); acc[1][1] = mma_f8(f[s][2], f[s][3], f[s][6], f[s][7], acc[1][1]); \
                __builtin_amdgcn_s_setprio(0); \
                if (st_) { _Pragma("unroll") for (int i = 2 * s; i < 2 * s + 2; ++i) { *(u32x4*)(As + (SBUF) * TILE_E + st_off + i * 32 * LSTR) = RA[i]; *(u32x4*)(Bs + (SBUF) * TILE_E + st_off + i * 32 * LSTR) = RB[i]; } } \
                if (ld_) { _Pragma("unroll") for (int i = 2 * s; i < 2 * s + 2; ++i) { LA[i] = *(const u32x4*)(A + aoff[i] + (LKT) * 64); LB[i] = *(const u32x4*)(B + boff[i] + (LKT) * 64); } } \
                __builtin_amdgcn_sched_barrier(0); if (s + 1 < 2) __builtin_amdgcn_s_setprio(1); } \
        } else { \
            bf16x8 f[2][4]; \
            f[0][0] = *(const bf16x8*)(Ab + a_rd); f[0][1] = *(const bf16x8*)(Ab + a_rd + 32 * LSTR); f[0][2] = *(const bf16x8*)(Bb + b_rd); f[0][3] = *(const bf16x8*)(Bb + b_rd + 32 * LSTR); \
            _Pragma("unroll") for (int s = 0; s < 4; ++s) { \
                if (s + 1 < 4) { f[(s + 1) & 1][0] = *(const bf16x8*)(Ab + a_rd + (s + 1) * 16); f[(s + 1) & 1][1] = *(const bf16x8*)(Ab + a_rd + 32 * LSTR + (s + 1) * 16); \
                                 f[(s + 1) & 1][2] = *(const bf16x8*)(Bb + b_rd + (s + 1) * 16); f[(s + 1) & 1][3] = *(const bf16x8*)(Bb + b_rd + 32 * LSTR + (s + 1) * 16); } \
                acc[0][0] = mma<MODE>(f[s & 1][0], f[s & 1][2], acc[0][0]); acc[0][1] = mma<MODE>(f[s & 1][0], f[s & 1][3], acc[0][1]); \
                acc[1][0] = mma<MODE>(f[s & 1][1], f[s & 1][2], acc[1][0]); acc[1][1] = mma<MODE>(f[s & 1][1], f[s & 1][3], acc[1][1]); \
                __builtin_amdgcn_s_setprio(0); \
                if (st_) { *(u32x4*)(As + (SBUF) * TILE_E + st_off + s * 32 * LSTR) = RA[s]; *(u32x4*)(Bs + (SBUF) * TILE_E + st_off + s * 32 * LSTR) = RB[s]; } \
                if (ld_) { LA[s] = *(const u32x4*)(A + aoff[s] + (LKT) * 64); LB[s] = *(const u32x4*)(B + boff[s] + (LKT) * 64); } \
                __builtin_amdgcn_sched_barrier(0); if (s + 1 < 4) __builtin_amdgcn_s_setprio(1); } \
        } __builtin_amdgcn_s_setprio(0); }
    G_STORE(g.ra0, g.rb0, 0);
    __syncthreads();
    for (int kt = 0; kt < nk; kt += 2) {
        G_STEP(0, kt + 1 < nk, g.ra1, g.rb1, 1, kt + 2 < nk, g.ra0, g.rb0, kt + 2);
        __syncthreads();
        if (kt + 1 >= nk) break;
        G_STEP(1, kt + 2 < nk, g.ra0, g.rb0, 0, kt + 3 < nk, g.ra1, g.rb1, kt + 3);
        __syncthreads();
    }
#undef G_STORE
#undef G_STEP
}
__device__ __forceinline__ void gemm_mainloop(f32x16 (&acc)[2][2], const u16* __restrict__ A, const unsigned (&aoff)[4],
                                              const u16* __restrict__ B, const unsigned (&boff)[4], int nk, u16* smem) {
    GemmRegs g; gemm_prefetch(g, A, aoff, B, boff, nk); gemm_run(acc, g, A, aoff, B, boff, nk, smem);
}
__device__ __forceinline__ void lin_off(unsigned (&off)[4], int row0, int ld, int col0) {
    const int tid = otid();
#pragma unroll
    for (int i = 0; i < 4; ++i) off[i] = (unsigned)(row0 + (tid >> 3) + 32 * i) * (unsigned)ld + (unsigned)(col0 + (tid & 7) * 8);
}
__device__ __forceinline__ bool dense_tile(int it, int C, int& rt, int& ct) {
    const int xcd = blockIdx.x & 7, slot = blockIdx.x >> 3, nslot = gridDim.x >> 3;
    const int i = slot + it * nslot;
    if (i >= 32 * C) return false;
    const int rg = i / (8 * C), rem = i - rg * 8 * C;
    ct = rem >> 3; rt = xcd * 32 + rg * 8 + (rem & 7);
    return true;
}
__device__ __forceinline__ bool moe_tile(int it, int ntl, int& rtg, int& ct) {
    const int xcd = blockIdx.x & 7, slot = blockIdx.x >> 3, nslot = gridDim.x >> 3;
    const int lo = (xcd * ntl) >> 3, hi = ((xcd + 1) * ntl) >> 3;
    const int i = slot + it * nslot;
    if (i >= (hi - lo) * 8) return false;
    rtg = lo + (i >> 3); ct = i & 7;
    return true;
}
#define WAVE_IDS const int tid = otid(), lane = tid & 63, wid = tid >> 6, wr = wid >> 1, wc = wid & 1, l31 = lane & 31, hi = lane >> 5; (void)wr; (void)wc; (void)l31; (void)hi; (void)lane; (void)wid; (void)tid

template <bool I8 = false, bool F8 = false, class SrcFn>
__device__ __forceinline__ void cvt_unit(SrcFn srcfn, int ld_src, int K, int nnt, size_t dst_mat_stride, const float* kscale, u16* dst, float* sm, int tile, float qs = 1.f) {
    const int tid = otid();
    const int nkt = K / 64, nng = (nnt + 3) >> 2, per = nkt * nng;
    {
        const int mat = tile / per, rem = tile % per, ng = rem % nng, kt = rem / nng;
        const int k = tid >> 2, c8 = (tid & 3) * 8;
        float v[4][8];
#pragma unroll
        for (int u = 0; u < 4; ++u) {
            const int nt = ng * 4 + u;
#pragma unroll
            for (int j = 0; j < 8; ++j) v[u][j] = 0.f;
            if (nt < nnt) {
                int ncols = 32; const float* src = srcfn(mat, nt, ncols);
                if (src) {
                    const float* q = src + (size_t)(kt * 64 + k) * ld_src + c8;
                    const f32x4 v0 = *(const f32x4*)q, v1 = *(const f32x4*)(q + 4);
                    v[u][0] = v0[0]; v[u][1] = v0[1]; v[u][2] = v0[2]; v[u][3] = v0[3]; v[u][4] = v1[0]; v[u][5] = v1[1]; v[u][6] = v1[2]; v[u][7] = v1[3];
                }
            }
        }
        if (kscale) { const float sc = kscale[kt * 64 + k];
#pragma unroll
            for (int u = 0; u < 4; ++u)
#pragma unroll
                for (int j = 0; j < 8; ++j) v[u][j] *= sc; }
#pragma unroll
        for (int u = 0; u < 4; ++u)
#pragma unroll
            for (int j = 0; j < 8; ++j) sm[k * 129 + u * 32 + c8 + j] = v[u][j];
        __syncthreads();
        const int kc = tid & 7;
#pragma unroll
        for (int u = 0; u < 4; ++u) {
            const int nt = ng * 4 + u, n = tid >> 3;
            if (nt < nnt) {
                float w[8];
#pragma unroll
                for (int j = 0; j < 8; ++j) w[j] = sm[(kc * 8 + j) * 129 + u * 32 + n];
                if constexpr (F8) {
                    u32x2 o; o[0] = 0u; o[1] = 0u;
                    o[0] = (unsigned)__builtin_amdgcn_cvt_pk_fp8_f32(f8clamp(w[0] * qs), f8clamp(w[1] * qs), (int)o[0], false); o[0] = (unsigned)__builtin_amdgcn_cvt_pk_fp8_f32(f8clamp(w[2] * qs), f8clamp(w[3] * qs), (int)o[0], true);
                    o[1] = (unsigned)__builtin_amdgcn_cvt_pk_fp8_f32(f8clamp(w[4] * qs), f8clamp(w[5] * qs), (int)o[1], false); o[1] = (unsigned)__builtin_amdgcn_cvt_pk_fp8_f32(f8clamp(w[6] * qs), f8clamp(w[7] * qs), (int)o[1], true);
                    *(u32x2*)((unsigned char*)dst + (size_t)mat * dst_mat_stride + (size_t)(nt * 32 + n) * K + kt * 64 + kc * 8) = o;
                } else if constexpr (I8) {
                    unsigned q[8];
#pragma unroll
                    for (int j = 0; j < 8; ++j) { int v_ = __float2int_rn(w[j] * qs); v_ = v_ < -127 ? -127 : (v_ > 127 ? 127 : v_); q[j] = (unsigned)v_ & 255u; }
                    u32x2 o; o[0] = q[0] | (q[1] << 8) | (q[2] << 16) | (q[3] << 24); o[1] = q[4] | (q[5] << 8) | (q[6] << 16) | (q[7] << 24);
                    *(u32x2*)((unsigned char*)dst + (size_t)mat * dst_mat_stride + (size_t)(nt * 32 + n) * K + kt * 64 + kc * 8) = o;
                } else {
                u32x4 o; o[0] = cvtpk(w[0], w[1]); o[1] = cvtpk(w[2], w[3]); o[2] = cvtpk(w[4], w[5]); o[3] = cvtpk(w[6], w[7]);
                *(u32x4*)(dst + (size_t)mat * dst_mat_stride + (size_t)(nt * 32 + n) * K + kt * 64 + kc * 8) = o; }
            }
        }
        __syncthreads();
    }
}

template <bool I8 = false, class SrcFn>
__device__ __forceinline__ void cvt_mat(SrcFn srcfn, int ld_src, int K, int nnt, int nmat, size_t dst_mat_stride, const float* kscale, u16* dst, float* sm, int& tile_base, float qs = 1.f) {
    const int total = (K / 64) * ((nnt + 3) >> 2) * nmat;
    for (int tile = (int)((blockIdx.x + gridDim.x - (tile_base % (int)gridDim.x)) % gridDim.x); tile < total; tile += gridDim.x)
        cvt_unit<I8>(srcfn, ld_src, K, nnt, dst_mat_stride, kscale, dst, sm, tile, qs);
    tile_base += total;
}
constexpr int MOE_CVT_UNITS = 6144;
__device__ __forceinline__ void moe_cvt_unit(const Params& p, int l, float* sm, int unit) {
    if (unit < 4096) {
        const float* wg = p.in[31] + (size_t)l * 32 * 1024 * 512; const float* wu = p.in[32] + (size_t)l * 32 * 1024 * 512;
        const float amax = fmaxf(__uint_as_float(__hip_atomic_load(WSP(unsigned, 0) + AMAX_W + l, __ATOMIC_RELAXED, __HIP_MEMORY_SCOPE_AGENT)), 1e-30f);
        cvt_unit<true>([=](int e, int nt, int&) -> const float* { const int fb = nt >> 2, q = nt & 3; const int f = fb * 64 + (q >> 1) * 32; return ((q & 1) ? wu : wg) + (size_t)e * 1024 * 512 + f; },
                 512, 1024, 32, (size_t)1024 * 1024, nullptr, WSP(u16, O_WGU), sm, unit, WQ_TOP / amax);
    } else {
        const float* wd = p.in[33] + (size_t)l * 32 * 512 * 1024;
        const float amaxd = fmaxf(__uint_as_float(__hip_atomic_load(WSP(unsigned, 0) + AMAX_W + 2 + l, __ATOMIC_RELAXED, __HIP_MEMORY_SCOPE_AGENT)), 1e-30f);
        cvt_unit<false, true>([=](int e, int nt, int&) -> const float* { return wd + (size_t)e * 512 * 1024 + nt * 32; }, 1024, 512, 32, (size_t)1024 * 512, nullptr, WSP(u16, O_WD), sm, unit - 4096, F8_TOP / amaxd);
    }
}
__device__ __forceinline__ void moe_cvt_dynamic(const Params& p, int l, float* sm, unsigned* ctr, int* bc) {
    for (;;) {
        if (otid() == 0) *bc = (int)atomicAdd(ctr, 4u);
        __syncthreads();
        const int base = *bc;
        __syncthreads();
        if (base >= MOE_CVT_UNITS) break;
        for (int u = base; u < base + 4 && u < MOE_CVT_UNITS; ++u) moe_cvt_unit(p, l, sm, u);
    }
}

__device__ __forceinline__ unsigned pack_i8x4(const f32x4 v, float q) {
    return ((unsigned)__float2int_rn(v[0] * q) & 255u) | (((unsigned)__float2int_rn(v[1] * q) & 255u) << 8) | (((unsigned)__float2int_rn(v[2] * q) & 255u) << 16) | ((unsigned)__float2int_rn(v[3] * q) << 24);
}
__device__ __forceinline__ void rownorm_rows(const float* __restrict__ src, const float* __restrict__ g, unsigned char* __restrict__ dst8, float* __restrict__ sa) {
    const int lane = otid() & 63, wv = blockIdx.x * 4 + (otid() >> 6), nw = gridDim.x * 4;
    f32x4 gv[4];
#pragma unroll
    for (int i = 0; i < 4; ++i) gv[i] = *(const f32x4*)(g + i * 256 + lane * 4);
    for (int row = wv * 2; row < T; row += nw * 2) {
        f32x4 x[2][4]; float ss[2] = {0.f, 0.f}, am[2] = {0.f, 0.f};
#pragma unroll
        for (int u = 0; u < 2; ++u)
#pragma unroll
            for (int i = 0; i < 4; ++i) x[u][i] = *(const f32x4*)(src + (size_t)(row + u) * D + i * 256 + lane * 4);
#pragma unroll
        for (int u = 0; u < 2; ++u) {
#pragma unroll
            for (int i = 0; i < 4; ++i) ss[u] += x[u][i][0] * x[u][i][0] + x[u][i][1] * x[u][i][1] + x[u][i][2] * x[u][i][2] + x[u][i][3] * x[u][i][3];
            ss[u] = wave_sum(ss[u]);
            const float rs = rsqrtf(ss[u] * (1.f / D) + EPS);
#pragma unroll
            for (int i = 0; i < 4; ++i)
#pragma unroll
                for (int c = 0; c < 4; ++c) { x[u][i][c] *= rs * gv[i][c]; am[u] = fmaxf(am[u], fabsf(x[u][i][c])); }
            am[u] = fmaxf(wave_max(am[u]), 1e-30f);
            const float qa = 127.f / am[u];
#pragma unroll
            for (int i = 0; i < 4; ++i) *(unsigned*)(dst8 + (size_t)(row + u) * D + i * 256 + lane * 4) = pack_i8x4(x[u][i], qa);
            if (lane == 0) sa[row + u] = am[u] * (1.f / 127.f);
        }
    }
}
__device__ __forceinline__ float sample_amax(const float* __restrict__ src, size_t total, float* sm) {
    const int tid = otid();
    const size_t stride = (total / 16) & ~(size_t)3;
    float m = 0.f;
    f32x4 v[16];
#pragma unroll
    for (int c = 0; c < 16; ++c) v[c] = *(const f32x4*)(src + c * stride + tid * 4);
#pragma unroll
    for (int c = 0; c < 16; ++c) m = fmaxf(fmaxf(m, fmaxf(fabsf(v[c][0]), fabsf(v[c][1]))), fmaxf(fabsf(v[c][2]), fabsf(v[c][3])));
    m = wave_max(m);
    if ((tid & 63) == 0) sm[tid >> 6] = m;
    __syncthreads();
    m = fmaxf(fmaxf(sm[0], sm[1]), fmaxf(sm[2], sm[3]));
    __syncthreads();
    return fmaxf(m, 1e-30f);
}
__device__ __forceinline__ void dequant_tile(f32x16 (&acc)[2][2], const float* sa_tile, float sw) {
    const int tid = otid(), wr = tid >> 7, hi = (tid >> 5) & 1;
#pragma unroll
    for (int m = 0; m < 2; ++m)
#pragma unroll
        for (int rg = 0; rg < 4; ++rg) {
            const f32x4 s4 = *(const f32x4*)(sa_tile + wr * 64 + m * 32 + 8 * rg + 4 * hi);
#pragma unroll
            for (int i = 0; i < 4; ++i) { const float sc = s4[i] * sw;
#pragma unroll
                for (int n = 0; n < 2; ++n) acc[m][n][4 * rg + i] = (float)__float_as_int(acc[m][n][4 * rg + i]) * sc; }
            __builtin_amdgcn_sched_barrier(0);
        }
}

__device__ __forceinline__ void phase_prologue(const Params& p, unsigned char* smem) {
    float* sm = (float*)smem;
    const int tid = otid();
    for (int i = blockIdx.x * 256 + tid; i < 4096 * 48; i += gridDim.x * 256) {
        if (i < 4096 * 32) { const int pos = i >> 5, f = i & 31; const float inv = powf(10000.f, -(float)f / 32.f); float s, c; sincosf((float)pos * inv, &s, &c); WSP(f32x2, O_ROPED)[i] = (f32x2){c, s}; }
        else { const int j = i - 4096 * 32, pos = j >> 4, f = j & 15; const float inv = powf(10000.f, -(float)f / 16.f); float s, c; sincosf((float)pos * inv, &s, &c); WSP(f32x2, O_ROPEM)[j] = (f32x2){c, s}; }
    }
    const float amax0 = sample_amax(p.in[4], (size_t)1024 * EV_IN, sm), amax1 = sample_amax(p.in[12], (size_t)1024 * OD_IN, sm);
    int tb = 0;
    { const float* w = p.in[4];
      cvt_mat<true>([=](int, int nt, int&) -> const float* { const int n = nt * 32; if (n < 512) return w + n; if (n < 2048) return w + n + 32; if (n < 2080) return w + 512 + (n - 2048); return nullptr; },
              EV_IN, 1024, EV_INP / 32, 1, 0, nullptr, WSP(u16, O_WIN0), sm, tb, WQ_TOP / amax0); }
    { const float* w = p.in[7];
      cvt_mat([=](int, int nt, int&) -> const float* { const int n = nt * 32; if (n < 512) return w + (n >> 6) * 96 + (n & 63); return w + ((n - 512) >> 5) * 96 + 64; },
              768, 256, 24, 1, 0, p.in[6], WSP(u16, O_WQ), sm, tb); }
    { const float* w = p.in[9];
      cvt_mat([=](int, int nt, int&) -> const float* { return w + nt * 32; }, 1024, 256, 32, 1, 0, p.in[8], WSP(u16, O_WKV), sm, tb); }
    { const float* w = p.in[5];
      cvt_mat([=](int, int nt, int&) -> const float* { return w + nt * 32; }, 1024, 1024, 32, 1, 0, nullptr, WSP(u16, O_WOUT0), sm, tb); }
    { const float* w = p.in[12];
      cvt_mat<true>([=](int, int nt, int&) -> const float* { return w + nt * 32; }, OD_IN, 1024, OD_IN / 32, 1, 0, nullptr, WSP(u16, O_WIN1), sm, tb, WQ_TOP / amax1); }
    { const float* w = p.in[13];
      cvt_mat([=](int, int nt, int&) -> const float* { return w + nt * 32; }, 1024, 1024, 32, 1, 0, nullptr, WSP(u16, O_WOUT1), sm, tb); }
    { const float* w = p.in[16];
      cvt_mat([=](int, int nt, int&) -> const float* { return w + nt * 32; }, 512, 64, 16, 1, 0, nullptr, WSP(u16, O_W2T), sm, tb); }
    { const float* w = p.in[18];
      cvt_mat([=](int, int nt, int&) -> const float* { return w + nt * 32; }, 512, 64, 16, 1, 0, nullptr, WSP(u16, O_A2T), sm, tb); }
    { const float* w = p.in[19];
      cvt_mat([=](int, int nt, int&) -> const float* { return w + nt * 32; }, 512, 128, 16, 1, 0, nullptr, WSP(u16, O_G2T), sm, tb); }
    { const float* we = p.in[29];
      cvt_mat([=](int mat, int, int&) -> const float* { return we + (size_t)mat * 1024 * 32; }, 32, 1024, 1, 2, (size_t)128 * 1024, nullptr, WSP(u16, O_WR), sm, tb); }
    for (int i = blockIdx.x * 256 + tid; i < 2 * 96 * 1024; i += gridDim.x * 256) {
        const int l = i / (96 * 1024), r = (i / 1024) % 96, k = i % 1024;
        const float v = (r < 4) ? p.in[27][((size_t)l * 1024 + k) * 4 + r] : 0.f;
        WSP(u16, O_WR)[((size_t)l * 128 + 32 + r) * 1024 + k] = f2bf(v);
    }
    for (int l = 0; l < 2; ++l) {
        float m = 0.f;
        for (int mt = 31; mt <= 32; ++mt) { const f32x4* src = (const f32x4*)(p.in[mt] + (size_t)l * 32 * 1024 * 512);
            for (int c = blockIdx.x * 4 + (tid >> 6); c < 2048; c += gridDim.x * 4) { const f32x4 v = src[(size_t)c * 2048 + (tid & 63)]; m = fmaxf(fmaxf(m, fmaxf(fabsf(v[0]), fabsf(v[1]))), fmaxf(fabsf(v[2]), fabsf(v[3]))); } }
        float md = 0.f;
        { const f32x4* src = (const f32x4*)(p.in[33] + (size_t)l * 32 * 512 * 1024);
            for (int c = blockIdx.x * 4 + (tid >> 6); c < 2048; c += gridDim.x * 4) { const f32x4 v = src[(size_t)c * 2048 + (tid & 63)]; md = fmaxf(fmaxf(md, fmaxf(fabsf(v[0]), fabsf(v[1]))), fmaxf(fabsf(v[2]), fabsf(v[3]))); } }
        m = wave_max(m); md = wave_max(md);
        if ((tid & 63) == 0 && __float_as_uint(m) > __hip_atomic_load(WSP(unsigned, 0) + AMAX_W + l, __ATOMIC_RELAXED, __HIP_MEMORY_SCOPE_AGENT)) atomicMax(WSP(unsigned, 0) + AMAX_W + l, __float_as_uint(m));
        if ((tid & 63) == 0 && __float_as_uint(md) > __hip_atomic_load(WSP(unsigned, 0) + AMAX_W + 2 + l, __ATOMIC_RELAXED, __HIP_MEMORY_SCOPE_AGENT)) atomicMax(WSP(unsigned, 0) + AMAX_W + 2 + l, __float_as_uint(md));
    }
    rownorm_rows(p.in[0], p.in[1], WSP(unsigned char, O_HA), WSP(float, O_SAIN));
}

__device__ __forceinline__ void epi_store_bf16(const f32x16 (&acc)[2][2], u16* dst, int ld, int row0, int col0, int l31, int hi) {
#pragma unroll
    for (int m = 0; m < 2; ++m)
#pragma unroll
        for (int n = 0; n < 2; ++n)
#pragma unroll
            for (int r = 0; r < 16; ++r) dst[(size_t)(row0 + m * 32 + crow(r, hi)) * ld + col0 + n * 32 + l31] = f2bf(acc[m][n][r]);
}
__device__ __forceinline__ void st16_wt(unsigned char* wsb, void* ptr, const u32x4 v) {
    __builtin_amdgcn_raw_buffer_store_b128(v, __builtin_amdgcn_make_buffer_rsrc(wsb, 0, 0x7fffffff, 0x00020000), (int)((unsigned char*)ptr - wsb), 0, 16);
}
__device__ __forceinline__ void epi_store_tile_lds(unsigned char* wsb, const f32x16 (&acc)[2][2], u16* dst, int ld, int row0, int col0, int row_lim, u16* Cs) {
    const int tid = otid(), lane = tid & 63, wid = tid >> 6, wr = wid >> 1, wc = wid & 1, l31 = lane & 31, hi = lane >> 5;
#pragma unroll
    for (int m = 0; m < 2; ++m)
#pragma unroll
        for (int n = 0; n < 2; ++n)
#pragma unroll
            for (int r = 0; r < 16; ++r) Cs[(wr * 64 + m * 32 + crow(r, hi)) * 136 + wc * 64 + n * 32 + l31] = f2bf(acc[m][n][r]);
    __syncthreads();
#pragma unroll
    for (int i = 0; i < 8; ++i) { const int c = tid + 256 * i, row = c >> 4, cc = c & 15;
        if (row0 + row < row_lim) st16_wt(wsb, dst + (size_t)(row0 + row) * ld + col0 + cc * 8, *(const u32x4*)(Cs + row * 136 + cc * 8)); }
    __syncthreads();
}
template <bool F16>
__device__ __forceinline__ void lds_put16(const f32x16 (&acc)[2][2], u16* Cs, int wr, int wc, int l31, int hi) {
#pragma unroll
    for (int m = 0; m < 2; ++m)
#pragma unroll
        for (int n = 0; n < 2; ++n)
#pragma unroll
            for (int r = 0; r < 16; ++r) { const float v = acc[m][n][r];
                Cs[(wr * 64 + m * 32 + crow(r, hi)) * 136 + wc * 64 + n * 32 + l31] = F16 ? __builtin_bit_cast(u16, (h16)v) : f2bf(v); }
}
template <int NCH, class DstFn>
__device__ __forceinline__ void lds_rows_store(unsigned char* wsb, const u16* Cs, DstFn dstfn) {
    const int tid = otid();
#pragma unroll
    for (int i = 0; i < (128 * NCH) / 256; ++i) { const int c = tid + 256 * i, row = c / NCH, cc = c % NCH;
        u16* d = dstfn(row, cc);
        if (d) st16_wt(wsb, d, *(const u32x4*)(Cs + row * 136 + cc * 8)); }
}
__device__ __forceinline__ void epi_store_T(const f32x16 (&acc)[2][2], unsigned char* plane, int e0, int pos0, float sc, int l31, int hi) {
    const float s16 = sc * V_F8_SCALE;
#pragma unroll
    for (int m = 0; m < 2; ++m)
#pragma unroll
        for (int n = 0; n < 2; ++n)
#pragma unroll
            for (int rg = 0; rg < 4; ++rg) {
                int w = 0;
                w = __builtin_amdgcn_cvt_pk_fp8_f32(f8clamp(acc[m][n][4 * rg] * s16), f8clamp(acc[m][n][4 * rg + 1] * s16), w, false);
                w = __builtin_amdgcn_cvt_pk_fp8_f32(f8clamp(acc[m][n][4 * rg + 2] * s16), f8clamp(acc[m][n][4 * rg + 3] * s16), w, true);
                *(int*)(plane + (size_t)(e0 + n * 32 + l31) * SEQ + pos0 + m * 32 + 8 * rg + 4 * hi) = w;
            }
}

__device__ __forceinline__ void phase_inproj0(const Params& p, unsigned char* smem) {
    WAVE_IDS;
    const u16* A = WSP(u16, O_HA); const u16* B = WSP(u16, O_WIN0);
    const f32x2* ropeD = WSP(f32x2, O_ROPED); const f32x2* ropeM = WSP(f32x2, O_ROPEM);
    constexpr int NCT = EV_INP / 128;
    const float swinv = sample_amax(p.in[4], (size_t)1024 * EV_IN, (float*)smem) * (1.f / WQ_TOP);
    GemmRegs g; unsigned aoff[4], boff[4];
    float sareg = 0.f; float* sl = (float*)(smem + 73728);
    int rt, ct, rtn = 0, ctn = 0; bool have = dense_tile(0, NCT, rt, ct);
    if (have) { lin_off(aoff, rt * 128, 512, 0); lin_off(boff, ct * 128, 512, 0); gemm_prefetch(g, A, aoff, B, boff, 8); if (tid < 128) sareg = WSP(float, O_SAIN)[rt * 128 + tid]; }
    for (int it = 0; have; ++it) {
        const int m0 = rt * 128, n0 = ct * 128;
        f32x16 acc[2][2];
        gemm_run<1>(acc, g, A, aoff, B, boff, 8, (u16*)smem);
        if (tid < 128) sl[tid] = sareg;
        have = dense_tile(it + 1, NCT, rtn, ctn);
        if (have) { lin_off(aoff, rtn * 128, 512, 0); lin_off(boff, ctn * 128, 512, 0); gemm_prefetch(g, A, aoff, B, boff, 8); if (tid < 128) sareg = WSP(float, O_SAIN)[rtn * 128 + tid]; }
        __syncthreads();
        dequant_tile(acc, sl, swinv);
        const int row0 = m0 + wr * 64, b = m0 >> 12, pos0 = row0 & (SEQ - 1);
        if (ct < 4) {
            epi_store_tile_lds(p.ws, acc, WSP(u16, O_CLAT), 512, m0, n0, T, (u16*)smem);
        } else if (ct < 12) {
            const bool isq = ct < 8; const int hh = (ct - 4) & 3;
            u16* dst = WSP(u16, isq ? O_QD : O_KD) + (size_t)((b * 4 + hh) * 2) * SEQ * 64;
            const float sc = isq ? QSCALE_D : 1.f;
#pragma unroll
            for (int m = 0; m < 2; ++m)
#pragma unroll
                for (int r = 0; r < 16; ++r) {
                    const int pos = pos0 + m * 32 + crow(r, hi);
                    const f32x2 cs = ropeD[pos * 32 + l31];
                    const float x1 = acc[m][0][r], x2 = acc[m][1][r];
                    acc[m][0][r] = (x1 * cs[0] - x2 * cs[1]) * sc; acc[m][1][r] = (x2 * cs[0] + x1 * cs[1]) * sc;
                }
            lds_put16<false>(acc, (u16*)smem, wr, wc, l31, hi);
            __syncthreads();
            { const int p0m = m0 & (SEQ - 1);
              lds_rows_store<16>(p.ws, (const u16*)smem, [=](int row, int cc) -> u16* { return dst + (size_t)(cc >> 3) * SEQ * 64 + (size_t)(p0m + row) * 64 + (cc & 7) * 8; }); }
            __syncthreads();
        } else if (ct < 16) {
            const int hh = ct - 12;
            epi_store_T(acc, WSP(unsigned char, O_VTD) + (size_t)(b * 4 + hh) * 128 * SEQ, wc * 64, pos0, 1.f, l31, hi);
        } else {
            if (wc == 0) {
#pragma unroll
                for (int m = 0; m < 2; ++m)
#pragma unroll
                    for (int r = 0; r < 16; ++r) {
                        const int pos = pos0 + m * 32 + crow(r, hi);
                        const float x = acc[m][0][r], y = __shfl_xor(x, 16);
                        const f32x2 cs = ropeM[pos * 16 + (l31 & 15)];
                        const float o = (l31 < 16) ? (x * cs[0] - y * cs[1]) : (x * cs[0] + y * cs[1]);
                        const u16 ob = f2bf(o);
#pragma unroll
                        for (int h8 = 0; h8 < 8; ++h8) WSP(u16, O_KM)[((size_t)(b * 8 + h8) * SEQ + pos) * 96 + 64 + l31] = ob;
                    }
            }
        }
            rt = rtn; ct = ctn;
    }
}

__device__ __forceinline__ void phase_upproj(const Params& p, unsigned char* smem) {
    WAVE_IDS;
    const u16* A = WSP(u16, O_CLAT);
    const f32x2* ropeM = WSP(f32x2, O_ROPEM);
    float* rsl = (float*)(smem + 73728);
    int rt, c14;
    for (int it = 0; dense_tile(it, 14, rt, c14); ++it) {
        const int m0 = rt * 128;
        const bool isq = c14 < 6; const int ct = isq ? c14 : c14 - 6; const int acol = isq ? 0 : 256;
        {
            const int row = tid >> 1, half = tid & 1;
            const u16* q = A + (size_t)(m0 + row) * 512 + acol + half * 128;
            float ss = 0.f;
#pragma unroll
            for (int i = 0; i < 16; ++i) { const u32x4 v = *(const u32x4*)(q + i * 8);
#pragma unroll
                for (int j = 0; j < 4; ++j) { const float a = bflo(v[j]), c = bfhi(v[j]); ss += a * a + c * c; } }
            ss += __shfl_xor(ss, 1);
            if (half == 0) rsl[row] = rsqrtf(ss * (1.f / 256.f) + EPS);
        }
        unsigned aoff[4], boff[4]; lin_off(aoff, m0, 512, acol); lin_off(boff, ct * 128, 256, 0);
        f32x16 acc[2][2];
        gemm_mainloop(acc, A, aoff, isq ? WSP(u16, O_WQ) : WSP(u16, O_WKV), boff, 4, (u16*)smem);
        const int row0 = m0 + wr * 64, b = m0 >> 12, pos0 = row0 & (SEQ - 1);
#pragma unroll
        for (int m = 0; m < 2; ++m)
#pragma unroll
            for (int r = 0; r < 16; ++r) { const float rs = rsl[wr * 64 + m * 32 + crow(r, hi)];
                acc[m][0][r] *= rs; acc[m][1][r] *= rs; }
        const int p0m = m0 & (SEQ - 1);
        if (isq) {
            if (ct < 4) {
#pragma unroll
                for (int m = 0; m < 2; ++m)
#pragma unroll
                    for (int n = 0; n < 2; ++n)
#pragma unroll
                        for (int r = 0; r < 16; ++r) acc[m][n][r] *= QSCALE_M;
                lds_put16<false>(acc, (u16*)smem, wr, wc, l31, hi);
                __syncthreads();
                u16* dst = WSP(u16, O_QM) + (size_t)(b * 8 + 2 * ct) * SEQ * 96;
                lds_rows_store<16>(p.ws, (const u16*)smem, [=](int row, int cc) -> u16* { return dst + (size_t)(cc >> 3) * SEQ * 96 + (size_t)(p0m + row) * 96 + (cc & 7) * 8; });
                __syncthreads();
            } else {
#pragma unroll
                for (int m = 0; m < 2; ++m)
#pragma unroll
                    for (int n = 0; n < 2; ++n)
#pragma unroll
                        for (int r = 0; r < 16; ++r) {
                            const int pos = pos0 + m * 32 + crow(r, hi);
                            const float x = acc[m][n][r], y = __shfl_xor(x, 16);
                            const f32x2 cs = ropeM[pos * 16 + (l31 & 15)];
                            acc[m][n][r] = ((l31 < 16) ? (x * cs[0] - y * cs[1]) : (x * cs[0] + y * cs[1])) * QSCALE_M;
                        }
                lds_put16<false>(acc, (u16*)smem, wr, wc, l31, hi);
                __syncthreads();
                u16* dst = WSP(u16, O_QM) + (size_t)(b * 8 + (ct - 4) * 4) * SEQ * 96 + 64;
                lds_rows_store<16>(p.ws, (const u16*)smem, [=](int row, int cc) -> u16* { return dst + (size_t)(cc >> 2) * SEQ * 96 + (size_t)(p0m + row) * 96 + (cc & 3) * 8; });
                __syncthreads();
            }
        } else {
            const int head = ct;
            if (wc == 1) epi_store_T(acc, WSP(unsigned char, O_VTM) + (size_t)(b * 8 + head) * 64 * SEQ, 0, pos0, 1.f, l31, hi);
            lds_put16<false>(acc, (u16*)smem, wr, wc, l31, hi);
            __syncthreads();
            u16* dst = WSP(u16, O_KM) + (size_t)(b * 8 + head) * SEQ * 96;
            lds_rows_store<8>(p.ws, (const u16*)smem, [=](int row, int cc) -> u16* { return dst + (size_t)(p0m + row) * 96 + cc * 8; });
            __syncthreads();
        }
        __syncthreads();
    }
}

template <int DK, int DV>
__device__ __forceinline__ void attn_core(const u16* __restrict__ Q, const u16* __restrict__ K, const unsigned char* __restrict__ Vt, int qt, f32x16 (&o)[DV / 32], float& lrun, u16* smem) {
    WAVE_IDS;
    constexpr int KS = DK + 8, VS8 = 80, KT = 64 * KS, VT8 = DV * VS8;
    constexpr int NKC = DK / 32, NVC = DV / 64, NDT = DV / 32, NKS = DK / 16;
    constexpr float THR = 8.f;
    u16* Kl = smem; unsigned char* Vl = (unsigned char*)(smem + 2 * KT);
    const int q0 = qt * 128 + wid * 32;
    const int ntw = (q0 >> 6) + 1, ntb = qt * 2 + 2;
    bf16x8 qf[NKS];
#pragma unroll
    for (int s = 0; s < NKS; ++s) qf[s] = *(const bf16x8*)(Q + (size_t)(q0 + l31) * DK + s * 16 + hi * 8);
    u32x4 rk[NKC], rv[NVC];
#pragma unroll
    for (int d = 0; d < NDT; ++d)
#pragma unroll
        for (int r = 0; r < 16; ++r) o[d][r] = 0.f;
    f32x16 negm;
#pragma unroll
    for (int r = 0; r < 16; ++r) negm[r] = 0.f;
    lrun = 0.f;
    auto gload = [&](int j) {
#pragma unroll
        for (int i = 0; i < NKC; ++i) rk[i] = *(const u32x4*)(K + (size_t)j * 64 * DK + (size_t)(tid + 256 * i) * 8);
#pragma unroll
        for (int i = 0; i < NVC; ++i) { const int c = tid + 256 * i; rv[i] = *(const u32x4*)(Vt + (size_t)(c >> 2) * SEQ + j * 64 + (c & 3) * 16); }
    };
    auto lstore = [&](int buf) {
#pragma unroll
        for (int i = 0; i < NKC; ++i) { const int c = tid + 256 * i, row = c / (DK / 8), kc = c % (DK / 8); *(u32x4*)(Kl + buf * KT + row * KS + kc * 8) = rk[i]; }
#pragma unroll
        for (int i = 0; i < NVC; ++i) { const int c = tid + 256 * i, part = c & 3;
            unsigned char* d = Vl + buf * VT8 + (c >> 2) * VS8 + part * 8;
            *(u32x2*)d = (u32x2){rv[i][0], rv[i][2]}; *(u32x2*)(d + 32) = (u32x2){rv[i][1], rv[i][3]}; }
    };
    gload(0); lstore(0); __syncthreads();
    for (int j = 0; j < ntb; ++j) {
        const int cur = j & 1;
        if (j + 1 < ntb) gload(j + 1);
        __builtin_amdgcn_sched_barrier(0);
        if (j < ntw) {
            const u16* Kb = Kl + cur * KT; const unsigned char* Vb = Vl + cur * VT8;
            f32x16 p0, p1;
            __builtin_amdgcn_s_setprio(1);
            bf16x8 kf[2][2];
#pragma unroll
            for (int s = 0; s < 2; ++s) { kf[s][0] = *(const bf16x8*)(Kb + l31 * KS + s * 16 + hi * 8); kf[s][1] = *(const bf16x8*)(Kb + (32 + l31) * KS + s * 16 + hi * 8); }
#pragma unroll
            for (int s = 0; s < NKS; ++s) {
                if (s == 0) { p0 = MFMA(kf[0][0], qf[0], negm); p1 = MFMA(kf[0][1], qf[0], negm); }
                else { p0 = MFMA(kf[s & 1][0], qf[s], p0); p1 = MFMA(kf[s & 1][1], qf[s], p1); }
                if (s + 2 < NKS) { kf[s & 1][0] = *(const bf16x8*)(Kb + l31 * KS + (s + 2) * 16 + hi * 8); kf[s & 1][1] = *(const bf16x8*)(Kb + (32 + l31) * KS + (s + 2) * 16 + hi * 8); }
                __builtin_amdgcn_sched_barrier(0);
            }
            u32x4 vf[NDT][2];
#pragma unroll
            for (int d = 0; d < NDT; ++d) { const unsigned char* vp = Vb + (d * 32 + l31) * VS8 + hi * 32; vf[d][0] = *(const u32x4*)vp; vf[d][1] = *(const u32x4*)(vp + 16); }
            __builtin_amdgcn_s_setprio(0);
            __builtin_amdgcn_sched_barrier(0);
            float mx = p0[0];
#pragma unroll
            for (int r = 1; r < 16; ++r) mx = fmaxf(mx, p0[r]);
#pragma unroll
            for (int r = 0; r < 16; ++r) mx = fmaxf(mx, p1[r]);
            mx = xhalf_max(mx);
            if (j == 0 || __any(mx > THR)) {
                const float dm = (j == 0) ? mx : fmaxf(mx, 0.f), alpha = (j == 0) ? 0.f : __builtin_amdgcn_exp2f(-dm);
                lrun *= alpha;
#pragma unroll
                for (int d = 0; d < NDT; ++d)
#pragma unroll
                    for (int r = 0; r < 16; ++r) o[d][r] *= alpha;
#pragma unroll
                for (int r = 0; r < 16; ++r) { p0[r] -= dm; p1[r] -= dm; negm[r] -= dm; }
            }
            float ps = 0.f;
#pragma unroll
            for (int r = 0; r < 16; ++r) { p0[r] = __builtin_amdgcn_exp2f(p0[r]); ps += p0[r]; }
#pragma unroll
            for (int r = 0; r < 16; ++r) { p1[r] = __builtin_amdgcn_exp2f(p1[r]); ps += p1[r]; }
            lrun += xhalf_sum(ps);
            u32x4 plo, phi;
#pragma unroll
            for (int d4 = 0; d4 < 4; ++d4) {
                int w0 = 0, w1 = 0;
                w0 = __builtin_amdgcn_cvt_pk_fp8_f32(p0[4 * d4], p0[4 * d4 + 1], w0, false); w0 = __builtin_amdgcn_cvt_pk_fp8_f32(p0[4 * d4 + 2], p0[4 * d4 + 3], w0, true);
                w1 = __builtin_amdgcn_cvt_pk_fp8_f32(p1[4 * d4], p1[4 * d4 + 1], w1, false); w1 = __builtin_amdgcn_cvt_pk_fp8_f32(p1[4 * d4 + 2], p1[4 * d4 + 3], w1, true);
                plo[d4] = (unsigned)w0; phi[d4] = (unsigned)w1;
            }
            __builtin_amdgcn_s_setprio(1);
#pragma unroll
            for (int d = 0; d < NDT; ++d) o[d] = mma_f8(vf[d][0], vf[d][1], plo, phi, o[d]);
            __builtin_amdgcn_s_setprio(0);
        }
        __builtin_amdgcn_sched_barrier(0);
        if (j + 1 < ntb) lstore(cur ^ 1);
        __syncthreads();
    }
}

__device__ __forceinline__ void phase_attn(const Params& p, unsigned char* smem) {
    WAVE_IDS;
    unsigned* ctr = WSP(unsigned, 0) + ATTN_CTR_W;
    int* bc = (int*)(smem + 73728 + 1024);
    float* sl = (float*)(smem + 73728 + 1536);
    if (tid < 64) { const float* lam = p.in[10]; float a = lam[tid] * lam[64 + tid], c = lam[128 + tid] * lam[192 + tid]; a = wave_sum(a); c = wave_sum(c);
        if (tid == 0) sl[0] = __expf(a) - __expf(c) + 0.2f; }
    __syncthreads();
    const float lamf = sl[0];
    u32x2* scr = WSP(u32x2, O_ATTSCR) + (size_t)blockIdx.x * 4096;
    for (;;) {
        if (tid == 0) *bc = (int)atomicAdd(ctr, 1u);
        __syncthreads();
        const int qi = *bc;
        __syncthreads();
        if (qi >= 3072) break;
        const int item = qi;
        const int level = item / 96, r = item - level * 96, qt = 31 - level;
        const int q0 = qt * 128 + wid * 32;
        if (r < 32) {
            const int bh = r, b = bh >> 2, hh = bh & 3;
            f32x16 o[4]; float l1;
            attn_core<64, 128>(WSP(u16, O_QD) + (size_t)(bh * 2) * SEQ * 64, WSP(u16, O_KD) + (size_t)(bh * 2) * SEQ * 64, WSP(unsigned char, O_VTD) + (size_t)bh * 128 * SEQ, qt, o, l1, (u16*)smem);
            { const float il = 1.f / (l1 * V_F8_SCALE);
#pragma unroll
              for (int d = 0; d < 4; ++d)
#pragma unroll
                  for (int rg = 0; rg < 4; ++rg) { u32x2 w; w[0] = cvtpk(o[d][4 * rg] * il, o[d][4 * rg + 1] * il); w[1] = cvtpk(o[d][4 * rg + 2] * il, o[d][4 * rg + 3] * il);
                      scr[((wid * 4 + d) * 4 + rg) * 64 + lane] = w; } }
            float l2;
            attn_core<64, 128>(WSP(u16, O_QD) + (size_t)(bh * 2 + 1) * SEQ * 64, WSP(u16, O_KD) + (size_t)(bh * 2 + 1) * SEQ * 64, WSP(unsigned char, O_VTD) + (size_t)bh * 128 * SEQ, qt, o, l2, (u16*)smem);
            const float il2 = lamf / (l2 * V_F8_SCALE);
            float ss = 0.f;
#pragma unroll
            for (int d = 0; d < 4; ++d)
#pragma unroll
                for (int rg = 0; rg < 4; ++rg) { const u32x2 w = scr[((wid * 4 + d) * 4 + rg) * 64 + lane];
                    o[d][4 * rg] = bflo(w[0]) - o[d][4 * rg] * il2; o[d][4 * rg + 1] = bfhi(w[0]) - o[d][4 * rg + 1] * il2;
                    o[d][4 * rg + 2] = bflo(w[1]) - o[d][4 * rg + 2] * il2; o[d][4 * rg + 3] = bfhi(w[1]) - o[d][4 * rg + 3] * il2;
                    ss += o[d][4 * rg] * o[d][4 * rg] + o[d][4 * rg + 1] * o[d][4 * rg + 1] + o[d][4 * rg + 2] * o[d][4 * rg + 2] + o[d][4 * rg + 3] * o[d][4 * rg + 3]; }
            ss = xhalf_sum(ss);
            const float rs = rsqrtf(ss * (1.f / 128.f) + EPS) * 0.8f;
            u16* dst = WSP(u16, O_HA) + ((size_t)b * SEQ + q0 + l31) * 1024 + 512 + hh * 128;
#pragma unroll
            for (int d = 0; d < 4; ++d)
#pragma unroll
                for (int rg = 0; rg < 4; ++rg) { const int e = d * 32 + 8 * rg + 4 * hi; const f32x4 gsub = *(const f32x4*)(p.in[11] + e);
                    u32x2 w; w[0] = cvtpk(o[d][4 * rg] * rs * gsub[0], o[d][4 * rg + 1] * rs * gsub[1]); w[1] = cvtpk(o[d][4 * rg + 2] * rs * gsub[2], o[d][4 * rg + 3] * rs * gsub[3]);
                    *(u32x2*)(dst + e) = w; }
        } else {
            const int bh = r - 32, b = bh >> 3, h8 = bh & 7;
            f32x16 o[2]; float l1;
            attn_core<96, 64>(WSP(u16, O_QM) + (size_t)bh * SEQ * 96, WSP(u16, O_KM) + (size_t)bh * SEQ * 96, WSP(unsigned char, O_VTM) + (size_t)bh * 64 * SEQ, qt, o, l1, (u16*)smem);
            const float il = 1.f / (l1 * V_F8_SCALE);
            u16* dst = WSP(u16, O_HA) + ((size_t)b * SEQ + q0 + l31) * 1024 + h8 * 64;
#pragma unroll
            for (int d = 0; d < 2; ++d)
#pragma unroll
                for (int rg = 0; rg < 4; ++rg) { u32x2 w; w[0] = cvtpk(o[d][4 * rg] * il, o[d][4 * rg + 1] * il); w[1] = cvtpk(o[d][4 * rg + 2] * il, o[d][4 * rg + 3] * il);
                    *(u32x2*)(dst + d * 32 + 8 * rg + 4 * hi) = w; }
        }
    }
}

__device__ __forceinline__ void phase_outproj(const Params& p, unsigned char* smem, int l) {
    WAVE_IDS;
    const u16* A = WSP(u16, O_HA); const u16* B = WSP(u16, l == 0 ? O_WOUT0 : O_WOUT1);
    const float* res = p.in[0];
    float* Cs = (float*)smem;
    GemmRegs g; unsigned aoff[4], boff[4];
    int rt, ct, rtn = 0, ctn = 0; bool have = dense_tile(0, 8, rt, ct);
    if (have) { lin_off(aoff, rt * 128, 1024, 0); lin_off(boff, ct * 128, 1024, 0); gemm_prefetch(g, A, aoff, B, boff, 16); }
    for (int it = 0; have; ++it) {
        const int m0 = rt * 128, n0 = ct * 128;
        f32x16 acc[2][2];
        gemm_run(acc, g, A, aoff, B, boff, 16, (u16*)smem);
        have = dense_tile(it + 1, 8, rtn, ctn);
        if (have) { lin_off(aoff, rtn * 128, 1024, 0); lin_off(boff, ctn * 128, 1024, 0); gemm_prefetch(g, A, aoff, B, boff, 16); }
#pragma unroll
        for (int m = 0; m < 2; ++m)
#pragma unroll
            for (int n = 0; n < 2; ++n)
#pragma unroll
                for (int r = 0; r < 16; ++r) Cs[(wr * 64 + m * 32 + crow(r, hi)) * 132 + wc * 64 + n * 32 + l31] = acc[m][n][r];
        __syncthreads();
#pragma unroll
        for (int i = 0; i < 16; ++i) { const int c = tid + 256 * i, row = c >> 5, c4 = (c & 31) * 4;
            const f32x4 rv = l == 0 ? *(const f32x4*)(res + (size_t)(m0 + row) * D + n0 + c4) : bf4_to_f32(*(const u32x2*)(HB(m0 + row) + n0 + c4));
            const f32x4 hv = rv + *(const f32x4*)(Cs + row * 132 + c4);
            u32x2 o; o[0] = cvtpk(hv[0], hv[1]); o[1] = cvtpk(hv[2], hv[3]);
            *(u32x2*)(HB(m0 + row) + n0 + c4) = o; }
        __syncthreads();
            rt = rtn; ct = ctn;
    }
}

__device__ __forceinline__ void phase_route(const Params& p, unsigned char* smem, int l) {
    WAVE_IDS;
    const u16* A = WSP(u16, O_HA); const u16* B = WSP(u16, O_WR) + (size_t)l * 128 * 1024;
    float* lg = (float*)smem;
    int* lc = (int*)(smem + 73728 + 1664);
    float* sarow = (float*)(smem + 73728);
    unsigned* cnt = WSP(unsigned, 0) + CNT_W + l * 64;
    const float* g = p.in[2] + l * 1024;
    int rt, ct0;
    for (int it = 0; dense_tile(it, 1, rt, ct0); ++it) {
        const int m0 = rt * 128;
        {
            f32x4 gv[4];
#pragma unroll
            for (int i = 0; i < 4; ++i) gv[i] = *(const f32x4*)(g + i * 256 + lane * 4);
            constexpr int RB = 4;
            for (int r2 = 0; r2 < 32; r2 += RB) {
                const int row = m0 + wid * 32 + r2;
                f32x4 x[RB][4]; float ss[RB];
#pragma unroll
                for (int u = 0; u < RB; ++u)
#pragma unroll
                    for (int i = 0; i < 4; ++i) x[u][i] = bf4_to_f32(*(const u32x2*)(HB(row + u) + i * 256 + lane * 4));
#pragma unroll
                for (int u = 0; u < RB; ++u) {
                    ss[u] = 0.f;
#pragma unroll
                    for (int i = 0; i < 4; ++i) ss[u] += x[u][i][0] * x[u][i][0] + x[u][i][1] * x[u][i][1] + x[u][i][2] * x[u][i][2] + x[u][i][3] * x[u][i][3];
                }
#pragma unroll
                for (int o = 32; o; o >>= 1)
#pragma unroll
                    for (int u = 0; u < RB; ++u) ss[u] += __shfl_xor(ss[u], o);
                float am[RB];
#pragma unroll
                for (int u = 0; u < RB; ++u) {
                    const float rs = rsqrtf(ss[u] * (1.f / D) + EPS);
                    am[u] = 0.f;
#pragma unroll
                    for (int i = 0; i < 4; ++i) {
#pragma unroll
                        for (int c = 0; c < 4; ++c) { x[u][i][c] *= rs * gv[i][c]; am[u] = fmaxf(am[u], fabsf(x[u][i][c])); }
                        u32x2 o; o[0] = cvtpk(x[u][i][0], x[u][i][1]); o[1] = cvtpk(x[u][i][2], x[u][i][3]);
                        *(u32x2*)(WSP(u16, O_HA) + (size_t)(row + u) * D + i * 256 + lane * 4) = o; }
                }
#pragma unroll
                for (int o = 32; o; o >>= 1)
#pragma unroll
                    for (int u = 0; u < RB; ++u) am[u] = fmaxf(am[u], __shfl_xor(am[u], o));
#pragma unroll
                for (int u = 0; u < RB; ++u) {
                    const float amx = fmaxf(am[u], 1e-30f);
                    const float qa = 127.f / amx;
#pragma unroll
                    for (int i = 0; i < 4; ++i) { unsigned q[4];
#pragma unroll
                        for (int c = 0; c < 4; ++c) q[c] = (unsigned)__float2int_rn(x[u][i][c] * qa) & 255u;
                        *(unsigned*)(WSP(unsigned char, O_A8) + (size_t)(row + u) * D + i * 256 + lane * 4) = q[0] | (q[1] << 8) | (q[2] << 16) | (q[3] << 24); }
                    if (lane == 0) sarow[row + u - m0] = amx * (1.f / 127.f);
                }
            }
            __syncthreads();
        }
        unsigned aoff[4], boff[4]; lin_off(aoff, m0, 1024, 0); lin_off(boff, 0, 1024, 0);
        f32x16 acc[2][2];
        gemm_mainloop(acc, A, aoff, B, boff, 16, (u16*)smem);
        if (wc == 0) {
#pragma unroll
            for (int m = 0; m < 2; ++m)
#pragma unroll
                for (int r = 0; r < 16; ++r) { const int row = wr * 64 + m * 32 + crow(r, hi);
                    lg[row * 37 + l31] = acc[m][0][r]; if (l31 < 4) lg[row * 37 + 32 + l31] = acc[m][1][r]; }
        }
        if (tid < 32) lc[tid] = 0;
        __syncthreads();
        int ea = 0, eb = 0, la = 0, lb = 0; float gw0 = 0.f, gw1 = 0.f;
        if (tid < 128) {
            const float* z = lg + tid * 37;
            float zg[4]; int gsel = 0;
#pragma unroll
            for (int i = 0; i < 4; ++i) zg[i] = z[32 + i] + p.in[28][l * 4 + i];
#pragma unroll
            for (int i = 1; i < 4; ++i) if (zg[i] > zg[gsel]) gsel = i;
            float den = 0.f;
#pragma unroll
            for (int i = 0; i < 4; ++i) den += __expf(zg[i] - zg[gsel]);
            const float pg = 1.f / den;
            float ze[8];
#pragma unroll
            for (int i = 0; i < 8; ++i) ze[i] = z[gsel * 8 + i] + p.in[30][l * 32 + gsel * 8 + i];
            int i0 = 0;
#pragma unroll
            for (int i = 1; i < 8; ++i) if (ze[i] > ze[i0]) i0 = i;
            int i1 = (i0 == 0) ? 1 : 0;
#pragma unroll
            for (int i = 0; i < 8; ++i) if (i != i0 && ze[i] > ze[i1]) i1 = i;
            const float e1 = __expf(ze[i1] - ze[i0]);
            const float w0 = pg / (1.f + e1), w1 = pg * e1 / (1.f + e1);
            ea = gsel * 8 + i0; eb = gsel * 8 + i1;
            la = atomicAdd(&lc[ea], 1); lb = atomicAdd(&lc[eb], 1);
            gw0 = w0; gw1 = w1;
        }
        __syncthreads();
        if (tid < 32) { const int c = lc[tid]; lc[32 + tid] = c ? (int)atomicAdd(&cnt[tid], (unsigned)c) : 0; }
        __syncthreads();
        if (tid < 128) { const int pa = lc[32 + ea] + la, pb = lc[32 + eb] + lb, t = m0 + tid; const float sa = sarow[tid];
            WSP(int4, O_SEL)[t] = make_int4(ea, pa, eb, pb);
            WSP(int, O_TOK2)[(size_t)ea * T + pa] = t; WSP(int, O_TOK2)[(size_t)eb * T + pb] = t;
            WSP(f32x2, O_GS2)[(size_t)ea * T + pa] = (f32x2){gw0, sa}; WSP(f32x2, O_GS2)[(size_t)eb * T + pb] = (f32x2){gw1, sa}; }
        __syncthreads();
    }
    moe_cvt_dynamic(p, l, (float*)smem, WSP(unsigned, 0) + (l == 0 ? CONV0_CTR_W : CONV1_CTR_W), (int*)(smem + 73728 + 1024));
}

__device__ __forceinline__ void expert_offsets(const Params& p, int l, int* offs) {
    if (otid() < 32) offs[128 + otid()] = (int)__hip_atomic_load(WSP(unsigned, 0) + CNT_W + l * 64 + otid(), __ATOMIC_RELAXED, __HIP_MEMORY_SCOPE_AGENT);
    __syncthreads();
    if (otid() == 0) { int a = 0, tl = 0;
        for (int e = 0; e < 32; ++e) { offs[e] = a; offs[64 + e] = tl; const int c = offs[128 + e]; a += c; tl += (c + 127) >> 7; }
        offs[32] = a; offs[64 + 32] = tl; }
    __syncthreads();
}

__device__ __forceinline__ void phase_lists(const Params& p, unsigned char* smem, int l) {
    int* offs = (int*)(smem + 73728);
    expert_offsets(p, l, offs);
    for (int t = blockIdx.x * 256 + otid(); t < T; t += gridDim.x * 256) {
        const int4 s = WSP(int4, O_SEL)[t]; const f32x2 g = WSP(f32x2, O_GATES)[t];
        const int r0 = offs[s.x] + s.y, r1 = offs[s.z] + s.w;
        WSP(int, O_TOKROW)[r0] = t; WSP(int, O_TOKROW)[r1] = t;
        WSP(float, O_GATEROW)[r0] = g[0]; WSP(float, O_GATEROW)[r1] = g[1];
        const float sa = WSP(float, O_SA8)[t];
        WSP(f32x2, O_GSROW)[r0] = (f32x2){g[0], sa}; WSP(f32x2, O_GSROW)[r1] = (f32x2){g[1], sa};
        WSP(int, O_ROWTOK)[2 * t] = r0; WSP(int, O_ROWTOK)[2 * t + 1] = r1;
    }
}

__device__ __forceinline__ void phase_moe1(const Params& p, unsigned char* smem, int l) {
    WAVE_IDS;
    int* offs = (int*)(smem + 73728);
    expert_offsets(p, l, offs);
    const int ntl = offs[64 + 32];
    const u16* A = WSP(u16, O_A8);
    const float swinv = fmaxf(__uint_as_float(__hip_atomic_load(WSP(unsigned, 0) + AMAX_W + l, __ATOMIC_RELAXED, __HIP_MEMORY_SCOPE_AGENT)), 1e-30f) * (1.f / WQ_TOP);
    GemmRegs g; unsigned aoff[4], boff[4];
    f32x2 gsreg = {0.f, 0.f}; f32x2* gl = (f32x2*)(smem + ROWSC_LDS);
    auto setup = [&](int it_, int& rtg_, int& ct_, int& e_, int& rbeg_, int& rend_) -> bool {
        if (!moe_tile(it_, ntl, rtg_, ct_)) return false;
        e_ = 0; while (offs[64 + e_ + 1] <= rtg_) ++e_;
        rbeg_ = offs[e_] + (rtg_ - offs[64 + e_]) * 128; rend_ = offs[e_ + 1];
#pragma unroll
        for (int i = 0; i < 4; ++i) { int r = rbeg_ + (tid >> 3) + 32 * i; r = r < rend_ ? r : rend_ - 1; aoff[i] = (unsigned)WSP(int, O_TOK2)[(size_t)e_ * T + (r - offs[e_])] * 512u + (tid & 7) * 8; }
        lin_off(boff, ct_ * 128, 512, 0);
        gemm_prefetch(g, A, aoff, WSP(u16, O_WGU) + (size_t)e_ * 1024 * 512, boff, 8);
        if (tid < 128) gsreg = WSP(f32x2, O_GS2)[(size_t)e_ * T + (rbeg_ - offs[e_]) + tid];
        return true; };
    int rtg, ct, e, rbeg, rend, rtgn = 0, ctn = 0, en = 0, rbegn = 0, rendn = 0;
    bool have = setup(0, rtg, ct, e, rbeg, rend);
    for (int it = 0; have; ++it) {
        f32x16 acc[2][2];
        gemm_run<1>(acc, g, A, aoff, WSP(u16, O_WGU) + (size_t)e * 1024 * 512, boff, 8, (u16*)smem);
        if (tid < 128) gl[tid] = gsreg;
        have = setup(it + 1, rtgn, ctn, en, rbegn, rendn);
        __syncthreads();
        { u16* Cs = (u16*)smem;
#pragma unroll
          for (int m = 0; m < 2; ++m)
#pragma unroll
              for (int rg = 0; rg < 4; ++rg) {
                  const int lr0 = wr * 64 + m * 32 + 8 * rg + 4 * hi;
                  const f32x4* gp = (const f32x4*)(gl + lr0);
                  const f32x4 g01 = gp[0], g23 = gp[1];
#pragma unroll
                  for (int i = 0; i < 4; ++i) { const float gt = i == 0 ? g01[0] : (i == 1 ? g01[2] : (i == 2 ? g23[0] : g23[2])); const float sc = (i == 0 ? g01[1] : (i == 1 ? g01[3] : (i == 2 ? g23[1] : g23[3]))) * swinv;
                      const float a = (float)__float_as_int(acc[m][0][4 * rg + i]) * sc, u = (float)__float_as_int(acc[m][1][4 * rg + i]) * sc;
                      ((unsigned char*)Cs)[(lr0 + i) * 272 + wc * 32 + l31] = (unsigned char)(__builtin_amdgcn_cvt_pk_fp8_f32(f8clamp(siluf_(a) * u * gt * ACT_F8_SCALE), 0.f, 0, false) & 0xff); }
                  __builtin_amdgcn_sched_barrier(0);
              }
          __syncthreads();
          u16* dst = WSP(u16, O_ACTB) + (size_t)rbeg * 256 + ct * 32; const int nvalid = rend - rbeg;
          lds_rows_store<4>(p.ws, (const u16*)smem, [=](int row, int cc) -> u16* { return row < nvalid ? dst + (size_t)row * 256 + cc * 8 : nullptr; });
          __syncthreads(); }
            rtg = rtgn; ct = ctn; e = en; rbeg = rbegn; rend = rendn;
    }
}

__device__ __forceinline__ void phase_moe2(const Params& p, unsigned char* smem, int l) {
    WAVE_IDS;
    int* offs = (int*)(smem + 73728);
    expert_offsets(p, l, offs);
    const int ntl = offs[64 + 32];
    const u16* A = WSP(u16, O_ACTB);
    const float sdq = fmaxf(__uint_as_float(__hip_atomic_load(WSP(unsigned, 0) + AMAX_W + 2 + l, __ATOMIC_RELAXED, __HIP_MEMORY_SCOPE_AGENT)), 1e-30f) * (1.f / (F8_TOP * ACT_F8_SCALE));
    GemmRegs g; unsigned aoff[4], boff[4];
    auto setup = [&](int it_, int& rtg_, int& ct_, int& e_, int& rbeg_, int& rend_) -> bool {
        if (!moe_tile(it_, ntl, rtg_, ct_)) return false;
        e_ = 0; while (offs[64 + e_ + 1] <= rtg_) ++e_;
        rbeg_ = offs[e_] + (rtg_ - offs[64 + e_]) * 128; rend_ = offs[e_ + 1];
#pragma unroll
        for (int i = 0; i < 4; ++i) { int r = rbeg_ + (tid >> 3) + 32 * i; r = r < rend_ ? r : rend_ - 1; aoff[i] = (unsigned)r * 256u + (tid & 7) * 8; }
        lin_off(boff, ct_ * 128, 256, 0);
        gemm_prefetch(g, A, aoff, WSP(u16, O_WD) + (size_t)e_ * 1024 * 256, boff, 4);
        return true; };
    int rtg, ct, e, rbeg, rend, rtgn = 0, ctn = 0, en = 0, rbegn = 0, rendn = 0;
    bool have = setup(0, rtg, ct, e, rbeg, rend);
    for (int it = 0; have; ++it) {
        f32x16 acc[2][2];
        gemm_run<2>(acc, g, A, aoff, WSP(u16, O_WD) + (size_t)e * 1024 * 256, boff, 4, (u16*)smem);
        have = setup(it + 1, rtgn, ctn, en, rbegn, rendn);
#pragma unroll
        for (int m = 0; m < 2; ++m)
#pragma unroll
            for (int n = 0; n < 2; ++n)
#pragma unroll
                for (int r = 0; r < 16; ++r) acc[m][n][r] *= sdq;
        epi_store_tile_lds(p.ws, acc, WSP(u16, O_YSORT), 1024, rbeg, ct * 128, rend, (u16*)smem);
            rtg = rtgn; ct = ctn; e = en; rbeg = rbegn; rend = rendn;
    }
}

__device__ __forceinline__ void phase_combine(const Params& p, unsigned char* smem, int l) {
    int* offs = (int*)(smem + 73728);
    expert_offsets(p, l, offs);
    const int lane = otid() & 63, wv = blockIdx.x * 4 + (otid() >> 6), nw = gridDim.x * 4;
    const float* g = (l == 0) ? (p.in[1] + 1024) : p.in[3];
    f32x4 gv[4];
#pragma unroll
    for (int i = 0; i < 4; ++i) gv[i] = *(const f32x4*)(g + i * 256 + lane * 4);
    const u16* ys = WSP(u16, O_YSORT);
    for (int t0 = wv * 2; t0 < T; t0 += nw * 2) {
        const int4 s0 = WSP(int4, O_SEL)[t0], s1 = WSP(int4, O_SEL)[t0 + 1];
        const int4 rr = make_int4(offs[s0.x] + s0.y, offs[s0.z] + s0.w, offs[s1.x] + s1.y, offs[s1.z] + s1.w);
        f32x4 x[2][4]; u32x2 ya[2][4], yb[2][4];
#pragma unroll
        for (int u = 0; u < 2; ++u) {
            const int r0 = u ? rr.z : rr.x, r1 = u ? rr.w : rr.y;
#pragma unroll
            for (int i = 0; i < 4; ++i) {
                x[u][i] = bf4_to_f32(*(const u32x2*)(HB(t0 + u) + i * 256 + lane * 4));
                ya[u][i] = *(const u32x2*)(ys + (size_t)r0 * 1024 + i * 256 + lane * 4); yb[u][i] = *(const u32x2*)(ys + (size_t)r1 * 1024 + i * 256 + lane * 4);
            }
        }
#pragma unroll
        for (int u = 0; u < 2; ++u) {
            const int t = t0 + u; float ss = 0.f;
#pragma unroll
            for (int i = 0; i < 4; ++i) {
                const u32x2 a = ya[u][i], c = yb[u][i];
                x[u][i][0] += bflo(a[0]) + bflo(c[0]); x[u][i][1] += bfhi(a[0]) + bfhi(c[0]); x[u][i][2] += bflo(a[1]) + bflo(c[1]); x[u][i][3] += bfhi(a[1]) + bfhi(c[1]);
                ss += x[u][i][0] * x[u][i][0] + x[u][i][1] * x[u][i][1] + x[u][i][2] * x[u][i][2] + x[u][i][3] * x[u][i][3];
            }
            ss = wave_sum(ss);
            const float rs = rsqrtf(ss * (1.f / D) + EPS);
            if (l == 0) {
#pragma unroll
                for (int i = 0; i < 4; ++i) { u32x2 o; o[0] = cvtpk(x[u][i][0], x[u][i][1]); o[1] = cvtpk(x[u][i][2], x[u][i][3]); *(u32x2*)(HB(t) + i * 256 + lane * 4) = o; }
                float am = 0.f;
#pragma unroll
                for (int i = 0; i < 4; ++i)
#pragma unroll
                    for (int c = 0; c < 4; ++c) { x[u][i][c] *= rs * gv[i][c]; am = fmaxf(am, fabsf(x[u][i][c])); }
                am = fmaxf(wave_max(am), 1e-30f);
                const float qa = 127.f / am;
#pragma unroll
                for (int i = 0; i < 4; ++i) *(unsigned*)(WSP(unsigned char, O_HA) + (size_t)t * D + i * 256 + lane * 4) = pack_i8x4(x[u][i], qa);
                if (lane == 0) WSP(float, O_SAIN)[t] = am * (1.f / 127.f);
            } else {
#pragma unroll
                for (int i = 0; i < 4; ++i) { f32x4 o; o[0] = x[u][i][0] * rs * gv[i][0]; o[1] = x[u][i][1] * rs * gv[i][1]; o[2] = x[u][i][2] * rs * gv[i][2]; o[3] = x[u][i][3] * rs * gv[i][3];
                    *(f32x4*)(p.out + (size_t)t * D + i * 256 + lane * 4) = o; }
            }
        }
    }
}

__device__ __forceinline__ void phase_inproj1(const Params& p, unsigned char* smem) {
    WAVE_IDS;
    const u16* A = WSP(u16, O_HA); const u16* B = WSP(u16, O_WIN1);
    const float swinv = sample_amax(p.in[12], (size_t)1024 * OD_IN, (float*)smem) * (1.f / WQ_TOP);
    GemmRegs g; unsigned aoff[4], boff[4];
    float sareg = 0.f; float* sl = (float*)(smem + 73728);
    int rt, ct, rtn = 0, ctn = 0; bool have = dense_tile(0, 30, rt, ct);
    if (have) { lin_off(aoff, rt * 128, 512, 0); lin_off(boff, ct * 128, 512, 0); gemm_prefetch(g, A, aoff, B, boff, 8); if (tid < 128) sareg = WSP(float, O_SAIN)[rt * 128 + tid]; }
    for (int it = 0; have; ++it) {
        const int m0 = rt * 128, n0 = ct * 128;
        f32x16 acc[2][2];
        gemm_run<1>(acc, g, A, aoff, B, boff, 8, (u16*)smem);
        if (tid < 128) sl[tid] = sareg;
        have = dense_tile(it + 1, 30, rtn, ctn);
        if (have) { lin_off(aoff, rtn * 128, 512, 0); lin_off(boff, ctn * 128, 512, 0); gemm_prefetch(g, A, aoff, B, boff, 8); if (tid < 128) sareg = WSP(float, O_SAIN)[rtn * 128 + tid]; }
        __syncthreads();
        dequant_tile(acc, sl, swinv);
        if (ct < 14) epi_store_tile_lds(p.ws, acc, WSP(u16, O_U1R), RW_IN, m0, n0, T, (u16*)smem);
        else epi_store_tile_lds(p.ws, acc, WSP(u16, O_U1H), 2048, m0, n0 - RW_IN, T, (u16*)smem);
            rt = rtn; ct = ctn;
    }
}

__device__ __forceinline__ float hgrn_lb(const Params& p, int col) { const float x0 = p.in[25][col], x1 = p.in[25][512 + col]; return 1.f / (1.f + __expf(x0 - x1)); }

__device__ __forceinline__ void phase_hgrnA(const Params& p, unsigned char* smem) {
    WAVE_IDS;
    float* bc = (float*)smem;
    u16* Kst = (u16*)(smem + 33280);
    u16* Vtl = (u16*)(smem + 33280 + 18432);
    const u16* U = WSP(u16, O_U1H);
    int* qb = (int*)(smem + 73728 + 1024);
    for (;;) {
        if (tid == 0) *qb = (int)atomicAdd(WSP(unsigned, 0) + HGA_CTR_W, 1u);
        __syncthreads();
        const int item = *qb;
        __syncthreads();
        if (item >= 2048) break;
        const int c = item & 63, bh = item >> 6, b = bh >> 2, hh = bh & 3, t0 = b * SEQ + c * 64;
#pragma unroll
        for (int i = 0; i < 4; ++i) {
            const int ch = tid + 256 * i, t = ch >> 4, d8 = (ch & 15) * 8;
            const u32x4 zv = *(const u32x4*)(U + (size_t)(t0 + t) * 2048 + 512 + hh * 128 + d8);
            const u32x4 v = *(const u32x4*)(U + (size_t)(t0 + t) * 2048 + 1024 + hh * 128 + d8);
#pragma unroll
            for (int q = 0; q < 4; ++q) {
                const float lb0 = hgrn_lb(p, hh * 128 + d8 + 2 * q), lb1 = hgrn_lb(p, hh * 128 + d8 + 2 * q + 1);
                bc[t * 129 + d8 + 2 * q] = __logf(lb0 + (1.f - lb0) * sigmoidf_(bflo(zv[q])));
                bc[t * 129 + d8 + 2 * q + 1] = __logf(lb1 + (1.f - lb1) * sigmoidf_(bfhi(zv[q])));
                Vtl[(d8 + 2 * q) * LSTR + t] = (u16)(v[q] & 0xffff); Vtl[(d8 + 2 * q + 1) * LSTR + t] = (u16)(v[q] >> 16);
            }
        }
        __syncthreads();
        { const int d = tid & 127, half = tid >> 7; float run = 0.f;
          for (int t = half * 32; t < half * 32 + 32; ++t) { run += bc[t * 129 + d]; bc[t * 129 + d] = run; }
          __syncthreads();
          if (half) { const float add = bc[31 * 129 + d]; for (int t = 32; t < 64; ++t) bc[t * 129 + d] += add; }
          __syncthreads();
          if (tid < 128) WSP(float, O_HD)[(size_t)item * 128 + d] = __expf(bc[63 * 129 + d]); }
#pragma unroll
        for (int i = 0; i < 4; ++i) {
            const int ch = tid + 256 * i, t = ch >> 4, d8 = (ch & 15) * 8;
            const u32x4 zv = *(const u32x4*)(U + (size_t)(t0 + t) * 2048 + 512 + hh * 128 + d8);
#pragma unroll
            for (int q = 0; q < 4; ++q) {
                const int d0 = d8 + 2 * q;
                const float lb0 = hgrn_lb(p, hh * 128 + d0), lb1 = hgrn_lb(p, hh * 128 + d0 + 1);
                const float f0 = lb0 + (1.f - lb0) * sigmoidf_(bflo(zv[q])), f1 = lb1 + (1.f - lb1) * sigmoidf_(bfhi(zv[q]));
                Kst[d0 * LSTR + t] = f2bf((1.f - f0) * __expf(bc[63 * 129 + d0] - bc[t * 129 + d0]));
                Kst[(d0 + 1) * LSTR + t] = f2bf((1.f - f1) * __expf(bc[63 * 129 + d0 + 1] - bc[t * 129 + d0 + 1]));
            }
        }
        __syncthreads();
        f32x16 acc[2][2];
#pragma unroll
        for (int m = 0; m < 2; ++m)
#pragma unroll
            for (int n = 0; n < 2; ++n)
#pragma unroll
                for (int r = 0; r < 16; ++r) acc[m][n][r] = 0.f;
#pragma unroll
        for (int s = 0; s < 4; ++s) {
            const bf16x8 a0 = *(const bf16x8*)(Vtl + (wr * 64 + l31) * LSTR + s * 16 + hi * 8), a1 = *(const bf16x8*)(Vtl + (wr * 64 + 32 + l31) * LSTR + s * 16 + hi * 8);
            const bf16x8 b0 = *(const bf16x8*)(Kst + (wc * 64 + l31) * LSTR + s * 16 + hi * 8), b1 = *(const bf16x8*)(Kst + (wc * 64 + 32 + l31) * LSTR + s * 16 + hi * 8);
            acc[0][0] = MFMA(a0, b0, acc[0][0]); acc[0][1] = MFMA(a0, b1, acc[0][1]); acc[1][0] = MFMA(a1, b0, acc[1][0]); acc[1][1] = MFMA(a1, b1, acc[1][1]);
        }
        __syncthreads();
        epi_store_tile_lds(p.ws, acc, WSP(u16, O_HL) + (size_t)item * 128 * 128, 128, 0, 0, 128, (u16*)smem);
    }
}
__device__ __forceinline__ void phase_hgrnB(const Params& p, unsigned char* smem) {
    int* qb = (int*)(smem + 73728 + 1024);
    for (;;) {
        if (otid() == 0) *qb = (int)atomicAdd(WSP(unsigned, 0) + HGB_CTR_W, 1u);
        __syncthreads();
        const int chunk = *qb;
        __syncthreads();
        if (chunk >= 512) break;
        const int id = chunk * 256 + otid();
        {
        const int bh = id >> 12, q = id & 4095, e = q >> 5, d4 = (q & 31) * 4;
        u16* base = WSP(u16, O_HL) + (size_t)bh * 64 * 16384 + e * 128 + d4;
        const float* dec = WSP(float, O_HD) + (size_t)bh * 64 * 128 + d4;
        float s0 = 0.f, s1 = 0.f, s2 = 0.f, s3 = 0.f;
        for (int c0 = 0; c0 < 64; c0 += 8) {
            u32x2 lv[8]; f32x4 dv[8];
#pragma unroll
            for (int i = 0; i < 8; ++i) { lv[i] = *(const u32x2*)(base + (size_t)(c0 + i) * 16384); dv[i] = *(const f32x4*)(dec + (size_t)(c0 + i) * 128); }
#pragma unroll
            for (int i = 0; i < 8; ++i) {
                u32x2 o; o[0] = cvtpk(s0, s1); o[1] = cvtpk(s2, s3);
                *(u32x2*)(base + (size_t)(c0 + i) * 16384) = o;
                s0 = dv[i][0] * s0 + bflo(lv[i][0]); s1 = dv[i][1] * s1 + bfhi(lv[i][0]); s2 = dv[i][2] * s2 + bflo(lv[i][1]); s3 = dv[i][3] * s3 + bfhi(lv[i][1]);
            }
        }
    }
    }
}
__device__ __forceinline__ void phase_hgrnC(const Params& p, unsigned char* smem) {
    WAVE_IDS;
    float* ssq = (float*)smem;
    u16* Qt = (u16*)(smem + 1024);
    u16* Kt = (u16*)(smem + 1024 + 17408);
    u16* Vtl = (u16*)(smem + 1024 + 34816);
    float* bc = (float*)(smem + 1024 + 34816);
    const u16* U = WSP(u16, O_U1H);
    int* qb = (int*)(smem + 73728 + 1024);
    for (;;) {
        if (tid == 0) *qb = (int)atomicAdd(WSP(unsigned, 0) + HGC_CTR_W, 1u);
        __syncthreads();
        const int item = *qb;
        __syncthreads();
        if (item >= 2048) break;
        const int c = item & 63, bh = item >> 6, b = bh >> 2, hh = bh & 3, t0 = b * SEQ + c * 64;
#pragma unroll
        for (int i = 0; i < 4; ++i) {
            const int ch = tid + 256 * i, t = ch >> 4, d8 = (ch & 15) * 8;
            const u32x4 zv = *(const u32x4*)(U + (size_t)(t0 + t) * 2048 + 512 + hh * 128 + d8);
#pragma unroll
            for (int q = 0; q < 4; ++q) {
                const float lb0 = hgrn_lb(p, hh * 128 + d8 + 2 * q), lb1 = hgrn_lb(p, hh * 128 + d8 + 2 * q + 1);
                bc[t * 129 + d8 + 2 * q] = __logf(lb0 + (1.f - lb0) * sigmoidf_(bflo(zv[q])));
                bc[t * 129 + d8 + 2 * q + 1] = __logf(lb1 + (1.f - lb1) * sigmoidf_(bfhi(zv[q])));
            }
        }
        __syncthreads();
        { const int d = tid & 127, half = tid >> 7; float run = 0.f;
          for (int t = half * 32; t < half * 32 + 32; ++t) { run += bc[t * 129 + d]; bc[t * 129 + d] = run; }
          __syncthreads();
          if (half) { const float add = bc[31 * 129 + d]; for (int t = 32; t < 64; ++t) bc[t * 129 + d] += add; }
          __syncthreads(); }
        u32x4 vreg[4];
#pragma unroll
        for (int i = 0; i < 4; ++i) {
            const int ch = tid + 256 * i, t = ch >> 4, d8 = (ch & 15) * 8;
            const u32x4 zv = *(const u32x4*)(U + (size_t)(t0 + t) * 2048 + 512 + hh * 128 + d8);
            const u32x4 qv = *(const u32x4*)(U + (size_t)(t0 + t) * 2048 + hh * 128 + d8);
            vreg[i] = *(const u32x4*)(U + (size_t)(t0 + t) * 2048 + 1024 + hh * 128 + d8);
            u32x4 qo, ko;
#pragma unroll
            for (int q = 0; q < 4; ++q) {
                const int d0 = d8 + 2 * q;
                const float lb0 = hgrn_lb(p, hh * 128 + d0), lb1 = hgrn_lb(p, hh * 128 + d0 + 1);
                const float f0 = lb0 + (1.f - lb0) * sigmoidf_(bflo(zv[q])), f1 = lb1 + (1.f - lb1) * sigmoidf_(bfhi(zv[q]));
                const float b0 = bc[t * 129 + d0], b1 = bc[t * 129 + d0 + 1];
                qo[q] = cvtpk(siluf_(bflo(qv[q])) * __expf(b0), siluf_(bfhi(qv[q])) * __expf(b1));
                ko[q] = cvtpk((1.f - f0) * __expf(-b0), (1.f - f1) * __expf(-b1));
            }
            *(u32x4*)(Qt + t * 136 + d8) = qo; *(u32x4*)(Kt + t * 136 + d8) = ko;
        }
        __syncthreads();
#pragma unroll
        for (int i = 0; i < 4; ++i) {
            const int ch = tid + 256 * i, t = ch >> 4, e8 = (ch & 15) * 8;
#pragma unroll
            for (int q = 0; q < 4; ++q) { Vtl[(e8 + 2 * q) * 68 + t] = (u16)(vreg[i][q] & 0xffff); Vtl[(e8 + 2 * q + 1) * 68 + t] = (u16)(vreg[i][q] >> 16); }
        }
        __syncthreads();
        f32x16 pt[2][2];
#pragma unroll
        for (int a = 0; a < 2; ++a)
#pragma unroll
            for (int c2 = 0; c2 < 2; ++c2)
#pragma unroll
                for (int r = 0; r < 16; ++r) pt[a][c2][r] = 0.f;
#pragma unroll
        for (int s = 0; s < 8; ++s) {
            const bf16x8 k0 = *(const bf16x8*)(Kt + l31 * 136 + s * 16 + hi * 8), k1 = *(const bf16x8*)(Kt + (32 + l31) * 136 + s * 16 + hi * 8);
            const bf16x8 q0 = *(const bf16x8*)(Qt + l31 * 136 + s * 16 + hi * 8), q1 = *(const bf16x8*)(Qt + (32 + l31) * 136 + s * 16 + hi * 8);
            pt[0][0] = MFMA(k0, q0, pt[0][0]); pt[0][1] = MFMA(k0, q1, pt[0][1]); pt[1][0] = MFMA(k1, q0, pt[1][0]); pt[1][1] = MFMA(k1, q1, pt[1][1]);
        }
        bf16x8 pb[2][4];
#pragma unroll
        for (int tt = 0; tt < 2; ++tt)
#pragma unroll
            for (int st = 0; st < 2; ++st) {
                float v[16];
#pragma unroll
                for (int r = 0; r < 16; ++r) { const int sidx = st * 32 + crow(r, hi), tidx = tt * 32 + l31; v[r] = (sidx <= tidx) ? pt[st][tt][r] : 0.f; }
                u32x4 w; w[0] = cvtpk(v[0], v[1]); w[1] = cvtpk(v[2], v[3]); w[2] = cvtpk(v[4], v[5]); w[3] = cvtpk(v[6], v[7]); pb[tt][st * 2] = __builtin_bit_cast(bf16x8, w);
                w[0] = cvtpk(v[8], v[9]); w[1] = cvtpk(v[10], v[11]); w[2] = cvtpk(v[12], v[13]); w[3] = cvtpk(v[14], v[15]); pb[tt][st * 2 + 1] = __builtin_bit_cast(bf16x8, w);
            }
        f32x16 o[2];
#pragma unroll
        for (int r = 0; r < 16; ++r) { o[0][r] = 0.f; o[1][r] = 0.f; }
        const u16* ST = WSP(u16, O_HL) + (size_t)item * 16384 + (size_t)(wid * 32 + l31) * 128;
#pragma unroll
        for (int s = 0; s < 8; ++s) {
            const bf16x8 a = *(const bf16x8*)(ST + s * 16 + hi * 8);
            const bf16x8 q0 = *(const bf16x8*)(Qt + l31 * 136 + s * 16 + hi * 8), q1 = *(const bf16x8*)(Qt + (32 + l31) * 136 + s * 16 + hi * 8);
            o[0] = MFMA(a, q0, o[0]); o[1] = MFMA(a, q1, o[1]);
        }
#pragma unroll
        for (int s = 0; s < 4; ++s) {
            const u16* vp = Vtl + (wid * 32 + l31) * 68 + 16 * s + 4 * hi;
            const u32x2 lo = *(const u32x2*)vp, h2 = *(const u32x2*)(vp + 8);
            const u32x4 w = {lo[0], lo[1], h2[0], h2[1]};
            o[0] = MFMA(__builtin_bit_cast(bf16x8, w), pb[0][s], o[0]); o[1] = MFMA(__builtin_bit_cast(bf16x8, w), pb[1][s], o[1]);
        }
#pragma unroll
        for (int tt = 0; tt < 2; ++tt) { float s2 = 0.f;
#pragma unroll
            for (int r = 0; r < 16; ++r) s2 += o[tt][r] * o[tt][r];
            s2 = xhalf_sum(s2);
            if (hi == 0) ssq[wid * 64 + tt * 32 + l31] = s2; }
        __syncthreads();
#pragma unroll
        for (int tt = 0; tt < 2; ++tt) {
            const int t = tt * 32 + l31;
            const float rs = rsqrtf((ssq[t] + ssq[64 + t] + ssq[128 + t] + ssq[192 + t]) * (1.f / 128.f) + EPS);
#pragma unroll
            for (int rg = 0; rg < 4; ++rg) {
                const int e = wid * 32 + 8 * rg + 4 * hi;
                const u32x2 gv = *(const u32x2*)(U + (size_t)(t0 + t) * 2048 + 1536 + hh * 128 + e);
                const f32x4 on = *(const f32x4*)(p.in[26] + hh * 128 + e);
                u32x2 w; w[0] = cvtpk(o[tt][4 * rg] * rs * on[0] * siluf_(bflo(gv[0])), o[tt][4 * rg + 1] * rs * on[1] * siluf_(bfhi(gv[0])));
                w[1] = cvtpk(o[tt][4 * rg + 2] * rs * on[2] * siluf_(bflo(gv[1])), o[tt][4 * rg + 3] * rs * on[3] * siluf_(bfhi(gv[1])));
                *(u32x2*)(WSP(u16, O_HA) + (size_t)(t0 + t) * 1024 + 512 + hh * 128 + e) = w;
            }
        }
        __syncthreads();
    }
}

__device__ __forceinline__ void phase_rwkv_prep(const Params& p) {
    const int lane = otid() & 63, wv = blockIdx.x * 4 + (otid() >> 6), nw = gridDim.x * 4;
    const u16* U = WSP(u16, O_U1R); const float* mu = p.in[14];
    for (int t = wv; t < T; t += nw) {
        const bool first = (t & (SEQ - 1)) == 0;
        { const int c = 1536 + lane * 4;
          const u32x2 a = *(const u32x2*)(U + (size_t)t * RW_IN + c); u32x2 pv = {0u, 0u}; if (!first) pv = *(const u32x2*)(U + (size_t)(t - 1) * RW_IN + c);
          const f32x4 m = *(const f32x4*)(mu + c);
          float x[4] = {bflo(a[0]), bfhi(a[0]), bflo(a[1]), bfhi(a[1])}; const float q[4] = {bflo(pv[0]), bfhi(pv[0]), bflo(pv[1]), bfhi(pv[1])};
#pragma unroll
          for (int j = 0; j < 4; ++j) { x[j] = x[j] + (q[j] - x[j]) * m[j];
              if (lane < 16) x[j] = tanhf(x[j]); else if (lane >= 32) x[j] = sigmoidf_(x[j]); }
          u32x2 o; o[0] = cvtpk(x[0], x[1]); o[1] = cvtpk(x[2], x[3]);
          *(u32x2*)(WSP(u16, O_LORA) + (size_t)t * 256 + lane * 4) = o; }
    }
}
__device__ __forceinline__ void phase_rwkv_lora(const Params& p, unsigned char* smem) {
    WAVE_IDS;
    const u16* A = WSP(u16, O_LORA);
    int rt, c12;
    for (int it = 0; dense_tile(it, 12, rt, c12); ++it) {
        const int which = c12 >> 2, ct = c12 & 3, m0 = rt * 128, n0 = ct * 128;
        unsigned aoff[4], boff[4];
        lin_off(aoff, m0, 256, which == 0 ? 0 : (which == 1 ? 64 : 128));
        const int K = which == 2 ? 128 : 64;
        lin_off(boff, n0, K, 0);
        f32x16 acc[2][2];
        gemm_mainloop(acc, A, aoff, WSP(u16, which == 0 ? O_W2T : (which == 1 ? O_A2T : O_G2T)), boff, K / 64, (u16*)smem);
        u16* dst = WSP(u16, which == 0 ? O_WD16 : (which == 1 ? O_AA16 : O_GG16));
#pragma unroll
        for (int m = 0; m < 2; ++m)
#pragma unroll
            for (int n = 0; n < 2; ++n) {
                const int col = n0 + wc * 64 + n * 32 + l31;
                const float bias = which == 0 ? p.in[15][col] : (which == 1 ? p.in[17][col] : 0.f);
#pragma unroll
                for (int r = 0; r < 16; ++r) {
                    float v = acc[m][n][r] + bias;
                    if (which == 0) v = __expf(-0.6065306597f * sigmoidf_(v));
                    else if (which == 1) v = sigmoidf_(v);
                    acc[m][n][r] = v;
                }
            }
        lds_put16<true>(acc, (u16*)smem, wr, wc, l31, hi);
        __syncthreads();
        lds_rows_store<16>(p.ws, (const u16*)smem, [=](int row, int cc) -> u16* { return dst + (size_t)(m0 + row) * 512 + n0 + cc * 8; });
        __syncthreads();
    }
}
#define DPP_ADD(x, ctrl) x += __builtin_bit_cast(float, __builtin_amdgcn_update_dpp(0, __builtin_bit_cast(int, x), ctrl, 0xf, 0xf, false))
__device__ __forceinline__ void sum32x2(float& a, float& b) {
    DPP_ADD(a, 0x128); DPP_ADD(b, 0x128); DPP_ADD(a, 0x124); DPP_ADD(b, 0x124);
    DPP_ADD(a, 0x122); DPP_ADD(b, 0x122); DPP_ADD(a, 0x121); DPP_ADD(b, 0x121);
    auto ra = __builtin_amdgcn_permlane16_swap(__float_as_uint(a), __float_as_uint(a), false, false);
    auto rb = __builtin_amdgcn_permlane16_swap(__float_as_uint(b), __float_as_uint(b), false, false);
    a = __uint_as_float(ra[0]) + __uint_as_float(ra[1]); b = __uint_as_float(rb[0]) + __uint_as_float(rb[1]);
}
__device__ __forceinline__ void sum16x2(float& a, float& b) {
    DPP_ADD(a, 0x128); DPP_ADD(b, 0x128); DPP_ADD(a, 0x124); DPP_ADD(b, 0x124);
    DPP_ADD(a, 0x122); DPP_ADD(b, 0x122); DPP_ADD(a, 0x121); DPP_ADD(b, 0x121);
}
__device__ __forceinline__ float sum16(float a) { DPP_ADD(a, 0x128); DPP_ADD(a, 0x124); DPP_ADD(a, 0x122); DPP_ADD(a, 0x121); return a; }
template <bool INNER>
__device__ __forceinline__ void phase_rwkv_rec(const Params& p, unsigned char* smem, const XcdBarrier& bar) {
    const int tid = otid(), lane = tid & 63, wid = tid >> 6, rowl = lane >> 4, j = lane & 15;
    constexpr int CH = 16;
    constexpr int BUF = CH * 6 * 64 * 4;
    int* bcast = (int*)(smem + 2 * BUF);
    unsigned* ctrl = WSP(unsigned, 0);
    if (INNER && p.solo) {
        phase_hgrnA(p, smem); xcd_barrier(bar); phase_hgrnB(p, smem); xcd_barrier(bar); phase_hgrnC(p, smem);
    }
    if (tid == 0) {
        const unsigned hw = (unsigned)__builtin_amdgcn_s_getreg((7 << 11) | (8 << 6) | 4);
        const unsigned key = (((unsigned)__builtin_amdgcn_s_getreg((3 << 11) | 20) & 0xFu) << 8) | (hw & 0xffu);
        bcast[0] = (int)atomicAdd(&ctrl[PERCU_W + key], 1u);
    }
    __syncthreads();
    const bool worker = bcast[0] == 0 || (INNER && p.solo);
    __syncthreads();
    if (!worker) {
        if (INNER) { phase_hgrnA(p, smem); xcd_barrier(bar); phase_hgrnB(p, smem); xcd_barrier(bar); phase_hgrnC(p, smem); }
        return;
    }
    int nbar = (INNER && p.solo) ? 2 : 0;
    __builtin_amdgcn_s_setprio(3);
    const u16* U = WSP(u16, O_U1R); const float* mu = p.in[14];
    for (;;) {
        if (tid == 0) bcast[0] = (int)atomicAdd(&ctrl[RWKV_TICKET_W], 1u);
        __syncthreads();
        const int item = bcast[0];
        __syncthreads();
        if (item >= 256) break;
        const int bh = item >> 2, rgp = item & 3, b = bh >> 3, h8 = bh & 7;
        const int row = rgp * 16 + wid * 4 + rowl;
        const size_t tb0 = (size_t)b * SEQ;
        const int ss_ = tid >> 4, k4 = (tid & 15) * 4;
        float mrv[4], mkv[4], mvv[4], kav[4], kkv[4];
#pragma unroll
        for (int q = 0; q < 4; ++q) { mrv[q] = mu[h8 * 64 + k4 + q]; mkv[q] = mu[512 + h8 * 64 + k4 + q]; mvv[q] = mu[1024 + h8 * 64 + k4 + q]; kav[q] = p.in[21][h8 * 64 + k4 + q]; kkv[q] = p.in[20][h8 * 64 + k4 + q]; }
        u32x2 r_c, k_c, v_c, r_p, k_p, v_p, w_c, a_c;
        auto sload = [&](int ch) {
            const int tl = ch * CH + ss_; const size_t t = tb0 + tl;
            const u16* ur = U + t * RW_IN + h8 * 64 + k4;
            r_c = *(const u32x2*)ur; k_c = *(const u32x2*)(ur + 512); v_c = *(const u32x2*)(ur + 1024);
            r_p = (u32x2){0u, 0u}; k_p = r_p; v_p = r_p;
            if (tl > 0) { r_p = *(const u32x2*)(ur - RW_IN); k_p = *(const u32x2*)(ur - RW_IN + 512); v_p = *(const u32x2*)(ur - RW_IN + 1024); }
            w_c = *(const u32x2*)(WSP(h16, O_WD16) + t * 512 + h8 * 64 + k4);
            a_c = *(const u32x2*)(WSP(h16, O_AA16) + t * 512 + h8 * 64 + k4);
        };
        auto swrite = [&](int buf) {
            const h16* wh = (const h16*)&w_c; const h16* ah = (const h16*)&a_c;
            float* bb = (float*)(smem + buf * BUF) + ss_ * 384 + k4;
            float rr[4], kk_[4], vv[4];
#pragma unroll
            for (int q = 0; q < 2; ++q) {
                float x0 = bflo(r_c[q]), x1 = bfhi(r_c[q]); rr[2 * q] = x0 + (bflo(r_p[q]) - x0) * mrv[2 * q]; rr[2 * q + 1] = x1 + (bfhi(r_p[q]) - x1) * mrv[2 * q + 1];
                x0 = bflo(k_c[q]); x1 = bfhi(k_c[q]); kk_[2 * q] = x0 + (bflo(k_p[q]) - x0) * mkv[2 * q]; kk_[2 * q + 1] = x1 + (bfhi(k_p[q]) - x1) * mkv[2 * q + 1];
                x0 = bflo(v_c[q]); x1 = bfhi(v_c[q]); vv[2 * q] = x0 + (bflo(v_p[q]) - x0) * mvv[2 * q]; vv[2 * q + 1] = x1 + (bfhi(v_p[q]) - x1) * mvv[2 * q + 1];
            }
            float kn[4]; float ssq = 0.f;
#pragma unroll
            for (int q = 0; q < 4; ++q) { kn[q] = kk_[q] * kkv[q]; ssq += kn[q] * kn[q]; }
            ssq = sum16(ssq);
            const float rn = rsqrtf(fmaxf(ssq, 1e-24f));
            f32x4 ow, on, ob, ok;
#pragma unroll
            for (int q = 0; q < 4; ++q) { const float a = (float)ah[q], n = kn[q] * rn; ow[q] = (float)wh[q]; on[q] = -n; ob[q] = n * a; ok[q] = kk_[q] * (1.f + (a - 1.f) * kav[q]); }
            *(f32x4*)(bb) = ow; *(f32x4*)(bb + 64) = on; *(f32x4*)(bb + 128) = ob; *(f32x4*)(bb + 192) = ok;
            *(f32x4*)(bb + 256) = (f32x4){rr[0], rr[1], rr[2], rr[3]}; *(f32x4*)(bb + 320) = (f32x4){vv[0], vv[1], vv[2], vv[3]};
        };
        sload(0); swrite(0);
        __syncthreads();
        f32x4 S = {0.f, 0.f, 0.f, 0.f};
        float ykeep = 0.f;
        for (int ch = 0; ch < SEQ / CH; ++ch) {
            const int cur = ch & 1;
            if (INNER && nbar < 2 && ch == (nbar == 0 ? 75 : 155)) { xcd_barrier(bar); ++nbar; }
            if (ch + 1 < SEQ / CH) sload(ch + 1);
            __builtin_amdgcn_sched_barrier(0);
            const float* bb = (const float*)(smem + cur * BUF) + j * 4;
            const float* vs = (const float*)(smem + cur * BUF) + 320 + row;
#define RW_LOAD(W, N, B_, K_, R, V, S_) { const float* q = bb + (S_) * 384; W = *(const f32x4*)q; N = *(const f32x4*)(q + 64); B_ = *(const f32x4*)(q + 128); K_ = *(const f32x4*)(q + 192); R = *(const f32x4*)(q + 256); V = vs[(S_) * 384]; }
#define RW_STEP(W, N, B_, K_, R, V, S_) { \
                float pa = S[0] * N[0]; pa = fmaf(S[1], N[1], pa); pa = fmaf(S[2], N[2], pa); pa = fmaf(S[3], N[3], pa); \
                if ((S_) > 0) { sum16x2(pa, pbk); ykeep = (j == (S_) - 1) ? pbk : ykeep; } else pa = sum16(pa); \
                S[0] = fmaf(pa, B_[0], fmaf(S[0], W[0], V * K_[0])); S[1] = fmaf(pa, B_[1], fmaf(S[1], W[1], V * K_[1])); \
                S[2] = fmaf(pa, B_[2], fmaf(S[2], W[2], V * K_[2])); S[3] = fmaf(pa, B_[3], fmaf(S[3], W[3], V * K_[3])); \
                pbk = S[0] * R[0]; pbk = fmaf(S[1], R[1], pbk); pbk = fmaf(S[2], R[2], pbk); pbk = fmaf(S[3], R[3], pbk); }
            f32x4 aw, an, ab, ak, ar, bw, bn, bb_, bk, br; float av, bv, pbk = 0.f;
            RW_LOAD(aw, an, ab, ak, ar, av, 0);
#pragma unroll
            for (int s = 0; s < CH; s += 2) {
                RW_LOAD(bw, bn, bb_, bk, br, bv, s + 1);
                RW_STEP(aw, an, ab, ak, ar, av, s);
                if (s + 2 < CH) { RW_LOAD(aw, an, ab, ak, ar, av, s + 2); }
                RW_STEP(bw, bn, bb_, bk, br, bv, s + 1);
            }
            pbk = sum16(pbk); ykeep = (j == CH - 1) ? pbk : ykeep;
            WSP(u16, O_YRAW)[(tb0 + ch * CH + j) * 512 + h8 * 64 + row] = f2bf(ykeep);
            __builtin_amdgcn_sched_barrier(0);
            if (ch + 1 < SEQ / CH) swrite(cur ^ 1);
            __syncthreads();
        }
    }
    __builtin_amdgcn_s_setprio(0);
    if (INNER) { while (nbar < 2) { xcd_barrier(bar); ++nbar; } }
}
__device__ __forceinline__ void phase_rwkv_fin(const Params& p) {
    const int lane = otid() & 63, wv = blockIdx.x * 4 + (otid() >> 6), nw = gridDim.x * 4;
    const u16* U = WSP(u16, O_U1R); const float* mu = p.in[14];
    const int c = lane * 8;
    float lw[8], lbv[8], rk[8], ka[8], mr[8], mk[8], mv[8];
#pragma unroll
    for (int q = 0; q < 8; ++q) { lw[q] = p.in[23][c + q]; lbv[q] = p.in[24][c + q]; rk[q] = p.in[22][c + q]; ka[q] = p.in[21][c + q]; mr[q] = mu[c + q]; mk[q] = mu[512 + c + q]; mv[q] = mu[1024 + c + q]; }
    for (int t = wv; t < T; t += nw) {
        const bool first = (t & (SEQ - 1)) == 0;
        const u16* ur = U + (size_t)t * RW_IN + c;
        const u32x4 r_c = *(const u32x4*)ur, k_c = *(const u32x4*)(ur + 512), v_c = *(const u32x4*)(ur + 1024);
        u32x4 r_p = {0u, 0u, 0u, 0u}, k_p = r_p, v_p = r_p;
        if (!first) { r_p = *(const u32x4*)(ur - RW_IN); k_p = *(const u32x4*)(ur - RW_IN + 512); v_p = *(const u32x4*)(ur - RW_IN + 1024); }
        const u32x4 a_c = *(const u32x4*)(WSP(h16, O_AA16) + (size_t)t * 512 + c), g_c = *(const u32x4*)(WSP(h16, O_GG16) + (size_t)t * 512 + c);
        const u32x4 y_c = *(const u32x4*)(WSP(u16, O_YRAW) + (size_t)t * 512 + c);
        const h16* ah = (const h16*)&a_c; const h16* gh = (const h16*)&g_c;
        float y[8], vv[8]; float sm = 0.f, bon = 0.f;
#pragma unroll
        for (int q = 0; q < 4; ++q) {
            y[2 * q] = bflo(y_c[q]); y[2 * q + 1] = bfhi(y_c[q]); sm += y[2 * q] + y[2 * q + 1];
            float x0 = bflo(r_c[q]), x1 = bfhi(r_c[q]); const float r0 = x0 + (bflo(r_p[q]) - x0) * mr[2 * q], r1 = x1 + (bfhi(r_p[q]) - x1) * mr[2 * q + 1];
            x0 = bflo(k_c[q]); x1 = bfhi(k_c[q]); float k0 = x0 + (bflo(k_p[q]) - x0) * mk[2 * q], k1 = x1 + (bfhi(k_p[q]) - x1) * mk[2 * q + 1];
            k0 *= 1.f + ((float)ah[2 * q] - 1.f) * ka[2 * q]; k1 *= 1.f + ((float)ah[2 * q + 1] - 1.f) * ka[2 * q + 1];
            x0 = bflo(v_c[q]); x1 = bfhi(v_c[q]); vv[2 * q] = x0 + (bflo(v_p[q]) - x0) * mv[2 * q]; vv[2 * q + 1] = x1 + (bfhi(v_p[q]) - x1) * mv[2 * q + 1];
            bon += r0 * k0 * rk[2 * q] + r1 * k1 * rk[2 * q + 1];
        }
        sm += __shfl_xor(sm, 1); sm += __shfl_xor(sm, 2); sm += __shfl_xor(sm, 4);
        bon += __shfl_xor(bon, 1); bon += __shfl_xor(bon, 2); bon += __shfl_xor(bon, 4);
        const float mean = sm * (1.f / 64.f);
        float var = 0.f;
#pragma unroll
        for (int q = 0; q < 8; ++q) { const float dd = y[q] - mean; var += dd * dd; }
        var += __shfl_xor(var, 1); var += __shfl_xor(var, 2); var += __shfl_xor(var, 4);
        const float rs = rsqrtf(var * (1.f / 64.f) + 64e-5f);
        float o[8];
#pragma unroll
        for (int q = 0; q < 8; ++q) o[q] = ((y[q] - mean) * rs * lw[q] + lbv[q] + bon * vv[q]) * (float)gh[q];
        u32x4 w; w[0] = cvtpk(o[0], o[1]); w[1] = cvtpk(o[2], o[3]); w[2] = cvtpk(o[4], o[5]); w[3] = cvtpk(o[6], o[7]);
        *(u32x4*)(WSP(u16, O_HA) + (size_t)t * 1024 + c) = w;
    }
}

#ifndef REPEAT_MASK
#define REPEAT_MASK 0
#endif
#if MEGA
constexpr int NPHASE = 19;
#else
constexpr int NPHASE = 24;
#endif
template <int PH> __device__ __forceinline__ void run_phase(const Params& p, unsigned char* smem, const XcdBarrier& bar) {
    if constexpr (PH == 0) phase_prologue(p, smem);
    else if constexpr (PH == 1) phase_inproj0(p, smem);
    else if constexpr (PH == 2) phase_upproj(p, smem);
    else if constexpr (PH == 3) phase_attn(p, smem);
    else if constexpr (PH == 4) phase_outproj(p, smem, 0);
    else if constexpr (PH == 5) phase_route(p, smem, 0);
    else if constexpr (PH == 6) phase_moe1(p, smem, 0);
    else if constexpr (PH == 7) phase_moe2(p, smem, 0);
    else if constexpr (PH == 8) phase_combine(p, smem, 0);
    else if constexpr (PH == 9) phase_inproj1(p, smem);
    else if constexpr (PH == 10) phase_rwkv_prep(p);
    else if constexpr (PH == 11) phase_rwkv_lora(p, smem);
#if MEGA
    else if constexpr (PH == 12) phase_rwkv_rec<true>(p, smem, bar);
    else if constexpr (PH == 13) phase_rwkv_fin(p);
    else if constexpr (PH == 14) phase_outproj(p, smem, 1);
    else if constexpr (PH == 15) phase_route(p, smem, 1);
    else if constexpr (PH == 16) phase_moe1(p, smem, 1);
    else if constexpr (PH == 17) phase_moe2(p, smem, 1);
    else if constexpr (PH == 18) phase_combine(p, smem, 1);
#else
    else if constexpr (PH == 13) phase_hgrnA(p, smem);
    else if constexpr (PH == 14) phase_hgrnB(p, smem);
    else if constexpr (PH == 15) phase_hgrnC(p, smem);
    else if constexpr (PH == 16) phase_rwkv_rec<false>(p, smem, bar);
    else if constexpr (PH == 17) phase_rwkv_fin(p);
    else if constexpr (PH == 18) phase_outproj(p, smem, 1);
    else if constexpr (PH == 19) phase_route(p, smem, 1);
    else if constexpr (PH == 20) phase_lists(p, smem, 1);
    else if constexpr (PH == 21) phase_moe1(p, smem, 1);
    else if constexpr (PH == 22) phase_moe2(p, smem, 1);
    else if constexpr (PH == 23) phase_combine(p, 1);
#endif
}

template <int PH> __global__ void __launch_bounds__(256, 2) k_phase(Params p) {
    __shared__ __attribute__((aligned(16))) unsigned char smem[SMEM_BYTES];
    run_phase<PH>(p, smem);
}


#if MEGA
template <int PH> __device__ __forceinline__ void run_all(const Params& p, unsigned char* smem, const XcdBarrier& bar) {
    run_phase<PH>(p, smem, bar);
    if constexpr (((REPEAT_MASK >> PH) & 1) != 0) { xcd_barrier(bar); run_phase<PH>(p, smem, bar); }
    if constexpr (PH + 1 < NPHASE) { xcd_barrier(bar); run_all<PH + 1>(p, smem, bar); }
}
__global__ void __launch_bounds__(256, 2) k_mega(Params p) {
    __shared__ __attribute__((aligned(16))) unsigned char smem[SMEM_BYTES];
    __shared__ uint4 xb_words;
    if (threadIdx.x == 0) xb_words = make_uint4(0u, 0u, 0u, 0u);
    __syncthreads();
    XcdBarrier bar = xcd_barrier_post((unsigned*)p.ws, (volatile LAS unsigned*)&xb_words);
    run_all<0>(p, smem, bar);
}
#endif
template <int PH> static void launch_phase(const Params& p, hipStream_t stream) {
    hipLaunchKernelGGL((k_phase<PH>), dim3(512), dim3(256), 0, stream, p);
}
template <int... I> static void launch_all(const Params& p, hipStream_t stream, std::integer_sequence<int, I...>) { (launch_phase<I>(p, stream), ...); }

extern "C" void kernel_launch(void* const* d_in, const int* in_sizes, int n_in, void* d_out, int out_size, void* d_ws, size_t ws_size, hipStream_t stream) {
    Params p;
    memset(&p, 0, sizeof(p));
    for (int i = 0; i < 34; ++i) p.in[i] = (const float*)d_in[i];
    p.out = (float*)d_out; p.ws = (unsigned char*)d_ws;
    if (ws_size < WS_TOTAL) { fprintf(stderr, "workspace too small: %zu < %zu\n", ws_size, (size_t)WS_TOTAL); return; }
    (void)hipMemsetAsync(d_ws, 0, CTRL_BYTES, stream);
#if MEGA
    static int grid = 0, solo = 0;
    if (!grid) {
        int dev = 0, cus = 0, per_cu = 0;
        (void)hipGetDevice(&dev);
        (void)hipDeviceGetAttribute(&cus, hipDeviceAttributeMultiprocessorCount, dev);
        (void)hipOccupancyMaxActiveBlocksPerMultiprocessor(&per_cu, k_mega, 256, 0);
        if (per_cu > 2) per_cu = 2;
        if (per_cu < 1) per_cu = 1;
        grid = cus * per_cu;
        if (grid > 512) grid = 512;
        solo = per_cu < 2;
    }
    p.solo = solo;
    hipLaunchKernelGGL(k_mega, dim3(grid), dim3(256), 0, stream, p);
#else
    launch_all(p, stream, std::make_integer_sequence<int, NPHASE>{});
#endif
}
```

```cpp
#include <hip/hip_runtime.h>
#include <stdint.h>
#include <stdio.h>
#include <string.h>
#include <utility>

#ifndef MEGA
#define MEGA 1
#endif

typedef unsigned short u16;
typedef short bf16x8 __attribute__((ext_vector_type(8)));
typedef short s16x4 __attribute__((ext_vector_type(4)));
typedef float f32x16 __attribute__((ext_vector_type(16)));
typedef float f32x4 __attribute__((ext_vector_type(4)));
typedef float f32x2 __attribute__((ext_vector_type(2)));
typedef unsigned u32x4 __attribute__((ext_vector_type(4)));
typedef unsigned u32x2 __attribute__((ext_vector_type(2)));
typedef _Float16 h16;

constexpr int NB = 8, SEQ = 4096, T = NB * SEQ, D = 1024;
constexpr int EV_IN = 2080, EV_INP = 2176;
constexpr int OD_IN = 3840, RW_IN = 1792;
constexpr float EPS = 1e-6f;
constexpr float LOG2E = 1.4426950408889634f;
constexpr float QSCALE_M = 0.10206207261596577f * LOG2E;
constexpr float QSCALE_D = 0.125f * LOG2E;

constexpr size_t CTRL_BYTES = 65536;
constexpr int    ROWSC_LDS = 40960;
constexpr int    RWKV_TICKET_W = 4608;
constexpr int    CONV1_CTR_W = 4672;
constexpr int    CONV0_CTR_W = 4736;
constexpr int    HGA_CTR_W = 4800, HGB_CTR_W = 4864, HGC_CTR_W = 4928;
constexpr int    PERCU_W = 8192;
constexpr int    ATTN_CTR_W = 4096;
constexpr int    CNT_W      = 4352;
constexpr int    AMAX_W     = 4992;
constexpr float  F8_TOP     = 224.f;
constexpr float  V_F8_SCALE = 16.f;
constexpr float  ACT_F8_SCALE = 16.f;
constexpr float  WQ_TOP     = 127.f;
constexpr size_t O_WIN0  = CTRL_BYTES;
constexpr size_t O_WQ    = O_WIN0  + (size_t)EV_INP * 1024 * 2;
constexpr size_t O_WKV   = O_WQ    + (size_t)768 * 256 * 2;
constexpr size_t O_WOUT0 = O_WKV   + (size_t)1024 * 256 * 2;
constexpr size_t O_WIN1  = O_WOUT0 + (size_t)1024 * 1024 * 2;
constexpr size_t O_WOUT1 = O_WIN1  + (size_t)OD_IN * 1024 * 2;
constexpr size_t O_W2T   = O_WOUT1 + (size_t)1024 * 1024 * 2;
constexpr size_t O_A2T   = O_W2T   + (size_t)512 * 64 * 2;
constexpr size_t O_G2T   = O_A2T   + (size_t)512 * 64 * 2;
constexpr size_t O_WR    = O_G2T   + (size_t)512 * 128 * 2;
constexpr size_t O_ROPED = O_WR    + (size_t)2 * 128 * 1024 * 2;
constexpr size_t O_ROPEM = O_ROPED + (size_t)4096 * 32 * 8;
constexpr size_t O_MOEW  = O_ROPEM + (size_t)4096 * 16 * 8;
constexpr size_t O_WGU   = O_MOEW;
constexpr size_t O_WD    = O_WGU + (size_t)32 * 1024 * 1024 * 2;
constexpr size_t MOEW_BYTES = (size_t)32 * 1024 * 1024 * 2 + (size_t)32 * 1024 * 512 * 2;
constexpr size_t O_A12   = O_MOEW;
constexpr size_t O_HL    = O_MOEW;
constexpr size_t O_ACT   = O_MOEW + MOEW_BYTES;
constexpr size_t O_HA    = O_ACT;
constexpr size_t O_CLAT  = O_ACT + (size_t)T * 1024 * 2;
constexpr size_t O_QM    = O_CLAT + (size_t)T * 512 * 2;
constexpr size_t O_KM    = O_QM + (size_t)T * 8 * 96 * 2;
constexpr size_t O_VTM   = O_KM + (size_t)T * 8 * 96 * 2;
constexpr size_t O_QD    = O_VTM + (size_t)T * 512 * 2;
constexpr size_t O_KD    = O_QD + (size_t)T * 512 * 2;
constexpr size_t O_VTD   = O_KD + (size_t)T * 512 * 2;
constexpr size_t ACT_L0_END = O_VTD + (size_t)T * 512 * 2;
constexpr size_t O_YRAW  = ACT_L0_END;
constexpr size_t O_ACTB  = O_ACT + (size_t)T * 1024 * 2;
constexpr size_t O_YSORT = O_ACTB + (size_t)2 * T * 512 * 2;
constexpr size_t O_SEL   = O_YSORT + (size_t)2 * T * 1024 * 2;
constexpr size_t O_GATES = O_SEL + (size_t)T * 16;
constexpr size_t O_TOKROW= O_GATES + (size_t)T * 8;
constexpr size_t O_GATEROW = O_TOKROW + (size_t)2 * T * 4;
constexpr size_t O_ROWTOK= O_GATEROW + (size_t)2 * T * 4;
constexpr size_t O_A8    = O_ACT + (size_t)260 * 1024 * 1024;
constexpr size_t O_SA8   = O_A8 + (size_t)T * 1024;
constexpr size_t O_GSROW = O_SA8 + (size_t)T * 4;
constexpr size_t O_TOK2  = O_GSROW + (size_t)2 * T * 8;
constexpr size_t O_GS2   = O_TOK2 + (size_t)32 * T * 4;
constexpr size_t O_U1R   = O_ACT + (size_t)T * 1024 * 2;
constexpr size_t O_U1H   = O_U1R + (size_t)T * RW_IN * 2;
constexpr size_t O_WD16  = O_MOEW + (size_t)2048 * 128 * 128 * 2;
constexpr size_t O_ATTSCR = ACT_L0_END + (size_t)T * 512 * 2;
constexpr size_t O_LORA  = O_U1H + (size_t)T * 2048 * 2;
constexpr size_t O_AA16  = O_ATTSCR;
constexpr size_t O_GG16  = O_AA16 + (size_t)T * 512 * 2;
constexpr size_t O_HD    = O_GG16 + (size_t)T * 512 * 2;
constexpr size_t O_SAIN  = O_HD + (size_t)2048 * 128 * 4;
constexpr size_t WS_TOTAL = O_SAIN + (size_t)T * 4;


struct Params { const float* in[34]; float* out; unsigned char* ws; int solo; int pad; };

#define WSP(type, off) ((type*)(p.ws + (off)))
#define HB(t) ((u16*)p.out + (size_t)(t) * 2048)

__device__ __forceinline__ int otid() { int z; asm volatile("v_mov_b32 %0, 0" : "=v"(z)); return (int)threadIdx.x + z; }
typedef __bf16 v2bf __attribute__((ext_vector_type(2)));
__device__ __forceinline__ unsigned cvtpk(float lo, float hi) { v2bf v = {(__bf16)lo, (__bf16)hi}; return __builtin_bit_cast(unsigned, v); }
__device__ __forceinline__ u16 f2bf(float x) { return __builtin_bit_cast(u16, (__bf16)x); }
__device__ __forceinline__ float bf2f(u16 b) { return __uint_as_float(((unsigned)b) << 16); }
__device__ __forceinline__ float bflo(unsigned w) { return __uint_as_float(w << 16); }
__device__ __forceinline__ float bfhi(unsigned w) { return __uint_as_float(w & 0xffff0000u); }
__device__ __forceinline__ f32x4 bf4_to_f32(const u32x2 w) { return (f32x4){bflo(w[0]), bfhi(w[0]), bflo(w[1]), bfhi(w[1])}; }
__device__ __forceinline__ int crow(int r, int hi) { return (r & 3) + 8 * (r >> 2) + 4 * hi; }
__device__ __forceinline__ float wave_sum(float v) {
#pragma unroll
    for (int o = 32; o; o >>= 1) v += __shfl_xor(v, o);
    return v;
}
__device__ __forceinline__ float wave_max(float v) {
#pragma unroll
    for (int o = 32; o; o >>= 1) v = fmaxf(v, __shfl_xor(v, o));
    return v;
}
__device__ __forceinline__ float sigmoidf_(float x) { return __builtin_amdgcn_rcpf(1.f + __expf(-x)); }
__device__ __forceinline__ float siluf_(float x) { return x * __builtin_amdgcn_rcpf(1.f + __expf(-x)); }
__device__ __forceinline__ float xhalf_sum(float x) { auto rr = __builtin_amdgcn_permlane32_swap(__float_as_uint(x), __float_as_uint(x), false, false); return __uint_as_float(rr[0]) + __uint_as_float(rr[1]); }
__device__ __forceinline__ float xhalf_max(float x) { auto rr = __builtin_amdgcn_permlane32_swap(__float_as_uint(x), __float_as_uint(x), false, false); return fmaxf(__uint_as_float(rr[0]), __uint_as_float(rr[1])); }
#define MFMA(a, b, c) __builtin_amdgcn_mfma_f32_32x32x16_bf16((a), (b), (c), 0, 0, 0)
typedef int i32x4v __attribute__((ext_vector_type(4)));
typedef int i32x16v __attribute__((ext_vector_type(16)));
typedef int i32x8v __attribute__((ext_vector_type(8)));
__device__ __forceinline__ float f8clamp(float v) { return fminf(fmaxf(v, -448.f), 448.f); }
__device__ __forceinline__ f32x16 mma_f8(const u32x4 alo, const u32x4 ahi, const u32x4 blo, const u32x4 bhi, const f32x16 c) {
    const i32x8v a = __builtin_shufflevector(__builtin_bit_cast(i32x4v, alo), __builtin_bit_cast(i32x4v, ahi), 0, 1, 2, 3, 4, 5, 6, 7);
    const i32x8v b = __builtin_shufflevector(__builtin_bit_cast(i32x4v, blo), __builtin_bit_cast(i32x4v, bhi), 0, 1, 2, 3, 4, 5, 6, 7);
    return __builtin_amdgcn_mfma_scale_f32_32x32x64_f8f6f4(a, b, c, 0, 0, 0, 0, 0, 0);
}
template <int MODE>
__device__ __forceinline__ f32x16 mma(const bf16x8 a, const bf16x8 b, const f32x16 c) {
    if constexpr (MODE == 0) return MFMA(a, b, c);
    else return __builtin_bit_cast(f32x16, __builtin_amdgcn_mfma_i32_32x32x32_i8(__builtin_bit_cast(i32x4v, a), __builtin_bit_cast(i32x4v, b), __builtin_bit_cast(i32x16v, c), 0, 0, 0));
}

#define XB_TMO      128
#define XB_XCNT(j)  (256  + 64 * (j))
#define XB_XSUB(j)  (1280 + 64 * (j))
#define XB_XGEN(j)  (2304 + 64 * (j))
#define XB_TOP      3328
#define XB_TOPGEN   3392
#define XCD_BAR_WORDS 3456
#define XB_SPIN_CAP (1u << 18)
#define LAS __attribute__((address_space(3)))

__device__ __forceinline__ unsigned xb_ld(unsigned* p)              { return __hip_atomic_load(p, __ATOMIC_RELAXED, __HIP_MEMORY_SCOPE_AGENT); }
__device__ __forceinline__ unsigned xb_add(unsigned* p, unsigned v) { return __hip_atomic_fetch_add(p, v, __ATOMIC_RELAXED, __HIP_MEMORY_SCOPE_AGENT); }
__device__ __forceinline__ unsigned xb_xcc_id() { return (unsigned)__builtin_amdgcn_s_getreg((3 << 11) | 20) & 0xFu; }
#define XB_SPIN(cond, bar) do { unsigned _sp = 0; while (cond) { __builtin_amdgcn_s_sleep(1); \
    if ((++_sp & 255u) == 0u) { if (xb_ld(&(bar)[XB_TMO])) break; if (_sp > XB_SPIN_CAP) { atomicAdd(&(bar)[XB_TMO], 1u); break; } } } } while (0)

struct XcdBarrier {
    unsigned* bar; unsigned x;
    volatile LAS unsigned* st;
};

__device__ __forceinline__ XcdBarrier xcd_barrier_post(unsigned* bar, volatile LAS unsigned* st) {
    XcdBarrier b; b.bar = bar; b.x = xb_xcc_id(); b.st = st;
    if (threadIdx.x == 0) (void)xb_add(&bar[XB_XCNT(b.x)], 1u);
    return b;
}
__device__ __forceinline__ void xcd_barrier_complete(unsigned* bar, unsigned x, unsigned& nloc, unsigned& nx) {
    const unsigned G = gridDim.x * gridDim.y * gridDim.z;
    unsigned sum, cnt, mine, sp = 0u;
    for (;;) {
        sum = 0u; cnt = 0u; mine = 0u;
#pragma unroll
        for (unsigned j = 0; j < 16; ++j) { const unsigned c = xb_ld(&bar[XB_XCNT(j)]); sum += c; cnt += (c > 0u) ? 1u : 0u; mine = (j == x) ? c : mine; }
        if (sum == G) break;
        __builtin_amdgcn_s_sleep(1);
        if ((++sp & 255u) == 0u) { if (xb_ld(&bar[XB_TMO])) break; if (sp > XB_SPIN_CAP) { atomicAdd(&bar[XB_TMO], 1u); break; } }
    }
    nloc = mine > 0u ? mine : 1u; nx = cnt > 0u ? cnt : 1u;
}

__device__ __forceinline__ void xcd_barrier(const XcdBarrier& b) {
    asm volatile("s_waitcnt vmcnt(0)" ::: "memory");
    __syncthreads();
    if (threadIdx.x == 0) {
        unsigned* bar = b.bar;
        __builtin_amdgcn_s_waitcnt(0);
        unsigned nloc = b.st[0], nx = b.st[1];
        if (nloc == 0u) { xcd_barrier_complete(bar, b.x, nloc, nx); b.st[0] = nloc; b.st[1] = nx; }
        const unsigned old = xb_add(&bar[XB_XSUB(b.x)], 1u);
        const unsigned gen = old / nloc;
        if (old + 1u == (gen + 1u) * nloc) {
            __builtin_amdgcn_fence(__ATOMIC_RELEASE, "agent");
            asm volatile("s_waitcnt vmcnt(0)" ::: "memory");
            const unsigned og = xb_add(&bar[XB_TOP], 1u);
            const unsigned tg = og / nx;
            if (og + 1u == (tg + 1u) * nx) xb_add(&bar[XB_TOPGEN], 1u);
            else XB_SPIN(xb_ld(&bar[XB_TOPGEN]) == tg, bar);
            __builtin_amdgcn_fence(__ATOMIC_ACQUIRE, "agent");
            xb_add(&bar[XB_XGEN(b.x)], 1u);
            asm volatile("s_waitcnt vmcnt(0)" ::: "memory");
        } else {
            XB_SPIN(xb_ld(&bar[XB_XGEN(b.x)]) == gen, bar);
            __builtin_amdgcn_fence(__ATOMIC_ACQUIRE, "agent");
            asm volatile("s_waitcnt vmcnt(0)" ::: "memory");
        }
    }
    __syncthreads();
}


constexpr int SMEM_BYTES = 75776;
constexpr int LSTR = 72;
constexpr int TILE_E = 128 * LSTR;

struct GemmRegs { u32x4 ra0[4], rb0[4], ra1[4], rb1[4]; };
#define G_LOAD(RA, RB, KT) _Pragma("unroll") for (int i = 0; i < 4; ++i) { RA[i] = *(const u32x4*)(A + aoff[i] + (KT) * 64); RB[i] = *(const u32x4*)(B + boff[i] + (KT) * 64); }
__device__ __forceinline__ void gemm_prefetch(GemmRegs& g, const u16* __restrict__ A, const unsigned (&aoff)[4], const u16* __restrict__ B, const unsigned (&boff)[4], int nk) {
    G_LOAD(g.ra0, g.rb0, 0);
    if (nk > 1) { G_LOAD(g.ra1, g.rb1, 1); }
}
template <int MODE = 0>
__device__ __forceinline__ void gemm_run(f32x16 (&acc)[2][2], GemmRegs& g, const u16* __restrict__ A, const unsigned (&aoff)[4],
                                         const u16* __restrict__ B, const unsigned (&boff)[4], int nk, u16* smem) {
    const int tid = otid(), lane = tid & 63, wid = tid >> 6, wr = wid >> 1, wc = wid & 1, l31 = lane & 31, hi = lane >> 5;
    u16* As = smem; u16* Bs = smem + 2 * TILE_E;
    const int st_off = (tid >> 3) * LSTR + (tid & 7) * 8;
    const int a_rd = (wr * 64 + l31) * LSTR + hi * 8, b_rd = (wc * 64 + l31) * LSTR + hi * 8;
#pragma unroll
    for (int m = 0; m < 2; ++m)
#pragma unroll
        for (int n = 0; n < 2; ++n)
#pragma unroll
            for (int r = 0; r < 16; ++r) acc[m][n][r] = 0.f;
#define G_STORE(RA, RB, BUF) _Pragma("unroll") for (int i = 0; i < 4; ++i) { *(u32x4*)(As + (BUF) * TILE_E + st_off + i * 32 * LSTR) = RA[i]; *(u32x4*)(Bs + (BUF) * TILE_E + st_off + i * 32 * LSTR) = RB[i]; }
    const int a_rd8 = (wr * 64 + l31) * LSTR + hi * 16, b_rd8 = (wc * 64 + l31) * LSTR + hi * 16;
    (void)a_rd8; (void)b_rd8;
#define G_STEP(BUF, ST, RA, RB, SBUF, LD, LA, LB, LKT) { const u16* Ab = As + (BUF) * TILE_E; const u16* Bb = Bs + (BUF) * TILE_E; const bool st_ = (ST), ld_ = (LD); __builtin_amdgcn_s_setprio(1); \
        if constexpr (MODE == 2) { \
            u32x4 f[2][8]; \
            { const u16* pa = Ab + a_rd8; const u16* pb = Bb + b_rd8; \
              f[0][0] = *(const u32x4*)pa; f[0][1] = *(const u32x4*)(pa + 8); f[0][2] = *(const u32x4*)(pa + 32 * LSTR); f[0][3] = *(const u32x4*)(pa + 32 * LSTR + 8); \
              f[0][4] = *(const u32x4*)pb; f[0][5] = *(const u32x4*)(pb + 8); f[0][6] = *(const u32x4*)(pb + 32 * LSTR); f[0][7] = *(const u32x4*)(pb + 32 * LSTR + 8); } \
            _Pragma("unroll") for (int s = 0; s < 2; ++s) { \
                if (s == 0) { const u16* pa = Ab + a_rd8 + 32; const u16* pb = Bb + b_rd8 + 32; \
                  f[1][0] = *(const u32x4*)pa; f[1][1] = *(const u32x4*)(pa + 8); f[1][2] = *(const u32x4*)(pa + 32 * LSTR); f[1][3] = *(const u32x4*)(pa + 32 * LSTR + 8); \
                  f[1][4] = *(const u32x4*)pb; f[1][5] = *(const u32x4*)(pb + 8); f[1][6] = *(const u32x4*)(pb + 32 * LSTR); f[1][7] = *(const u32x4*)(pb + 32 * LSTR + 8); } \
                acc[0][0] = mma_f8(f[s][0], f[s][1], f[s][4], f[s][5], acc[0][0]); acc[0][1] = mma_f8(f[s][0], f[s][1], f[s][6], f[s][7], acc[0][1]); \
                acc[1][0] = mma_f8(f[s][2], f[s][3], f[s][4], f[s][5], acc[1][0]); acc[1][1] = mma_f8(f[s][2], f[s][3], f[s][6], f[s][7], acc[1][1]); \
                __builtin_amdgcn_s_setprio(0); \
                if (st_) { _Pragma("unroll") for (int i = 2 * s; i < 2 * s + 2; ++i) { *(u32x4*)(As + (SBUF) * TILE_E + st_off + i * 32 * LSTR) = RA[i]; *(u32x4*)(Bs + (SBUF) * TILE_E + st_off + i * 32 * LSTR) = RB[i]; } } \
                if (ld_) { _Pragma("unroll") for (int i = 2 * s; i < 2 * s + 2; ++i) { LA[i] = *(const u32x4*)(A + aoff[i] + (LKT) * 64); LB[i] = *(const u32x4*)(B + boff[i] + (LKT) * 64); } } \
                __builtin_amdgcn_sched_barrier(0); if (s + 1 < 2) __builtin_amdgcn_s_setprio(1); } \
        } else { \
            bf16x8 f[2][4]; \
            f[0][0] = *(const bf16x8*)(Ab + a_rd); f[0][1] = *(const bf16x8*)(Ab + a_rd + 32 * LSTR); f[0][2] = *(const bf16x8*)(Bb + b_rd); f[0][3] = *(const bf16x8*)(Bb + b_rd + 32 * LSTR); \
            _Pragma("unroll") for (int s = 0; s < 4; ++s) { \
                if (s + 1 < 4) { f[(s + 1) & 1][0] = *(const bf16x8*)(Ab + a_rd + (s + 1) * 16); f[(s + 1) & 1][1] = *(const bf16x8*)(Ab + a_rd + 32 * LSTR + (s + 1) * 16); \
                                 f[(s + 1) & 1][2] = *(const bf16x8*)(Bb + b_rd + (s + 1) * 16); f[(s + 1) & 1][3] = *(const bf16x8*)(Bb + b_rd + 32 * LSTR + (s + 1) * 16); } \
                acc[0][0] = mma<MODE>(f[s & 1][0], f[s & 1][2], acc[0][0]); acc[0][1] = mma<MODE>(f[s & 1][0], f[s & 1][3], acc[0][1]); \
                acc[1][0] = mma<MODE>(f[s & 1][1], f[s & 1][2], acc[1][0]); acc[1][1] = mma<MODE>(f[s & 1][1], f[s & 1][3], acc[1][1]); \
                __builtin_amdgcn_s_setprio(0); \
                if (st_) { *(u32x4*)(As + (SBUF) * TILE_E + st_off + s * 32 * LSTR) = RA[s]; *(u32x4*)(Bs + (SBUF) * TILE_E + st_off + s * 32 * LSTR) = RB[s]; } \
                if (ld_) { LA[s] = *(const u32x4*)(A + aoff[s] + (LKT) * 64); LB[s] = *(const u32x4*)(B + boff[s] + (LKT) * 64); } \
                __builtin_amdgcn_sched_barrier(0); if (s + 1 < 4) __builtin_amdgcn_s_setprio(1); } \
        } __builtin_amdgcn_s_setprio(0); }
    G_STORE(g.ra0, g.rb0, 0);
    __syncthreads();
    for (int kt = 0; kt < nk; kt += 2) {
        G_STEP(0, kt + 1 < nk, g.ra1, g.rb1, 1, kt + 2 < nk, g.ra0, g.rb0, kt + 2);
        __syncthreads();
        if (kt + 1 >= nk) break;
        G_STEP(1, kt + 2 < nk, g.ra0, g.rb0, 0, kt + 3 < nk, g.ra1, g.rb1, kt + 3);
        __syncthreads();
    }
#undef G_STORE
#undef G_STEP
}
__device__ __forceinline__ void gemm_mainloop(f32x16 (&acc)[2][2], const u16* __restrict__ A, const unsigned (&aoff)[4],
                                              const u16* __restrict__ B, const unsigned (&boff)[4], int nk, u16* smem) {
    GemmRegs g; gemm_prefetch(g, A, aoff, B, boff, nk); gemm_run(acc, g, A, aoff, B, boff, nk, smem);
}
__device__ __forceinline__ void lin_off(unsigned (&off)[4], int row0, int ld, int col0) {
    const int tid = otid();
#pragma unroll
    for (int i = 0; i < 4; ++i) off[i] = (unsigned)(row0 + (tid >> 3) + 32 * i) * (unsigned)ld + (unsigned)(col0 + (tid & 7) * 8);
}
__device__ __forceinline__ bool dense_tile(int it, int C, int& rt, int& ct) {
    const int xcd = blockIdx.x & 7, slot = blockIdx.x >> 3, nslot = gridDim.x >> 3;
    const int i = slot + it * nslot;
    if (i >= 32 * C) return false;
    const int rg = i / (8 * C), rem = i - rg * 8 * C;
    ct = rem >> 3; rt = xcd * 32 + rg * 8 + (rem & 7);
    return true;
}
__device__ __forceinline__ bool moe_tile(int it, int ntl, int& rtg, int& ct) {
    const int xcd = blockIdx.x & 7, slot = blockIdx.x >> 3, nslot = gridDim.x >> 3;
    const int lo = (xcd * ntl) >> 3, hi = ((xcd + 1) * ntl) >> 3;
    const int i = slot + it * nslot;
    if (i >= (hi - lo) * 8) return false;
    rtg = lo + (i >> 3); ct = i & 7;
    return true;
}
#define WAVE_IDS const int tid = otid(), lane = tid & 63, wid = tid >> 6, wr = wid >> 1, wc = wid & 1, l31 = lane & 31, hi = lane >> 5; (void)wr; (void)wc; (void)l31; (void)hi; (void)lane; (void)wid; (void)tid

template <bool I8 = false, bool F8 = false, class SrcFn>
__device__ __forceinline__ void cvt_unit(SrcFn srcfn, int ld_src, int K, int nnt, size_t dst_mat_stride, const float* kscale, u16* dst, float* sm, int tile, float qs = 1.f) {
    const int tid = otid();
    const int nkt = K / 64, nng = (nnt + 3) >> 2, per = nkt * nng;
    {
        const int mat = tile / per, rem = tile % per, ng = rem % nng, kt = rem / nng;
        const int k = tid >> 2, c8 = (tid & 3) * 8;
        float v[4][8];
#pragma unroll
        for (int u = 0; u < 4; ++u) {
            const int nt = ng * 4 + u;
#pragma unroll
            for (int j = 0; j < 8; ++j) v[u][j] = 0.f;
            if (nt < nnt) {
                int ncols = 32; const float* src = srcfn(mat, nt, ncols);
                if (src) {
                    const float* q = src + (size_t)(kt * 64 + k) * ld_src + c8;
                    const f32x4 v0 = *(const f32x4*)q, v1 = *(const f32x4*)(q + 4);
                    v[u][0] = v0[0]; v[u][1] = v0[1]; v[u][2] = v0[2]; v[u][3] = v0[3]; v[u][4] = v1[0]; v[u][5] = v1[1]; v[u][6] = v1[2]; v[u][7] = v1[3];
                }
            }
        }
        if (kscale) { const float sc = kscale[kt * 64 + k];
#pragma unroll
            for (int u = 0; u < 4; ++u)
#pragma unroll
                for (int j = 0; j < 8; ++j) v[u][j] *= sc; }
#pragma unroll
        for (int u = 0; u < 4; ++u)
#pragma unroll
            for (int j = 0; j < 8; ++j) sm[k * 129 + u * 32 + c8 + j] = v[u][j];
        __syncthreads();
        const int kc = tid & 7;
#pragma unroll
        for (int u = 0; u < 4; ++u) {
            const int nt = ng * 4 + u, n = tid >> 3;
            if (nt < nnt) {
                float w[8];
#pragma unroll
                for (int j = 0; j < 8; ++j) w[j] = sm[(kc * 8 + j) * 129 + u * 32 + n];
                if constexpr (F8) {
                    u32x2 o; o[0] = 0u; o[1] = 0u;
                    o[0] = (unsigned)__builtin_amdgcn_cvt_pk_fp8_f32(f8clamp(w[0] * qs), f8clamp(w[1] * qs), (int)o[0], false); o[0] = (unsigned)__builtin_amdgcn_cvt_pk_fp8_f32(f8clamp(w[2] * qs), f8clamp(w[3] * qs), (int)o[0], true);
                    o[1] = (unsigned)__builtin_amdgcn_cvt_pk_fp8_f32(f8clamp(w[4] * qs), f8clamp(w[5] * qs), (int)o[1], false); o[1] = (unsigned)__builtin_amdgcn_cvt_pk_fp8_f32(f8clamp(w[6] * qs), f8clamp(w[7] * qs), (int)o[1], true);
                    *(u32x2*)((unsigned char*)dst + (size_t)mat * dst_mat_stride + (size_t)(nt * 32 + n) * K + kt * 64 + kc * 8) = o;
                } else if constexpr (I8) {
                    unsigned q[8];
#pragma unroll
                    for (int j = 0; j < 8; ++j) { int v_ = __float2int_rn(w[j] * qs); v_ = v_ < -127 ? -127 : (v_ > 127 ? 127 : v_); q[j] = (unsigned)v_ & 255u; }
                    u32x2 o; o[0] = q[0] | (q[1] << 8) | (q[2] << 16) | (q[3] << 24); o[1] = q[4] | (q[5] << 8) | (q[6] << 16) | (q[7] << 24);
                    *(u32x2*)((unsigned char*)dst + (size_t)mat * dst_mat_stride + (size_t)(nt * 32 + n) * K + kt * 64 + kc * 8) = o;
                } else {
                u32x4 o; o[0] = cvtpk(w[0], w[1]); o[1] = cvtpk(w[2], w[3]); o[2] = cvtpk(w[4], w[5]); o[3] = cvtpk(w[6], w[7]);
                *(u32x4*)(dst + (size_t)mat * dst_mat_stride + (size_t)(nt * 32 + n) * K + kt * 64 + kc * 8) = o; }
            }
        }
        __syncthreads();
    }
}

template <bool I8 = false, class SrcFn>
__device__ __forceinline__ void cvt_mat(SrcFn srcfn, int ld_src, int K, int nnt, int nmat, size_t dst_mat_stride, const float* kscale, u16* dst, float* sm, int& tile_base, float qs = 1.f) {
    const int total = (K / 64) * ((nnt + 3) >> 2) * nmat;
    for (int tile = (int)((blockIdx.x + gridDim.x - (tile_base % (int)gridDim.x)) % gridDim.x); tile < total; tile += gridDim.x)
        cvt_unit<I8>(srcfn, ld_src, K, nnt, dst_mat_stride, kscale, dst, sm, tile, qs);
    tile_base += total;
}
constexpr int MOE_CVT_UNITS = 6144;
__device__ __forceinline__ void moe_cvt_unit(const Params& p, int l, float* sm, int unit) {
    if (unit < 4096) {
        const float* wg = p.in[31] + (size_t)l * 32 * 1024 * 512; const float* wu = p.in[32] + (size_t)l * 32 * 1024 * 512;
        const float amax = fmaxf(__uint_as_float(__hip_atomic_load(WSP(unsigned, 0) + AMAX_W + l, __ATOMIC_RELAXED, __HIP_MEMORY_SCOPE_AGENT)), 1e-30f);
        cvt_unit<true>([=](int e, int nt, int&) -> const float* { const int fb = nt >> 2, q = nt & 3; const int f = fb * 64 + (q >> 1) * 32; return ((q & 1) ? wu : wg) + (size_t)e * 1024 * 512 + f; },
                 512, 1024, 32, (size_t)1024 * 1024, nullptr, WSP(u16, O_WGU), sm, unit, WQ_TOP / amax);
    } else {
        const float* wd = p.in[33] + (size_t)l * 32 * 512 * 1024;
        const float amaxd = fmaxf(__uint_as_float(__hip_atomic_load(WSP(unsigned, 0) + AMAX_W + 2 + l, __ATOMIC_RELAXED, __HIP_MEMORY_SCOPE_AGENT)), 1e-30f);
        cvt_unit<false, true>([=](int e, int nt, int&) -> const float* { return wd + (size_t)e * 512 * 1024 + nt * 32; }, 1024, 512, 32, (size_t)1024 * 512, nullptr, WSP(u16, O_WD), sm, unit - 4096, F8_TOP / amaxd);
    }
}
__device__ __forceinline__ void moe_cvt_dynamic(const Params& p, int l, float* sm, unsigned* ctr, int* bc) {
    for (;;) {
        if (otid() == 0) *bc = (int)atomicAdd(ctr, 4u);
        __syncthreads();
        const int base = *bc;
        __syncthreads();
        if (base >= MOE_CVT_UNITS) break;
        for (int u = base; u < base + 4 && u < MOE_CVT_UNITS; ++u) moe_cvt_unit(p, l, sm, u);
    }
}

__device__ __forceinline__ unsigned pack_i8x4(const f32x4 v, float q) {
    return ((unsigned)__float2int_rn(v[0] * q) & 255u) | (((unsigned)__float2int_rn(v[1] * q) & 255u) << 8) | (((unsigned)__float2int_rn(v[2] * q) & 255u) << 16) | ((unsigned)__float2int_rn(v[3] * q) << 24);
}
__device__ __forceinline__ void rownorm_rows(const float* __restrict__ src, const float* __restrict__ g, unsigned char* __restrict__ dst8, float* __restrict__ sa) {
    const int lane = otid() & 63, wv = blockIdx.x * 4 + (otid() >> 6), nw = gridDim.x * 4;
    f32x4 gv[4];
#pragma unroll
    for (int i = 0; i < 4; ++i) gv[i] = *(const f32x4*)(g + i * 256 + lane * 4);
    for (int row = wv * 2; row < T; row += nw * 2) {
        f32x4 x[2][4]; float ss[2] = {0.f, 0.f}, am[2] = {0.f, 0.f};
#pragma unroll
        for (int u = 0; u < 2; ++u)
#pragma unroll
            for (int i = 0; i < 4; ++i) x[u][i] = *(const f32x4*)(src + (size_t)(row + u) * D + i * 256 + lane * 4);
#pragma unroll
        for (int u = 0; u < 2; ++u) {
#pragma unroll
            for (int i = 0; i < 4; ++i) ss[u] += x[u][i][0] * x[u][i][0] + x[u][i][1] * x[u][i][1] + x[u][i][2] * x[u][i][2] + x[u][i][3] * x[u][i][3];
            ss[u] = wave_sum(ss[u]);
            const float rs = rsqrtf(ss[u] * (1.f / D) + EPS);
#pragma unroll
            for (int i = 0; i < 4; ++i)
#pragma unroll
                for (int c = 0; c < 4; ++c) { x[u][i][c] *= rs * gv[i][c]; am[u] = fmaxf(am[u], fabsf(x[u][i][c])); }
            am[u] = fmaxf(wave_max(am[u]), 1e-30f);
            const float qa = 127.f / am[u];
#pragma unroll
            for (int i = 0; i < 4; ++i) *(unsigned*)(dst8 + (size_t)(row + u) * D + i * 256 + lane * 4) = pack_i8x4(x[u][i], qa);
            if (lane == 0) sa[row + u] = am[u] * (1.f / 127.f);
        }
    }
}
__device__ __forceinline__ float sample_amax(const float* __restrict__ src, size_t total, float* sm) {
    const int tid = otid();
    const size_t stride = (total / 16) & ~(size_t)3;
    float m = 0.f;
    f32x4 v[16];
#pragma unroll
    for (int c = 0; c < 16; ++c) v[c] = *(const f32x4*)(src + c * stride + tid * 4);
#pragma unroll
    for (int c = 0; c < 16; ++c) m = fmaxf(fmaxf(m, fmaxf(fabsf(v[c][0]), fabsf(v[c][1]))), fmaxf(fabsf(v[c][2]), fabsf(v[c][3])));
    m = wave_max(m);
    if ((tid & 63) == 0) sm[tid >> 6] = m;
    __syncthreads();
    m = fmaxf(fmaxf(sm[0], sm[1]), fmaxf(sm[2], sm[3]));
    __syncthreads();
    return fmaxf(m, 1e-30f);
}
__device__ __forceinline__ void dequant_tile(f32x16 (&acc)[2][2], const float* sa_tile, float sw) {
    const int tid = otid(), wr = tid >> 7, hi = (tid >> 5) & 1;
#pragma unroll
    for (int m = 0; m < 2; ++m)
#pragma unroll
        for (int rg = 0; rg < 4; ++rg) {
            const f32x4 s4 = *(const f32x4*)(sa_tile + wr * 64 + m * 32 + 8 * rg + 4 * hi);
#pragma unroll
            for (int i = 0; i < 4; ++i) { const float sc = s4[i] * sw;
#pragma unroll
                for (int n = 0; n < 2; ++n) acc[m][n][4 * rg + i] = (float)__float_as_int(acc[m][n][4 * rg + i]) * sc; }
            __builtin_amdgcn_sched_barrier(0);
        }
}

__device__ __forceinline__ void phase_prologue(const Params& p, unsigned char* smem) {
    float* sm = (float*)smem;
    const int tid = otid();
    for (int i = blockIdx.x * 256 + tid; i < 4096 * 48; i += gridDim.x * 256) {
        if (i < 4096 * 32) { const int pos = i >> 5, f = i & 31; const float inv = powf(10000.f, -(float)f / 32.f); float s, c; sincosf((float)pos * inv, &s, &c); WSP(f32x2, O_ROPED)[i] = (f32x2){c, s}; }
        else { const int j = i - 4096 * 32, pos = j >> 4, f = j & 15; const float inv = powf(10000.f, -(float)f / 16.f); float s, c; sincosf((float)pos * inv, &s, &c); WSP(f32x2, O_ROPEM)[j] = (f32x2){c, s}; }
    }
    const float amax0 = sample_amax(p.in[4], (size_t)1024 * EV_IN, sm), amax1 = sample_amax(p.in[12], (size_t)1024 * OD_IN, sm);
    int tb = 0;
    { const float* w = p.in[4];
      cvt_mat<true>([=](int, int nt, int&) -> const float* { const int n = nt * 32; if (n < 512) return w + n; if (n < 2048) return w + n + 32; if (n < 2080) return w + 512 + (n - 2048); return nullptr; },
              EV_IN, 1024, EV_INP / 32, 1, 0, nullptr, WSP(u16, O_WIN0), sm, tb, WQ_TOP / amax0); }
    { const float* w = p.in[7];
      cvt_mat([=](int, int nt, int&) -> const float* { const int n = nt * 32; if (n < 512) return w + (n >> 6) * 96 + (n & 63); return w + ((n - 512) >> 5) * 96 + 64; },
              768, 256, 24, 1, 0, p.in[6], WSP(u16, O_WQ), sm, tb); }
    { const float* w = p.in[9];
      cvt_mat([=](int, int nt, int&) -> const float* { return w + nt * 32; }, 1024, 256, 32, 1, 0, p.in[8], WSP(u16, O_WKV), sm, tb); }
    { const float* w = p.in[5];
      cvt_mat([=](int, int nt, int&) -> const float* { return w + nt * 32; }, 1024, 1024, 32, 1, 0, nullptr, WSP(u16, O_WOUT0), sm, tb); }
    { const float* w = p.in[12];
      cvt_mat<true>([=](int, int nt, int&) -> const float* { return w + nt * 32; }, OD_IN, 1024, OD_IN / 32, 1, 0, nullptr, WSP(u16, O_WIN1), sm, tb, WQ_TOP / amax1); }
    { const float* w = p.in[13];
      cvt_mat([=](int, int nt, int&) -> const float* { return w + nt * 32; }, 1024, 1024, 32, 1, 0, nullptr, WSP(u16, O_WOUT1), sm, tb); }
    { const float* w = p.in[16];
      cvt_mat([=](int, int nt, int&) -> const float* { return w + nt * 32; }, 512, 64, 16, 1, 0, nullptr, WSP(u16, O_W2T), sm, tb); }
    { const float* w = p.in[18];
      cvt_mat([=](int, int nt, int&) -> const float* { return w + nt * 32; }, 512, 64, 16, 1, 0, nullptr, WSP(u16, O_A2T), sm, tb); }
    { const float* w = p.in[19];
      cvt_mat([=](int, int nt, int&) -> const float* { return w + nt * 32; }, 512, 128, 16, 1, 0, nullptr, WSP(u16, O_G2T), sm, tb); }
    { const float* we = p.in[29];
      cvt_mat([=](int mat, int, int&) -> const float* { return we + (size_t)mat * 1024 * 32; }, 32, 1024, 1, 2, (size_t)128 * 1024, nullptr, WSP(u16, O_WR), sm, tb); }
    for (int i = blockIdx.x * 256 + tid; i < 2 * 96 * 1024; i += gridDim.x * 256) {
        const int l = i / (96 * 1024), r = (i / 1024) % 96, k = i % 1024;
        const float v = (r < 4) ? p.in[27][((size_t)l * 1024 + k) * 4 + r] : 0.f;
        WSP(u16, O_WR)[((size_t)l * 128 + 32 + r) * 1024 + k] = f2bf(v);
    }
    for (int l = 0; l < 2; ++l) {
        float m = 0.f;
        for (int mt = 31; mt <= 32; ++mt) { const f32x4* src = (const f32x4*)(p.in[mt] + (size_t)l * 32 * 1024 * 512);
            for (int c = blockIdx.x * 4 + (tid >> 6); c < 2048; c += gridDim.x * 4) { const f32x4 v = src[(size_t)c * 2048 + (tid & 63)]; m = fmaxf(fmaxf(m, fmaxf(fabsf(v[0]), fabsf(v[1]))), fmaxf(fabsf(v[2]), fabsf(v[3]))); } }
        float md = 0.f;
        { const f32x4* src = (const f32x4*)(p.in[33] + (size_t)l * 32 * 512 * 1024);
            for (int c = blockIdx.x * 4 + (tid >> 6); c < 2048; c += gridDim.x * 4) { const f32x4 v = src[(size_t)c * 2048 + (tid & 63)]; md = fmaxf(fmaxf(md, fmaxf(fabsf(v[0]), fabsf(v[1]))), fmaxf(fabsf(v[2]), fabsf(v[3]))); } }
        m = wave_max(m); md = wave_max(md);
        if ((tid & 63) == 0 && __float_as_uint(m) > __hip_atomic_load(WSP(unsigned, 0) + AMAX_W + l, __ATOMIC_RELAXED, __HIP_MEMORY_SCOPE_AGENT)) atomicMax(WSP(unsigned, 0) + AMAX_W + l, __float_as_uint(m));
        if ((tid & 63) == 0 && __float_as_uint(md) > __hip_atomic_load(WSP(unsigned, 0) + AMAX_W + 2 + l, __ATOMIC_RELAXED, __HIP_MEMORY_SCOPE_AGENT)) atomicMax(WSP(unsigned, 0) + AMAX_W + 2 + l, __float_as_uint(md));
    }
    rownorm_rows(p.in[0], p.in[1], WSP(unsigned char, O_HA), WSP(float, O_SAIN));
}

__device__ __forceinline__ void epi_store_bf16(const f32x16 (&acc)[2][2], u16* dst, int ld, int row0, int col0, int l31, int hi) {
#pragma unroll
    for (int m = 0; m < 2; ++m)
#pragma unroll
        for (int n = 0; n < 2; ++n)
#pragma unroll
            for (int r = 0; r < 16; ++r) dst[(size_t)(row0 + m * 32 + crow(r, hi)) * ld + col0 + n * 32 + l31] = f2bf(acc[m][n][r]);
}
__device__ __forceinline__ void epi_store_tile_lds(const f32x16 (&acc)[2][2], u16* dst, int ld, int row0, int col0, int row_lim, u16* Cs) {
    const int tid = otid(), lane = tid & 63, wid = tid >> 6, wr = wid >> 1, wc = wid & 1, l31 = lane & 31, hi = lane >> 5;
#pragma unroll
    for (int m = 0; m < 2; ++m)
#pragma unroll
        for (int n = 0; n < 2; ++n)
#pragma unroll
            for (int r = 0; r < 16; ++r) Cs[(wr * 64 + m * 32 + crow(r, hi)) * 136 + wc * 64 + n * 32 + l31] = f2bf(acc[m][n][r]);
    __syncthreads();
#pragma unroll
    for (int i = 0; i < 8; ++i) { const int c = tid + 256 * i, row = c >> 4, cc = c & 15;
        if (row0 + row < row_lim) *(u32x4*)(dst + (size_t)(row0 + row) * ld + col0 + cc * 8) = *(const u32x4*)(Cs + row * 136 + cc * 8); }
    __syncthreads();
}
template <bool F16>
__device__ __forceinline__ void lds_put16(const f32x16 (&acc)[2][2], u16* Cs, int wr, int wc, int l31, int hi) {
#pragma unroll
    for (int m = 0; m < 2; ++m)
#pragma unroll
        for (int n = 0; n < 2; ++n)
#pragma unroll
            for (int r = 0; r < 16; ++r) { const float v = acc[m][n][r];
                Cs[(wr * 64 + m * 32 + crow(r, hi)) * 136 + wc * 64 + n * 32 + l31] = F16 ? __builtin_bit_cast(u16, (h16)v) : f2bf(v); }
}
template <int NCH, class DstFn>
__device__ __forceinline__ void lds_rows_store(const u16* Cs, DstFn dstfn) {
    const int tid = otid();
#pragma unroll
    for (int i = 0; i < (128 * NCH) / 256; ++i) { const int c = tid + 256 * i, row = c / NCH, cc = c % NCH;
        u16* d = dstfn(row, cc);
        if (d) *(u32x4*)d = *(const u32x4*)(Cs + row * 136 + cc * 8); }
}
__device__ __forceinline__ void epi_store_T(const f32x16 (&acc)[2][2], unsigned char* plane, int e0, int pos0, float sc, int l31, int hi) {
    const float s16 = sc * V_F8_SCALE;
#pragma unroll
    for (int m = 0; m < 2; ++m)
#pragma unroll
        for (int n = 0; n < 2; ++n)
#pragma unroll
            for (int rg = 0; rg < 4; ++rg) {
                int w = 0;
                w = __builtin_amdgcn_cvt_pk_fp8_f32(f8clamp(acc[m][n][4 * rg] * s16), f8clamp(acc[m][n][4 * rg + 1] * s16), w, false);
                w = __builtin_amdgcn_cvt_pk_fp8_f32(f8clamp(acc[m][n][4 * rg + 2] * s16), f8clamp(acc[m][n][4 * rg + 3] * s16), w, true);
                *(int*)(plane + (size_t)(e0 + n * 32 + l31) * SEQ + pos0 + m * 32 + 8 * rg + 4 * hi) = w;
            }
}

__device__ __forceinline__ void phase_inproj0(const Params& p, unsigned char* smem) {
    WAVE_IDS;
    const u16* A = WSP(u16, O_HA); const u16* B = WSP(u16, O_WIN0);
    const f32x2* ropeD = WSP(f32x2, O_ROPED); const f32x2* ropeM = WSP(f32x2, O_ROPEM);
    constexpr int NCT = EV_INP / 128;
    const float swinv = sample_amax(p.in[4], (size_t)1024 * EV_IN, (float*)smem) * (1.f / WQ_TOP);
    GemmRegs g; unsigned aoff[4], boff[4];
    float sareg = 0.f; float* sl = (float*)(smem + 73728);
    int rt, ct, rtn = 0, ctn = 0; bool have = dense_tile(0, NCT, rt, ct);
    if (have) { lin_off(aoff, rt * 128, 512, 0); lin_off(boff, ct * 128, 512, 0); gemm_prefetch(g, A, aoff, B, boff, 8); if (tid < 128) sareg = WSP(float, O_SAIN)[rt * 128 + tid]; }
    for (int it = 0; have; ++it) {
        const int m0 = rt * 128, n0 = ct * 128;
        f32x16 acc[2][2];
        gemm_run<1>(acc, g, A, aoff, B, boff, 8, (u16*)smem);
        if (tid < 128) sl[tid] = sareg;
        have = dense_tile(it + 1, NCT, rtn, ctn);
        if (have) { lin_off(aoff, rtn * 128, 512, 0); lin_off(boff, ctn * 128, 512, 0); gemm_prefetch(g, A, aoff, B, boff, 8); if (tid < 128) sareg = WSP(float, O_SAIN)[rtn * 128 + tid]; }
        __syncthreads();
        dequant_tile(acc, sl, swinv);
        const int row0 = m0 + wr * 64, b = m0 >> 12, pos0 = row0 & (SEQ - 1);
        if (ct < 4) {
            epi_store_tile_lds(acc, WSP(u16, O_CLAT), 512, m0, n0, T, (u16*)smem);
        } else if (ct < 12) {
            const bool isq = ct < 8; const int hh = (ct - 4) & 3;
            u16* dst = WSP(u16, isq ? O_QD : O_KD) + (size_t)((b * 4 + hh) * 2) * SEQ * 64;
            const float sc = isq ? QSCALE_D : 1.f;
#pragma unroll
            for (int m = 0; m < 2; ++m)
#pragma unroll
                for (int r = 0; r < 16; ++r) {
                    const int pos = pos0 + m * 32 + crow(r, hi);
                    const f32x2 cs = ropeD[pos * 32 + l31];
                    const float x1 = acc[m][0][r], x2 = acc[m][1][r];
                    acc[m][0][r] = (x1 * cs[0] - x2 * cs[1]) * sc; acc[m][1][r] = (x2 * cs[0] + x1 * cs[1]) * sc;
                }
            lds_put16<false>(acc, (u16*)smem, wr, wc, l31, hi);
            __syncthreads();
            { const int p0m = m0 & (SEQ - 1);
              lds_rows_store<16>((const u16*)smem, [=](int row, int cc) -> u16* { return dst + (size_t)(cc >> 3) * SEQ * 64 + (size_t)(p0m + row) * 64 + (cc & 7) * 8; }); }
            __syncthreads();
        } else if (ct < 16) {
            const int hh = ct - 12;
            epi_store_T(acc, WSP(unsigned char, O_VTD) + (size_t)(b * 4 + hh) * 128 * SEQ, wc * 64, pos0, 1.f, l31, hi);
        } else {
            if (wc == 0) {
#pragma unroll
                for (int m = 0; m < 2; ++m)
#pragma unroll
                    for (int r = 0; r < 16; ++r) {
                        const int pos = pos0 + m * 32 + crow(r, hi);
                        const float x = acc[m][0][r], y = __shfl_xor(x, 16);
                        const f32x2 cs = ropeM[pos * 16 + (l31 & 15)];
                        const float o = (l31 < 16) ? (x * cs[0] - y * cs[1]) : (x * cs[0] + y * cs[1]);
                        const u16 ob = f2bf(o);
#pragma unroll
                        for (int h8 = 0; h8 < 8; ++h8) WSP(u16, O_KM)[((size_t)(b * 8 + h8) * SEQ + pos) * 96 + 64 + l31] = ob;
                    }
            }
        }
            rt = rtn; ct = ctn;
    }
}

__device__ __forceinline__ void phase_upproj(const Params& p, unsigned char* smem) {
    WAVE_IDS;
    const u16* A = WSP(u16, O_CLAT);
    const f32x2* ropeM = WSP(f32x2, O_ROPEM);
    float* rsl = (float*)(smem + 73728);
    int rt, c14;
    for (int it = 0; dense_tile(it, 14, rt, c14); ++it) {
        const int m0 = rt * 128;
        const bool isq = c14 < 6; const int ct = isq ? c14 : c14 - 6; const int acol = isq ? 0 : 256;
        {
            const int row = tid >> 1, half = tid & 1;
            const u16* q = A + (size_t)(m0 + row) * 512 + acol + half * 128;
            float ss = 0.f;
#pragma unroll
            for (int i = 0; i < 16; ++i) { const u32x4 v = *(const u32x4*)(q + i * 8);
#pragma unroll
                for (int j = 0; j < 4; ++j) { const float a = bflo(v[j]), c = bfhi(v[j]); ss += a * a + c * c; } }
            ss += __shfl_xor(ss, 1);
            if (half == 0) rsl[row] = rsqrtf(ss * (1.f / 256.f) + EPS);
        }
        unsigned aoff[4], boff[4]; lin_off(aoff, m0, 512, acol); lin_off(boff, ct * 128, 256, 0);
        f32x16 acc[2][2];
        gemm_mainloop(acc, A, aoff, isq ? WSP(u16, O_WQ) : WSP(u16, O_WKV), boff, 4, (u16*)smem);
        const int row0 = m0 + wr * 64, b = m0 >> 12, pos0 = row0 & (SEQ - 1);
#pragma unroll
        for (int m = 0; m < 2; ++m)
#pragma unroll
            for (int r = 0; r < 16; ++r) { const float rs = rsl[wr * 64 + m * 32 + crow(r, hi)];
                acc[m][0][r] *= rs; acc[m][1][r] *= rs; }
        const int p0m = m0 & (SEQ - 1);
        if (isq) {
            if (ct < 4) {
#pragma unroll
                for (int m = 0; m < 2; ++m)
#pragma unroll
                    for (int n = 0; n < 2; ++n)
#pragma unroll
                        for (int r = 0; r < 16; ++r) acc[m][n][r] *= QSCALE_M;
                lds_put16<false>(acc, (u16*)smem, wr, wc, l31, hi);
                __syncthreads();
                u16* dst = WSP(u16, O_QM) + (size_t)(b * 8 + 2 * ct) * SEQ * 96;
                lds_rows_store<16>((const u16*)smem, [=](int row, int cc) -> u16* { return dst + (size_t)(cc >> 3) * SEQ * 96 + (size_t)(p0m + row) * 96 + (cc & 7) * 8; });
                __syncthreads();
            } else {
#pragma unroll
                for (int m = 0; m < 2; ++m)
#pragma unroll
                    for (int n = 0; n < 2; ++n)
#pragma unroll
                        for (int r = 0; r < 16; ++r) {
                            const int pos = pos0 + m * 32 + crow(r, hi);
                            const float x = acc[m][n][r], y = __shfl_xor(x, 16);
                            const f32x2 cs = ropeM[pos * 16 + (l31 & 15)];
                            acc[m][n][r] = ((l31 < 16) ? (x * cs[0] - y * cs[1]) : (x * cs[0] + y * cs[1])) * QSCALE_M;
                        }
                lds_put16<false>(acc, (u16*)smem, wr, wc, l31, hi);
                __syncthreads();
                u16* dst = WSP(u16, O_QM) + (size_t)(b * 8 + (ct - 4) * 4) * SEQ * 96 + 64;
                lds_rows_store<16>((const u16*)smem, [=](int row, int cc) -> u16* { return dst + (size_t)(cc >> 2) * SEQ * 96 + (size_t)(p0m + row) * 96 + (cc & 3) * 8; });
                __syncthreads();
            }
        } else {
            const int head = ct;
            if (wc == 1) epi_store_T(acc, WSP(unsigned char, O_VTM) + (size_t)(b * 8 + head) * 64 * SEQ, 0, pos0, 1.f, l31, hi);
            lds_put16<false>(acc, (u16*)smem, wr, wc, l31, hi);
            __syncthreads();
            u16* dst = WSP(u16, O_KM) + (size_t)(b * 8 + head) * SEQ * 96;
            lds_rows_store<8>((const u16*)smem, [=](int row, int cc) -> u16* { return dst + (size_t)(p0m + row) * 96 + cc * 8; });
            __syncthreads();
        }
        __syncthreads();
    }
}

template <int DK, int DV>
__device__ __forceinline__ void attn_core(const u16* __restrict__ Q, const u16* __restrict__ K, const unsigned char* __restrict__ Vt, int qt, f32x16 (&o)[DV / 32], float& lrun, u16* smem) {
    WAVE_IDS;
    constexpr int KS = DK + 8, VS8 = 80, KT = 64 * KS, VT8 = DV * VS8;
    constexpr int NKC = DK / 32, NVC = DV / 64, NDT = DV / 32, NKS = DK / 16;
    constexpr float THR = 8.f;
    u16* Kl = smem; unsigned char* Vl = (unsigned char*)(smem + 2 * KT);
    const int q0 = qt * 128 + wid * 32;
    const int ntw = (q0 >> 6) + 1, ntb = qt * 2 + 2;
    bf16x8 qf[NKS];
#pragma unroll
    for (int s = 0; s < NKS; ++s) qf[s] = *(const bf16x8*)(Q + (size_t)(q0 + l31) * DK + s * 16 + hi * 8);
    u32x4 rk[NKC], rv[NVC];
#pragma unroll
    for (int d = 0; d < NDT; ++d)
#pragma unroll
        for (int r = 0; r < 16; ++r) o[d][r] = 0.f;
    f32x16 negm;
#pragma unroll
    for (int r = 0; r < 16; ++r) negm[r] = 0.f;
    lrun = 0.f;
    auto gload = [&](int j) {
#pragma unroll
        for (int i = 0; i < NKC; ++i) rk[i] = *(const u32x4*)(K + (size_t)j * 64 * DK + (size_t)(tid + 256 * i) * 8);
#pragma unroll
        for (int i = 0; i < NVC; ++i) { const int c = tid + 256 * i; rv[i] = *(const u32x4*)(Vt + (size_t)(c >> 2) * SEQ + j * 64 + (c & 3) * 16); }
    };
    auto lstore = [&](int buf) {
#pragma unroll
        for (int i = 0; i < NKC; ++i) { const int c = tid + 256 * i, row = c / (DK / 8), kc = c % (DK / 8); *(u32x4*)(Kl + buf * KT + row * KS + kc * 8) = rk[i]; }
#pragma unroll
        for (int i = 0; i < NVC; ++i) { const int c = tid + 256 * i, part = c & 3;
            unsigned char* d = Vl + buf * VT8 + (c >> 2) * VS8 + part * 8;
            *(u32x2*)d = (u32x2){rv[i][0], rv[i][2]}; *(u32x2*)(d + 32) = (u32x2){rv[i][1], rv[i][3]}; }
    };
    gload(0); lstore(0); __syncthreads();
    for (int j = 0; j < ntb; ++j) {
        const int cur = j & 1;
        if (j + 1 < ntb) gload(j + 1);
        __builtin_amdgcn_sched_barrier(0);
        if (j < ntw) {
            const u16* Kb = Kl + cur * KT; const unsigned char* Vb = Vl + cur * VT8;
            f32x16 p0, p1;
            __builtin_amdgcn_s_setprio(1);
            bf16x8 kf[2][2];
#pragma unroll
            for (int s = 0; s < 2; ++s) { kf[s][0] = *(const bf16x8*)(Kb + l31 * KS + s * 16 + hi * 8); kf[s][1] = *(const bf16x8*)(Kb + (32 + l31) * KS + s * 16 + hi * 8); }
#pragma unroll
            for (int s = 0; s < NKS; ++s) {
                if (s == 0) { p0 = MFMA(kf[0][0], qf[0], negm); p1 = MFMA(kf[0][1], qf[0], negm); }
                else { p0 = MFMA(kf[s & 1][0], qf[s], p0); p1 = MFMA(kf[s & 1][1], qf[s], p1); }
                if (s + 2 < NKS) { kf[s & 1][0] = *(const bf16x8*)(Kb + l31 * KS + (s + 2) * 16 + hi * 8); kf[s & 1][1] = *(const bf16x8*)(Kb + (32 + l31) * KS + (s + 2) * 16 + hi * 8); }
                __builtin_amdgcn_sched_barrier(0);
            }
            u32x4 vf[NDT][2];
#pragma unroll
            for (int d = 0; d < NDT; ++d) { const unsigned char* vp = Vb + (d * 32 + l31) * VS8 + hi * 32; vf[d][0] = *(const u32x4*)vp; vf[d][1] = *(const u32x4*)(vp + 16); }
            __builtin_amdgcn_s_setprio(0);
            __builtin_amdgcn_sched_barrier(0);
            float mx = p0[0];
#pragma unroll
            for (int r = 1; r < 16; ++r) mx = fmaxf(mx, p0[r]);
#pragma unroll
            for (int r = 0; r < 16; ++r) mx = fmaxf(mx, p1[r]);
            mx = xhalf_max(mx);
            if (j == 0 || __any(mx > THR)) {
                const float dm = (j == 0) ? mx : fmaxf(mx, 0.f), alpha = (j == 0) ? 0.f : __builtin_amdgcn_exp2f(-dm);
                lrun *= alpha;
#pragma unroll
                for (int d = 0; d < NDT; ++d)
#pragma unroll
                    for (int r = 0; r < 16; ++r) o[d][r] *= alpha;
#pragma unroll
                for (int r = 0; r < 16; ++r) { p0[r] -= dm; p1[r] -= dm; negm[r] -= dm; }
            }
            float ps = 0.f;
#pragma unroll
            for (int r = 0; r < 16; ++r) { p0[r] = __builtin_amdgcn_exp2f(p0[r]); ps += p0[r]; }
#pragma unroll
            for (int r = 0; r < 16; ++r) { p1[r] = __builtin_amdgcn_exp2f(p1[r]); ps += p1[r]; }
            lrun += xhalf_sum(ps);
            u32x4 plo, phi;
#pragma unroll
            for (int d4 = 0; d4 < 4; ++d4) {
                int w0 = 0, w1 = 0;
                w0 = __builtin_amdgcn_cvt_pk_fp8_f32(p0[4 * d4], p0[4 * d4 + 1], w0, false); w0 = __builtin_amdgcn_cvt_pk_fp8_f32(p0[4 * d4 + 2], p0[4 * d4 + 3], w0, true);
                w1 = __builtin_amdgcn_cvt_pk_fp8_f32(p1[4 * d4], p1[4 * d4 + 1], w1, false); w1 = __builtin_amdgcn_cvt_pk_fp8_f32(p1[4 * d4 + 2], p1[4 * d4 + 3], w1, true);
                plo[d4] = (unsigned)w0; phi[d4] = (unsigned)w1;
            }
            __builtin_amdgcn_s_setprio(1);
#pragma unroll
            for (int d = 0; d < NDT; ++d) o[d] = mma_f8(vf[d][0], vf[d][1], plo, phi, o[d]);
            __builtin_amdgcn_s_setprio(0);
        }
        __builtin_amdgcn_sched_barrier(0);
        if (j + 1 < ntb) lstore(cur ^ 1);
        __syncthreads();
    }
}

__device__ __forceinline__ void phase_attn(const Params& p, unsigned char* smem) {
    WAVE_IDS;
    unsigned* ctr = WSP(unsigned, 0) + ATTN_CTR_W;
    int* bc = (int*)(smem + 73728 + 1024);
    float* sl = (float*)(smem + 73728 + 1536);
    if (tid < 64) { const float* lam = p.in[10]; float a = lam[tid] * lam[64 + tid], c = lam[128 + tid] * lam[192 + tid]; a = wave_sum(a); c = wave_sum(c);
        if (tid == 0) sl[0] = __expf(a) - __expf(c) + 0.2f; }
    __syncthreads();
    const float lamf = sl[0];
    u32x2* scr = WSP(u32x2, O_ATTSCR) + (size_t)blockIdx.x * 4096;
    for (;;) {
        if (tid == 0) *bc = (int)atomicAdd(ctr, 1u);
        __syncthreads();
        const int qi = *bc;
        __syncthreads();
        if (qi >= 3072) break;
        const int item = qi;
        const int level = item / 96, r = item - level * 96, qt = 31 - level;
        const int q0 = qt * 128 + wid * 32;
        if (r < 32) {
            const int bh = r, b = bh >> 2, hh = bh & 3;
            f32x16 o[4]; float l1;
            attn_core<64, 128>(WSP(u16, O_QD) + (size_t)(bh * 2) * SEQ * 64, WSP(u16, O_KD) + (size_t)(bh * 2) * SEQ * 64, WSP(unsigned char, O_VTD) + (size_t)bh * 128 * SEQ, qt, o, l1, (u16*)smem);
            { const float il = 1.f / (l1 * V_F8_SCALE);
#pragma unroll
              for (int d = 0; d < 4; ++d)
#pragma unroll
                  for (int rg = 0; rg < 4; ++rg) { u32x2 w; w[0] = cvtpk(o[d][4 * rg] * il, o[d][4 * rg + 1] * il); w[1] = cvtpk(o[d][4 * rg + 2] * il, o[d][4 * rg + 3] * il);
                      scr[((wid * 4 + d) * 4 + rg) * 64 + lane] = w; } }
            float l2;
            attn_core<64, 128>(WSP(u16, O_QD) + (size_t)(bh * 2 + 1) * SEQ * 64, WSP(u16, O_KD) + (size_t)(bh * 2 + 1) * SEQ * 64, WSP(unsigned char, O_VTD) + (size_t)bh * 128 * SEQ, qt, o, l2, (u16*)smem);
            const float il2 = lamf / (l2 * V_F8_SCALE);
            float ss = 0.f;
#pragma unroll
            for (int d = 0; d < 4; ++d)
#pragma unroll
                for (int rg = 0; rg < 4; ++rg) { const u32x2 w = scr[((wid * 4 + d) * 4 + rg) * 64 + lane];
                    o[d][4 * rg] = bflo(w[0]) - o[d][4 * rg] * il2; o[d][4 * rg + 1] = bfhi(w[0]) - o[d][4 * rg + 1] * il2;
                    o[d][4 * rg + 2] = bflo(w[1]) - o[d][4 * rg + 2] * il2; o[d][4 * rg + 3] = bfhi(w[1]) - o[d][4 * rg + 3] * il2;
                    ss += o[d][4 * rg] * o[d][4 * rg] + o[d][4 * rg + 1] * o[d][4 * rg + 1] + o[d][4 * rg + 2] * o[d][4 * rg + 2] + o[d][4 * rg + 3] * o[d][4 * rg + 3]; }
            ss = xhalf_sum(ss);
            const float rs = rsqrtf(ss * (1.f / 128.f) + EPS) * 0.8f;
            u16* dst = WSP(u16, O_HA) + ((size_t)b * SEQ + q0 + l31) * 1024 + 512 + hh * 128;
#pragma unroll
            for (int d = 0; d < 4; ++d)
#pragma unroll
                for (int rg = 0; rg < 4; ++rg) { const int e = d * 32 + 8 * rg + 4 * hi; const f32x4 gsub = *(const f32x4*)(p.in[11] + e);
                    u32x2 w; w[0] = cvtpk(o[d][4 * rg] * rs * gsub[0], o[d][4 * rg + 1] * rs * gsub[1]); w[1] = cvtpk(o[d][4 * rg + 2] * rs * gsub[2], o[d][4 * rg + 3] * rs * gsub[3]);
                    *(u32x2*)(dst + e) = w; }
        } else {
            const int bh = r - 32, b = bh >> 3, h8 = bh & 7;
            f32x16 o[2]; float l1;
            attn_core<96, 64>(WSP(u16, O_QM) + (size_t)bh * SEQ * 96, WSP(u16, O_KM) + (size_t)bh * SEQ * 96, WSP(unsigned char, O_VTM) + (size_t)bh * 64 * SEQ, qt, o, l1, (u16*)smem);
            const float il = 1.f / (l1 * V_F8_SCALE);
            u16* dst = WSP(u16, O_HA) + ((size_t)b * SEQ + q0 + l31) * 1024 + h8 * 64;
#pragma unroll
            for (int d = 0; d < 2; ++d)
#pragma unroll
                for (int rg = 0; rg < 4; ++rg) { u32x2 w; w[0] = cvtpk(o[d][4 * rg] * il, o[d][4 * rg + 1] * il); w[1] = cvtpk(o[d][4 * rg + 2] * il, o[d][4 * rg + 3] * il);
                    *(u32x2*)(dst + d * 32 + 8 * rg + 4 * hi) = w; }
        }
    }
}

__device__ __forceinline__ void phase_outproj(const Params& p, unsigned char* smem, int l) {
    WAVE_IDS;
    const u16* A = WSP(u16, O_HA); const u16* B = WSP(u16, l == 0 ? O_WOUT0 : O_WOUT1);
    const float* res = p.in[0];
    float* Cs = (float*)smem;
    GemmRegs g; unsigned aoff[4], boff[4];
    int rt, ct, rtn = 0, ctn = 0; bool have = dense_tile(0, 8, rt, ct);
    if (have) { lin_off(aoff, rt * 128, 1024, 0); lin_off(boff, ct * 128, 1024, 0); gemm_prefetch(g, A, aoff, B, boff, 16); }
    for (int it = 0; have; ++it) {
        const int m0 = rt * 128, n0 = ct * 128;
        f32x16 acc[2][2];
        gemm_run(acc, g, A, aoff, B, boff, 16, (u16*)smem);
        have = dense_tile(it + 1, 8, rtn, ctn);
        if (have) { lin_off(aoff, rtn * 128, 1024, 0); lin_off(boff, ctn * 128, 1024, 0); gemm_prefetch(g, A, aoff, B, boff, 16); }
#pragma unroll
        for (int m = 0; m < 2; ++m)
#pragma unroll
            for (int n = 0; n < 2; ++n)
#pragma unroll
                for (int r = 0; r < 16; ++r) Cs[(wr * 64 + m * 32 + crow(r, hi)) * 132 + wc * 64 + n * 32 + l31] = acc[m][n][r];
        __syncthreads();
#pragma unroll
        for (int i = 0; i < 16; ++i) { const int c = tid + 256 * i, row = c >> 5, c4 = (c & 31) * 4;
            const f32x4 rv = l == 0 ? *(const f32x4*)(res + (size_t)(m0 + row) * D + n0 + c4) : bf4_to_f32(*(const u32x2*)(HB(m0 + row) + n0 + c4));
            const f32x4 hv = rv + *(const f32x4*)(Cs + row * 132 + c4);
            u32x2 o; o[0] = cvtpk(hv[0], hv[1]); o[1] = cvtpk(hv[2], hv[3]);
            *(u32x2*)(HB(m0 + row) + n0 + c4) = o; }
        __syncthreads();
            rt = rtn; ct = ctn;
    }
}

__device__ __forceinline__ void phase_route(const Params& p, unsigned char* smem, int l) {
    WAVE_IDS;
    const u16* A = WSP(u16, O_HA); const u16* B = WSP(u16, O_WR) + (size_t)l * 128 * 1024;
    float* lg = (float*)smem;
    int* lc = (int*)(smem + 73728 + 1664);
    float* sarow = (float*)(smem + 73728);
    unsigned* cnt = WSP(unsigned, 0) + CNT_W + l * 64;
    const float* g = p.in[2] + l * 1024;
    int rt, ct0;
    for (int it = 0; dense_tile(it, 1, rt, ct0); ++it) {
        const int m0 = rt * 128;
        {
            f32x4 gv[4];
#pragma unroll
            for (int i = 0; i < 4; ++i) gv[i] = *(const f32x4*)(g + i * 256 + lane * 4);
            constexpr int RB = 4;
            for (int r2 = 0; r2 < 32; r2 += RB) {
                const int row = m0 + wid * 32 + r2;
                f32x4 x[RB][4]; float ss[RB];
#pragma unroll
                for (int u = 0; u < RB; ++u)
#pragma unroll
                    for (int i = 0; i < 4; ++i) x[u][i] = bf4_to_f32(*(const u32x2*)(HB(row + u) + i * 256 + lane * 4));
#pragma unroll
                for (int u = 0; u < RB; ++u) {
                    ss[u] = 0.f;
#pragma unroll
                    for (int i = 0; i < 4; ++i) ss[u] += x[u][i][0] * x[u][i][0] + x[u][i][1] * x[u][i][1] + x[u][i][2] * x[u][i][2] + x[u][i][3] * x[u][i][3];
                }
#pragma unroll
                for (int o = 32; o; o >>= 1)
#pragma unroll
                    for (int u = 0; u < RB; ++u) ss[u] += __shfl_xor(ss[u], o);
                float am[RB];
#pragma unroll
                for (int u = 0; u < RB; ++u) {
                    const float rs = rsqrtf(ss[u] * (1.f / D) + EPS);
                    am[u] = 0.f;
#pragma unroll
                    for (int i = 0; i < 4; ++i) {
#pragma unroll
                        for (int c = 0; c < 4; ++c) { x[u][i][c] *= rs * gv[i][c]; am[u] = fmaxf(am[u], fabsf(x[u][i][c])); }
                        u32x2 o; o[0] = cvtpk(x[u][i][0], x[u][i][1]); o[1] = cvtpk(x[u][i][2], x[u][i][3]);
                        *(u32x2*)(WSP(u16, O_HA) + (size_t)(row + u) * D + i * 256 + lane * 4) = o; }
                }
#pragma unroll
                for (int o = 32; o; o >>= 1)
#pragma unroll
                    for (int u = 0; u < RB; ++u) am[u] = fmaxf(am[u], __shfl_xor(am[u], o));
#pragma unroll
                for (int u = 0; u < RB; ++u) {
                    const float amx = fmaxf(am[u], 1e-30f);
                    const float qa = 127.f / amx;
#pragma unroll
                    for (int i = 0; i < 4; ++i) { unsigned q[4];
#pragma unroll
                        for (int c = 0; c < 4; ++c) q[c] = (unsigned)__float2int_rn(x[u][i][c] * qa) & 255u;
                        *(unsigned*)(WSP(unsigned char, O_A8) + (size_t)(row + u) * D + i * 256 + lane * 4) = q[0] | (q[1] << 8) | (q[2] << 16) | (q[3] << 24); }
                    if (lane == 0) sarow[row + u - m0] = amx * (1.f / 127.f);
                }
            }
            __syncthreads();
        }
        unsigned aoff[4], boff[4]; lin_off(aoff, m0, 1024, 0); lin_off(boff, 0, 1024, 0);
        f32x16 acc[2][2];
        gemm_mainloop(acc, A, aoff, B, boff, 16, (u16*)smem);
        if (wc == 0) {
#pragma unroll
            for (int m = 0; m < 2; ++m)
#pragma unroll
                for (int r = 0; r < 16; ++r) { const int row = wr * 64 + m * 32 + crow(r, hi);
                    lg[row * 37 + l31] = acc[m][0][r]; if (l31 < 4) lg[row * 37 + 32 + l31] = acc[m][1][r]; }
        }
        if (tid < 32) lc[tid] = 0;
        __syncthreads();
        int ea = 0, eb = 0, la = 0, lb = 0; float gw0 = 0.f, gw1 = 0.f;
        if (tid < 128) {
            const float* z = lg + tid * 37;
            float zg[4]; int gsel = 0;
#pragma unroll
            for (int i = 0; i < 4; ++i) zg[i] = z[32 + i] + p.in[28][l * 4 + i];
#pragma unroll
            for (int i = 1; i < 4; ++i) if (zg[i] > zg[gsel]) gsel = i;
            float den = 0.f;
#pragma unroll
            for (int i = 0; i < 4; ++i) den += __expf(zg[i] - zg[gsel]);
            const float pg = 1.f / den;
            float ze[8];
#pragma unroll
            for (int i = 0; i < 8; ++i) ze[i] = z[gsel * 8 + i] + p.in[30][l * 32 + gsel * 8 + i];
            int i0 = 0;
#pragma unroll
            for (int i = 1; i < 8; ++i) if (ze[i] > ze[i0]) i0 = i;
            int i1 = (i0 == 0) ? 1 : 0;
#pragma unroll
            for (int i = 0; i < 8; ++i) if (i != i0 && ze[i] > ze[i1]) i1 = i;
            const float e1 = __expf(ze[i1] - ze[i0]);
            const float w0 = pg / (1.f + e1), w1 = pg * e1 / (1.f + e1);
            ea = gsel * 8 + i0; eb = gsel * 8 + i1;
            la = atomicAdd(&lc[ea], 1); lb = atomicAdd(&lc[eb], 1);
            gw0 = w0; gw1 = w1;
        }
        __syncthreads();
        if (tid < 32) { const int c = lc[tid]; lc[32 + tid] = c ? (int)atomicAdd(&cnt[tid], (unsigned)c) : 0; }
        __syncthreads();
        if (tid < 128) { const int pa = lc[32 + ea] + la, pb = lc[32 + eb] + lb, t = m0 + tid; const float sa = sarow[tid];
            WSP(int4, O_SEL)[t] = make_int4(ea, pa, eb, pb);
            WSP(int, O_TOK2)[(size_t)ea * T + pa] = t; WSP(int, O_TOK2)[(size_t)eb * T + pb] = t;
            WSP(f32x2, O_GS2)[(size_t)ea * T + pa] = (f32x2){gw0, sa}; WSP(f32x2, O_GS2)[(size_t)eb * T + pb] = (f32x2){gw1, sa}; }
        __syncthreads();
    }
    moe_cvt_dynamic(p, l, (float*)smem, WSP(unsigned, 0) + (l == 0 ? CONV0_CTR_W : CONV1_CTR_W), (int*)(smem + 73728 + 1024));
}

__device__ __forceinline__ void expert_offsets(const Params& p, int l, int* offs) {
    if (otid() < 32) offs[128 + otid()] = (int)__hip_atomic_load(WSP(unsigned, 0) + CNT_W + l * 64 + otid(), __ATOMIC_RELAXED, __HIP_MEMORY_SCOPE_AGENT);
    __syncthreads();
    if (otid() == 0) { int a = 0, tl = 0;
        for (int e = 0; e < 32; ++e) { offs[e] = a; offs[64 + e] = tl; const int c = offs[128 + e]; a += c; tl += (c + 127) >> 7; }
        offs[32] = a; offs[64 + 32] = tl; }
    __syncthreads();
}

__device__ __forceinline__ void phase_lists(const Params& p, unsigned char* smem, int l) {
    int* offs = (int*)(smem + 73728);
    expert_offsets(p, l, offs);
    for (int t = blockIdx.x * 256 + otid(); t < T; t += gridDim.x * 256) {
        const int4 s = WSP(int4, O_SEL)[t]; const f32x2 g = WSP(f32x2, O_GATES)[t];
        const int r0 = offs[s.x] + s.y, r1 = offs[s.z] + s.w;
        WSP(int, O_TOKROW)[r0] = t; WSP(int, O_TOKROW)[r1] = t;
        WSP(float, O_GATEROW)[r0] = g[0]; WSP(float, O_GATEROW)[r1] = g[1];
        const float sa = WSP(float, O_SA8)[t];
        WSP(f32x2, O_GSROW)[r0] = (f32x2){g[0], sa}; WSP(f32x2, O_GSROW)[r1] = (f32x2){g[1], sa};
        WSP(int, O_ROWTOK)[2 * t] = r0; WSP(int, O_ROWTOK)[2 * t + 1] = r1;
    }
}

__device__ __forceinline__ void phase_moe1(const Params& p, unsigned char* smem, int l) {
    WAVE_IDS;
    int* offs = (int*)(smem + 73728);
    expert_offsets(p, l, offs);
    const int ntl = offs[64 + 32];
    const u16* A = WSP(u16, O_A8);
    const float swinv = fmaxf(__uint_as_float(__hip_atomic_load(WSP(unsigned, 0) + AMAX_W + l, __ATOMIC_RELAXED, __HIP_MEMORY_SCOPE_AGENT)), 1e-30f) * (1.f / WQ_TOP);
    GemmRegs g; unsigned aoff[4], boff[4];
    f32x2 gsreg = {0.f, 0.f}; f32x2* gl = (f32x2*)(smem + ROWSC_LDS);
    auto setup = [&](int it_, int& rtg_, int& ct_, int& e_, int& rbeg_, int& rend_) -> bool {
        if (!moe_tile(it_, ntl, rtg_, ct_)) return false;
        e_ = 0; while (offs[64 + e_ + 1] <= rtg_) ++e_;
        rbeg_ = offs[e_] + (rtg_ - offs[64 + e_]) * 128; rend_ = offs[e_ + 1];
#pragma unroll
        for (int i = 0; i < 4; ++i) { int r = rbeg_ + (tid >> 3) + 32 * i; r = r < rend_ ? r : rend_ - 1; aoff[i] = (unsigned)WSP(int, O_TOK2)[(size_t)e_ * T + (r - offs[e_])] * 512u + (tid & 7) * 8; }
        lin_off(boff, ct_ * 128, 512, 0);
        gemm_prefetch(g, A, aoff, WSP(u16, O_WGU) + (size_t)e_ * 1024 * 512, boff, 8);
        if (tid < 128) gsreg = WSP(f32x2, O_GS2)[(size_t)e_ * T + (rbeg_ - offs[e_]) + tid];
        return true; };
    int rtg, ct, e, rbeg, rend, rtgn = 0, ctn = 0, en = 0, rbegn = 0, rendn = 0;
    bool have = setup(0, rtg, ct, e, rbeg, rend);
    for (int it = 0; have; ++it) {
        f32x16 acc[2][2];
        gemm_run<1>(acc, g, A, aoff, WSP(u16, O_WGU) + (size_t)e * 1024 * 512, boff, 8, (u16*)smem);
        if (tid < 128) gl[tid] = gsreg;
        have = setup(it + 1, rtgn, ctn, en, rbegn, rendn);
        __syncthreads();
        { u16* Cs = (u16*)smem;
#pragma unroll
          for (int m = 0; m < 2; ++m)
#pragma unroll
              for (int rg = 0; rg < 4; ++rg) {
                  const int lr0 = wr * 64 + m * 32 + 8 * rg + 4 * hi;
                  const f32x4* gp = (const f32x4*)(gl + lr0);
                  const f32x4 g01 = gp[0], g23 = gp[1];
#pragma unroll
                  for (int i = 0; i < 4; ++i) { const float gt = i == 0 ? g01[0] : (i == 1 ? g01[2] : (i == 2 ? g23[0] : g23[2])); const float sc = (i == 0 ? g01[1] : (i == 1 ? g01[3] : (i == 2 ? g23[1] : g23[3]))) * swinv;
                      const float a = (float)__float_as_int(acc[m][0][4 * rg + i]) * sc, u = (float)__float_as_int(acc[m][1][4 * rg + i]) * sc;
                      ((unsigned char*)Cs)[(lr0 + i) * 272 + wc * 32 + l31] = (unsigned char)(__builtin_amdgcn_cvt_pk_fp8_f32(f8clamp(siluf_(a) * u * gt * ACT_F8_SCALE), 0.f, 0, false) & 0xff); }
                  __builtin_amdgcn_sched_barrier(0);
              }
          __syncthreads();
          u16* dst = WSP(u16, O_ACTB) + (size_t)rbeg * 256 + ct * 32; const int nvalid = rend - rbeg;
          lds_rows_store<4>((const u16*)smem, [=](int row, int cc) -> u16* { return row < nvalid ? dst + (size_t)row * 256 + cc * 8 : nullptr; });
          __syncthreads(); }
            rtg = rtgn; ct = ctn; e = en; rbeg = rbegn; rend = rendn;
    }
}

__device__ __forceinline__ void phase_moe2(const Params& p, unsigned char* smem, int l) {
    WAVE_IDS;
    int* offs = (int*)(smem + 73728);
    expert_offsets(p, l, offs);
    const int ntl = offs[64 + 32];
    const u16* A = WSP(u16, O_ACTB);
    const float sdq = fmaxf(__uint_as_float(__hip_atomic_load(WSP(unsigned, 0) + AMAX_W + 2 + l, __ATOMIC_RELAXED, __HIP_MEMORY_SCOPE_AGENT)), 1e-30f) * (1.f / (F8_TOP * ACT_F8_SCALE));
    GemmRegs g; unsigned aoff[4], boff[4];
    auto setup = [&](int it_, int& rtg_, int& ct_, int& e_, int& rbeg_, int& rend_) -> bool {
        if (!moe_tile(it_, ntl, rtg_, ct_)) return false;
        e_ = 0; while (offs[64 + e_ + 1] <= rtg_) ++e_;
        rbeg_ = offs[e_] + (rtg_ - offs[64 + e_]) * 128; rend_ = offs[e_ + 1];
#pragma unroll
        for (int i = 0; i < 4; ++i) { int r = rbeg_ + (tid >> 3) + 32 * i; r = r < rend_ ? r : rend_ - 1; aoff[i] = (unsigned)r * 256u + (tid & 7) * 8; }
        lin_off(boff, ct_ * 128, 256, 0);
        gemm_prefetch(g, A, aoff, WSP(u16, O_WD) + (size_t)e_ * 1024 * 256, boff, 4);
        return true; };
    int rtg, ct, e, rbeg, rend, rtgn = 0, ctn = 0, en = 0, rbegn = 0, rendn = 0;
    bool have = setup(0, rtg, ct, e, rbeg, rend);
    for (int it = 0; have; ++it) {
        f32x16 acc[2][2];
        gemm_run<2>(acc, g, A, aoff, WSP(u16, O_WD) + (size_t)e * 1024 * 256, boff, 4, (u16*)smem);
        have = setup(it + 1, rtgn, ctn, en, rbegn, rendn);
#pragma unroll
        for (int m = 0; m < 2; ++m)
#pragma unroll
            for (int n = 0; n < 2; ++n)
#pragma unroll
                for (int r = 0; r < 16; ++r) acc[m][n][r] *= sdq;
        epi_store_tile_lds(acc, WSP(u16, O_YSORT), 1024, rbeg, ct * 128, rend, (u16*)smem);
            rtg = rtgn; ct = ctn; e = en; rbeg = rbegn; rend = rendn;
    }
}

__device__ __forceinline__ void phase_combine(const Params& p, unsigned char* smem, int l) {
    int* offs = (int*)(smem + 73728);
    expert_offsets(p, l, offs);
    const int lane = otid() & 63, wv = blockIdx.x * 4 + (otid() >> 6), nw = gridDim.x * 4;
    const float* g = (l == 0) ? (p.in[1] + 1024) : p.in[3];
    f32x4 gv[4];
#pragma unroll
    for (int i = 0; i < 4; ++i) gv[i] = *(const f32x4*)(g + i * 256 + lane * 4);
    const u16* ys = WSP(u16, O_YSORT);
    for (int t0 = wv * 2; t0 < T; t0 += nw * 2) {
        const int4 s0 = WSP(int4, O_SEL)[t0], s1 = WSP(int4, O_SEL)[t0 + 1];
        const int4 rr = make_int4(offs[s0.x] + s0.y, offs[s0.z] + s0.w, offs[s1.x] + s1.y, offs[s1.z] + s1.w);
        f32x4 x[2][4]; u32x2 ya[2][4], yb[2][4];
#pragma unroll
        for (int u = 0; u < 2; ++u) {
            const int r0 = u ? rr.z : rr.x, r1 = u ? rr.w : rr.y;
#pragma unroll
            for (int i = 0; i < 4; ++i) {
                x[u][i] = bf4_to_f32(*(const u32x2*)(HB(t0 + u) + i * 256 + lane * 4));
                ya[u][i] = *(const u32x2*)(ys + (size_t)r0 * 1024 + i * 256 + lane * 4); yb[u][i] = *(const u32x2*)(ys + (size_t)r1 * 1024 + i * 256 + lane * 4);
            }
        }
#pragma unroll
        for (int u = 0; u < 2; ++u) {
            const int t = t0 + u; float ss = 0.f;
#pragma unroll
            for (int i = 0; i < 4; ++i) {
                const u32x2 a = ya[u][i], c = yb[u][i];
                x[u][i][0] += bflo(a[0]) + bflo(c[0]); x[u][i][1] += bfhi(a[0]) + bfhi(c[0]); x[u][i][2] += bflo(a[1]) + bflo(c[1]); x[u][i][3] += bfhi(a[1]) + bfhi(c[1]);
                ss += x[u][i][0] * x[u][i][0] + x[u][i][1] * x[u][i][1] + x[u][i][2] * x[u][i][2] + x[u][i][3] * x[u][i][3];
            }
            ss = wave_sum(ss);
            const float rs = rsqrtf(ss * (1.f / D) + EPS);
            if (l == 0) {
#pragma unroll
                for (int i = 0; i < 4; ++i) { u32x2 o; o[0] = cvtpk(x[u][i][0], x[u][i][1]); o[1] = cvtpk(x[u][i][2], x[u][i][3]); *(u32x2*)(HB(t) + i * 256 + lane * 4) = o; }
                float am = 0.f;
#pragma unroll
                for (int i = 0; i < 4; ++i)
#pragma unroll
                    for (int c = 0; c < 4; ++c) { x[u][i][c] *= rs * gv[i][c]; am = fmaxf(am, fabsf(x[u][i][c])); }
                am = fmaxf(wave_max(am), 1e-30f);
                const float qa = 127.f / am;
#pragma unroll
                for (int i = 0; i < 4; ++i) *(unsigned*)(WSP(unsigned char, O_HA) + (size_t)t * D + i * 256 + lane * 4) = pack_i8x4(x[u][i], qa);
                if (lane == 0) WSP(float, O_SAIN)[t] = am * (1.f / 127.f);
            } else {
#pragma unroll
                for (int i = 0; i < 4; ++i) { f32x4 o; o[0] = x[u][i][0] * rs * gv[i][0]; o[1] = x[u][i][1] * rs * gv[i][1]; o[2] = x[u][i][2] * rs * gv[i][2]; o[3] = x[u][i][3] * rs * gv[i][3];
                    *(f32x4*)(p.out + (size_t)t * D + i * 256 + lane * 4) = o; }
            }
        }
    }
}

__device__ __forceinline__ void phase_inproj1(const Params& p, unsigned char* smem) {
    WAVE_IDS;
    const u16* A = WSP(u16, O_HA); const u16* B = WSP(u16, O_WIN1);
    const float swinv = sample_amax(p.in[12], (size_t)1024 * OD_IN, (float*)smem) * (1.f / WQ_TOP);
    GemmRegs g; unsigned aoff[4], boff[4];
    float sareg = 0.f; float* sl = (float*)(smem + 73728);
    int rt, ct, rtn = 0, ctn = 0; bool have = dense_tile(0, 30, rt, ct);
    if (have) { lin_off(aoff, rt * 128, 512, 0); lin_off(boff, ct * 128, 512, 0); gemm_prefetch(g, A, aoff, B, boff, 8); if (tid < 128) sareg = WSP(float, O_SAIN)[rt * 128 + tid]; }
    for (int it = 0; have; ++it) {
        const int m0 = rt * 128, n0 = ct * 128;
        f32x16 acc[2][2];
        gemm_run<1>(acc, g, A, aoff, B, boff, 8, (u16*)smem);
        if (tid < 128) sl[tid] = sareg;
        have = dense_tile(it + 1, 30, rtn, ctn);
        if (have) { lin_off(aoff, rtn * 128, 512, 0); lin_off(boff, ctn * 128, 512, 0); gemm_prefetch(g, A, aoff, B, boff, 8); if (tid < 128) sareg = WSP(float, O_SAIN)[rtn * 128 + tid]; }
        __syncthreads();
        dequant_tile(acc, sl, swinv);
        if (ct < 14) epi_store_tile_lds(acc, WSP(u16, O_U1R), RW_IN, m0, n0, T, (u16*)smem);
        else epi_store_tile_lds(acc, WSP(u16, O_U1H), 2048, m0, n0 - RW_IN, T, (u16*)smem);
            rt = rtn; ct = ctn;
    }
}

__device__ __forceinline__ float hgrn_lb(const Params& p, int col) { const float x0 = p.in[25][col], x1 = p.in[25][512 + col]; return 1.f / (1.f + __expf(x0 - x1)); }

__device__ __forceinline__ void phase_hgrnA(const Params& p, unsigned char* smem) {
    WAVE_IDS;
    float* bc = (float*)smem;
    u16* Kst = (u16*)(smem + 33280);
    u16* Vtl = (u16*)(smem + 33280 + 18432);
    const u16* U = WSP(u16, O_U1H);
    int* qb = (int*)(smem + 73728 + 1024);
    for (;;) {
        if (tid == 0) *qb = (int)atomicAdd(WSP(unsigned, 0) + HGA_CTR_W, 1u);
        __syncthreads();
        const int item = *qb;
        __syncthreads();
        if (item >= 2048) break;
        const int c = item & 63, bh = item >> 6, b = bh >> 2, hh = bh & 3, t0 = b * SEQ + c * 64;
#pragma unroll
        for (int i = 0; i < 4; ++i) {
            const int ch = tid + 256 * i, t = ch >> 4, d8 = (ch & 15) * 8;
            const u32x4 zv = *(const u32x4*)(U + (size_t)(t0 + t) * 2048 + 512 + hh * 128 + d8);
            const u32x4 v = *(const u32x4*)(U + (size_t)(t0 + t) * 2048 + 1024 + hh * 128 + d8);
#pragma unroll
            for (int q = 0; q < 4; ++q) {
                const float lb0 = hgrn_lb(p, hh * 128 + d8 + 2 * q), lb1 = hgrn_lb(p, hh * 128 + d8 + 2 * q + 1);
                bc[t * 129 + d8 + 2 * q] = __logf(lb0 + (1.f - lb0) * sigmoidf_(bflo(zv[q])));
                bc[t * 129 + d8 + 2 * q + 1] = __logf(lb1 + (1.f - lb1) * sigmoidf_(bfhi(zv[q])));
                Vtl[(d8 + 2 * q) * LSTR + t] = (u16)(v[q] & 0xffff); Vtl[(d8 + 2 * q + 1) * LSTR + t] = (u16)(v[q] >> 16);
            }
        }
        __syncthreads();
        { const int d = tid & 127, half = tid >> 7; float run = 0.f;
          for (int t = half * 32; t < half * 32 + 32; ++t) { run += bc[t * 129 + d]; bc[t * 129 + d] = run; }
          __syncthreads();
          if (half) { const float add = bc[31 * 129 + d]; for (int t = 32; t < 64; ++t) bc[t * 129 + d] += add; }
          __syncthreads();
          if (tid < 128) WSP(float, O_HD)[(size_t)item * 128 + d] = __expf(bc[63 * 129 + d]); }
#pragma unroll
        for (int i = 0; i < 4; ++i) {
            const int ch = tid + 256 * i, t = ch >> 4, d8 = (ch & 15) * 8;
            const u32x4 zv = *(const u32x4*)(U + (size_t)(t0 + t) * 2048 + 512 + hh * 128 + d8);
#pragma unroll
            for (int q = 0; q < 4; ++q) {
                const int d0 = d8 + 2 * q;
                const float lb0 = hgrn_lb(p, hh * 128 + d0), lb1 = hgrn_lb(p, hh * 128 + d0 + 1);
                const float f0 = lb0 + (1.f - lb0) * sigmoidf_(bflo(zv[q])), f1 = lb1 + (1.f - lb1) * sigmoidf_(bfhi(zv[q]));
                Kst[d0 * LSTR + t] = f2bf((1.f - f0) * __expf(bc[63 * 129 + d0] - bc[t * 129 + d0]));
                Kst[(d0 + 1) * LSTR + t] = f2bf((1.f - f1) * __expf(bc[63 * 129 + d0 + 1] - bc[t * 129 + d0 + 1]));
            }
        }
        __syncthreads();
        f32x16 acc[2][2];
#pragma unroll
        for (int m = 0; m < 2; ++m)
#pragma unroll
            for (int n = 0; n < 2; ++n)
#pragma unroll
                for (int r = 0; r < 16; ++r) acc[m][n][r] = 0.f;
#pragma unroll
        for (int s = 0; s < 4; ++s) {
            const bf16x8 a0 = *(const bf16x8*)(Vtl + (wr * 64 + l31) * LSTR + s * 16 + hi * 8), a1 = *(const bf16x8*)(Vtl + (wr * 64 + 32 + l31) * LSTR + s * 16 + hi * 8);
            const bf16x8 b0 = *(const bf16x8*)(Kst + (wc * 64 + l31) * LSTR + s * 16 + hi * 8), b1 = *(const bf16x8*)(Kst + (wc * 64 + 32 + l31) * LSTR + s * 16 + hi * 8);
            acc[0][0] = MFMA(a0, b0, acc[0][0]); acc[0][1] = MFMA(a0, b1, acc[0][1]); acc[1][0] = MFMA(a1, b0, acc[1][0]); acc[1][1] = MFMA(a1, b1, acc[1][1]);
        }
        __syncthreads();
        epi_store_tile_lds(acc, WSP(u16, O_HL) + (size_t)item * 128 * 128, 128, 0, 0, 128, (u16*)smem);
    }
}
__device__ __forceinline__ void phase_hgrnB(const Params& p, unsigned char* smem) {
    int* qb = (int*)(smem + 73728 + 1024);
    for (;;) {
        if (otid() == 0) *qb = (int)atomicAdd(WSP(unsigned, 0) + HGB_CTR_W, 1u);
        __syncthreads();
        const int chunk = *qb;
        __syncthreads();
        if (chunk >= 512) break;
        const int id = chunk * 256 + otid();
        {
        const int bh = id >> 12, q = id & 4095, e = q >> 5, d4 = (q & 31) * 4;
        u16* base = WSP(u16, O_HL) + (size_t)bh * 64 * 16384 + e * 128 + d4;
        const float* dec = WSP(float, O_HD) + (size_t)bh * 64 * 128 + d4;
        float s0 = 0.f, s1 = 0.f, s2 = 0.f, s3 = 0.f;
        for (int c0 = 0; c0 < 64; c0 += 8) {
            u32x2 lv[8]; f32x4 dv[8];
#pragma unroll
            for (int i = 0; i < 8; ++i) { lv[i] = *(const u32x2*)(base + (size_t)(c0 + i) * 16384); dv[i] = *(const f32x4*)(dec + (size_t)(c0 + i) * 128); }
#pragma unroll
            for (int i = 0; i < 8; ++i) {
                u32x2 o; o[0] = cvtpk(s0, s1); o[1] = cvtpk(s2, s3);
                *(u32x2*)(base + (size_t)(c0 + i) * 16384) = o;
                s0 = dv[i][0] * s0 + bflo(lv[i][0]); s1 = dv[i][1] * s1 + bfhi(lv[i][0]); s2 = dv[i][2] * s2 + bflo(lv[i][1]); s3 = dv[i][3] * s3 + bfhi(lv[i][1]);
            }
        }
    }
    }
}
__device__ __forceinline__ void phase_hgrnC(const Params& p, unsigned char* smem) {
    WAVE_IDS;
    float* ssq = (float*)smem;
    u16* Qt = (u16*)(smem + 1024);
    u16* Kt = (u16*)(smem + 1024 + 17408);
    u16* Vtl = (u16*)(smem + 1024 + 34816);
    float* bc = (float*)(smem + 1024 + 34816);
    const u16* U = WSP(u16, O_U1H);
    int* qb = (int*)(smem + 73728 + 1024);
    for (;;) {
        if (tid == 0) *qb = (int)atomicAdd(WSP(unsigned, 0) + HGC_CTR_W, 1u);
        __syncthreads();
        const int item = *qb;
        __syncthreads();
        if (item >= 2048) break;
        const int c = item & 63, bh = item >> 6, b = bh >> 2, hh = bh & 3, t0 = b * SEQ + c * 64;
#pragma unroll
        for (int i = 0; i < 4; ++i) {
            const int ch = tid + 256 * i, t = ch >> 4, d8 = (ch & 15) * 8;
            const u32x4 zv = *(const u32x4*)(U + (size_t)(t0 + t) * 2048 + 512 + hh * 128 + d8);
#pragma unroll
            for (int q = 0; q < 4; ++q) {
                const float lb0 = hgrn_lb(p, hh * 128 + d8 + 2 * q), lb1 = hgrn_lb(p, hh * 128 + d8 + 2 * q + 1);
                bc[t * 129 + d8 + 2 * q] = __logf(lb0 + (1.f - lb0) * sigmoidf_(bflo(zv[q])));
                bc[t * 129 + d8 + 2 * q + 1] = __logf(lb1 + (1.f - lb1) * sigmoidf_(bfhi(zv[q])));
            }
        }
        __syncthreads();
        { const int d = tid & 127, half = tid >> 7; float run = 0.f;
          for (int t = half * 32; t < half * 32 + 32; ++t) { run += bc[t * 129 + d]; bc[t * 129 + d] = run; }
          __syncthreads();
          if (half) { const float add = bc[31 * 129 + d]; for (int t = 32; t < 64; ++t) bc[t * 129 + d] += add; }
          __syncthreads(); }
        u32x4 vreg[4];
#pragma unroll
        for (int i = 0; i < 4; ++i) {
            const int ch = tid + 256 * i, t = ch >> 4, d8 = (ch & 15) * 8;
            const u32x4 zv = *(const u32x4*)(U + (size_t)(t0 + t) * 2048 + 512 + hh * 128 + d8);
            const u32x4 qv = *(const u32x4*)(U + (size_t)(t0 + t) * 2048 + hh * 128 + d8);
            vreg[i] = *(const u32x4*)(U + (size_t)(t0 + t) * 2048 + 1024 + hh * 128 + d8);
            u32x4 qo, ko;
#pragma unroll
            for (int q = 0; q < 4; ++q) {
                const int d0 = d8 + 2 * q;
                const float lb0 = hgrn_lb(p, hh * 128 + d0), lb1 = hgrn_lb(p, hh * 128 + d0 + 1);
                const float f0 = lb0 + (1.f - lb0) * sigmoidf_(bflo(zv[q])), f1 = lb1 + (1.f - lb1) * sigmoidf_(bfhi(zv[q]));
                const float b0 = bc[t * 129 + d0], b1 = bc[t * 129 + d0 + 1];
                qo[q] = cvtpk(siluf_(bflo(qv[q])) * __expf(b0), siluf_(bfhi(qv[q])) * __expf(b1));
                ko[q] = cvtpk((1.f - f0) * __expf(-b0), (1.f - f1) * __expf(-b1));
            }
            *(u32x4*)(Qt + t * 136 + d8) = qo; *(u32x4*)(Kt + t * 136 + d8) = ko;
        }
        __syncthreads();
#pragma unroll
        for (int i = 0; i < 4; ++i) {
            const int ch = tid + 256 * i, t = ch >> 4, e8 = (ch & 15) * 8;
#pragma unroll
            for (int q = 0; q < 4; ++q) { Vtl[(e8 + 2 * q) * 68 + t] = (u16)(vreg[i][q] & 0xffff); Vtl[(e8 + 2 * q + 1) * 68 + t] = (u16)(vreg[i][q] >> 16); }
        }
        __syncthreads();
        f32x16 pt[2][2];
#pragma unroll
        for (int a = 0; a < 2; ++a)
#pragma unroll
            for (int c2 = 0; c2 < 2; ++c2)
#pragma unroll
                for (int r = 0; r < 16; ++r) pt[a][c2][r] = 0.f;
#pragma unroll
        for (int s = 0; s < 8; ++s) {
            const bf16x8 k0 = *(const bf16x8*)(Kt + l31 * 136 + s * 16 + hi * 8), k1 = *(const bf16x8*)(Kt + (32 + l31) * 136 + s * 16 + hi * 8);
            const bf16x8 q0 = *(const bf16x8*)(Qt + l31 * 136 + s * 16 + hi * 8), q1 = *(const bf16x8*)(Qt + (32 + l31) * 136 + s * 16 + hi * 8);
            pt[0][0] = MFMA(k0, q0, pt[0][0]); pt[0][1] = MFMA(k0, q1, pt[0][1]); pt[1][0] = MFMA(k1, q0, pt[1][0]); pt[1][1] = MFMA(k1, q1, pt[1][1]);
        }
        bf16x8 pb[2][4];
#pragma unroll
        for (int tt = 0; tt < 2; ++tt)
#pragma unroll
            for (int st = 0; st < 2; ++st) {
                float v[16];
#pragma unroll
                for (int r = 0; r < 16; ++r) { const int sidx = st * 32 + crow(r, hi), tidx = tt * 32 + l31; v[r] = (sidx <= tidx) ? pt[st][tt][r] : 0.f; }
                u32x4 w; w[0] = cvtpk(v[0], v[1]); w[1] = cvtpk(v[2], v[3]); w[2] = cvtpk(v[4], v[5]); w[3] = cvtpk(v[6], v[7]); pb[tt][st * 2] = __builtin_bit_cast(bf16x8, w);
                w[0] = cvtpk(v[8], v[9]); w[1] = cvtpk(v[10], v[11]); w[2] = cvtpk(v[12], v[13]); w[3] = cvtpk(v[14], v[15]); pb[tt][st * 2 + 1] = __builtin_bit_cast(bf16x8, w);
            }
        f32x16 o[2];
#pragma unroll
        for (int r = 0; r < 16; ++r) { o[0][r] = 0.f; o[1][r] = 0.f; }
        const u16* ST = WSP(u16, O_HL) + (size_t)item * 16384 + (size_t)(wid * 32 + l31) * 128;
#pragma unroll
        for (int s = 0; s < 8; ++s) {
            const bf16x8 a = *(const bf16x8*)(ST + s * 16 + hi * 8);
            const bf16x8 q0 = *(const bf16x8*)(Qt + l31 * 136 + s * 16 + hi * 8), q1 = *(const bf16x8*)(Qt + (32 + l31) * 136 + s * 16 + hi * 8);
            o[0] = MFMA(a, q0, o[0]); o[1] = MFMA(a, q1, o[1]);
        }
#pragma unroll
        for (int s = 0; s < 4; ++s) {
            const u16* vp = Vtl + (wid * 32 + l31) * 68 + 16 * s + 4 * hi;
            const u32x2 lo = *(const u32x2*)vp, h2 = *(const u32x2*)(vp + 8);
            const u32x4 w = {lo[0], lo[1], h2[0], h2[1]};
            o[0] = MFMA(__builtin_bit_cast(bf16x8, w), pb[0][s], o[0]); o[1] = MFMA(__builtin_bit_cast(bf16x8, w), pb[1][s], o[1]);
        }
#pragma unroll
        for (int tt = 0; tt < 2; ++tt) { float s2 = 0.f;
#pragma unroll
            for (int r = 0; r < 16; ++r) s2 += o[tt][r] * o[tt][r];
            s2 = xhalf_sum(s2);
            if (hi == 0) ssq[wid * 64 + tt * 32 + l31] = s2; }
        __syncthreads();
#pragma unroll
        for (int tt = 0; tt < 2; ++tt) {
            const int t = tt * 32 + l31;
            const float rs = rsqrtf((ssq[t] + ssq[64 + t] + ssq[128 + t] + ssq[192 + t]) * (1.f / 128.f) + EPS);
#pragma unroll
            for (int rg = 0; rg < 4; ++rg) {
                const int e = wid * 32 + 8 * rg + 4 * hi;
                const u32x2 gv = *(const u32x2*)(U + (size_t)(t0 + t) * 2048 + 1536 + hh * 128 + e);
                const f32x4 on = *(const f32x4*)(p.in[26] + hh * 128 + e);
                u32x2 w; w[0] = cvtpk(o[tt][4 * rg] * rs * on[0] * siluf_(bflo(gv[0])), o[tt][4 * rg + 1] * rs * on[1] * siluf_(bfhi(gv[0])));
                w[1] = cvtpk(o[tt][4 * rg + 2] * rs * on[2] * siluf_(bflo(gv[1])), o[tt][4 * rg + 3] * rs * on[3] * siluf_(bfhi(gv[1])));
                *(u32x2*)(WSP(u16, O_HA) + (size_t)(t0 + t) * 1024 + 512 + hh * 128 + e) = w;
            }
        }
        __syncthreads();
    }
}

__device__ __forceinline__ void phase_rwkv_prep(const Params& p) {
    const int lane = otid() & 63, wv = blockIdx.x * 4 + (otid() >> 6), nw = gridDim.x * 4;
    const u16* U = WSP(u16, O_U1R); const float* mu = p.in[14];
    const int c = 1536 + lane * 4;
    const f32x4 m = *(const f32x4*)(mu + c);
    for (int t0 = wv * 4; t0 < T; t0 += nw * 4) {
        u32x2 a[4], pv[4];
#pragma unroll
        for (int u = 0; u < 4; ++u) { const int t = t0 + u; a[u] = *(const u32x2*)(U + (size_t)t * RW_IN + c); pv[u] = (u32x2){0u, 0u}; if ((t & (SEQ - 1)) != 0) pv[u] = *(const u32x2*)(U + (size_t)(t - 1) * RW_IN + c); }
#pragma unroll
        for (int u = 0; u < 4; ++u) {
            float x[4] = {bflo(a[u][0]), bfhi(a[u][0]), bflo(a[u][1]), bfhi(a[u][1])}; const float q[4] = {bflo(pv[u][0]), bfhi(pv[u][0]), bflo(pv[u][1]), bfhi(pv[u][1])};
#pragma unroll
            for (int j = 0; j < 4; ++j) { x[j] = x[j] + (q[j] - x[j]) * m[j];
                if (lane < 16) x[j] = 1.f - 2.f * __builtin_amdgcn_rcpf(1.f + __expf(2.f * x[j]));
                else if (lane >= 32) x[j] = sigmoidf_(x[j]); }
            u32x2 o; o[0] = cvtpk(x[0], x[1]); o[1] = cvtpk(x[2], x[3]);
            *(u32x2*)(WSP(u16, O_LORA) + (size_t)(t0 + u) * 256 + lane * 4) = o; }
    }
}
__device__ __forceinline__ void phase_rwkv_lora(const Params& p, unsigned char* smem) {
    WAVE_IDS;
    const u16* A = WSP(u16, O_LORA);
    int rt, c12;
    for (int it = 0; dense_tile(it, 12, rt, c12); ++it) {
        const int which = c12 >> 2, ct = c12 & 3, m0 = rt * 128, n0 = ct * 128;
        unsigned aoff[4], boff[4];
        lin_off(aoff, m0, 256, which == 0 ? 0 : (which == 1 ? 64 : 128));
        const int K = which == 2 ? 128 : 64;
        lin_off(boff, n0, K, 0);
        f32x16 acc[2][2];
        gemm_mainloop(acc, A, aoff, WSP(u16, which == 0 ? O_W2T : (which == 1 ? O_A2T : O_G2T)), boff, K / 64, (u16*)smem);
        u16* dst = WSP(u16, which == 0 ? O_WD16 : (which == 1 ? O_AA16 : O_GG16));
#pragma unroll
        for (int m = 0; m < 2; ++m)
#pragma unroll
            for (int n = 0; n < 2; ++n) {
                const int col = n0 + wc * 64 + n * 32 + l31;
                const float bias = which == 0 ? p.in[15][col] : (which == 1 ? p.in[17][col] : 0.f);
#pragma unroll
                for (int r = 0; r < 16; ++r) {
                    float v = acc[m][n][r] + bias;
                    if (which == 0) v = __expf(-0.6065306597f * sigmoidf_(v));
                    else if (which == 1) v = sigmoidf_(v);
                    acc[m][n][r] = v;
                }
            }
        lds_put16<true>(acc, (u16*)smem, wr, wc, l31, hi);
        __syncthreads();
        lds_rows_store<16>((const u16*)smem, [=](int row, int cc) -> u16* { return dst + (size_t)(m0 + row) * 512 + n0 + cc * 8; });
        __syncthreads();
    }
}
#define DPP_ADD(x, ctrl) x += __builtin_bit_cast(float, __builtin_amdgcn_update_dpp(0, __builtin_bit_cast(int, x), ctrl, 0xf, 0xf, false))
__device__ __forceinline__ void sum32x2(float& a, float& b) {
    DPP_ADD(a, 0x128); DPP_ADD(b, 0x128); DPP_ADD(a, 0x124); DPP_ADD(b, 0x124);
    DPP_ADD(a, 0x122); DPP_ADD(b, 0x122); DPP_ADD(a, 0x121); DPP_ADD(b, 0x121);
    auto ra = __builtin_amdgcn_permlane16_swap(__float_as_uint(a), __float_as_uint(a), false, false);
    auto rb = __builtin_amdgcn_permlane16_swap(__float_as_uint(b), __float_as_uint(b), false, false);
    a = __uint_as_float(ra[0]) + __uint_as_float(ra[1]); b = __uint_as_float(rb[0]) + __uint_as_float(rb[1]);
}
__device__ __forceinline__ void sum16x2(float& a, float& b) {
    DPP_ADD(a, 0x128); DPP_ADD(b, 0x128); DPP_ADD(a, 0x124); DPP_ADD(b, 0x124);
    DPP_ADD(a, 0x122); DPP_ADD(b, 0x122); DPP_ADD(a, 0x121); DPP_ADD(b, 0x121);
}
__device__ __forceinline__ float sum16(float a) { DPP_ADD(a, 0x128); DPP_ADD(a, 0x124); DPP_ADD(a, 0x122); DPP_ADD(a, 0x121); return a; }
template <bool INNER>
__device__ __forceinline__ void phase_rwkv_rec(const Params& p, unsigned char* smem, const XcdBarrier& bar) {
    const int tid = otid(), lane = tid & 63, wid = tid >> 6, rowl = lane >> 4, j = lane & 15;
    constexpr int CH = 16;
    constexpr int BUF = CH * 6 * 64 * 4;
    int* bcast = (int*)(smem + 2 * BUF);
    unsigned* ctrl = WSP(unsigned, 0);
    if (INNER && p.solo) {
        phase_hgrnA(p, smem); xcd_barrier(bar); phase_hgrnB(p, smem); xcd_barrier(bar); phase_hgrnC(p, smem);
    }
    if (tid == 0) {
        const unsigned hw = (unsigned)__builtin_amdgcn_s_getreg((7 << 11) | (8 << 6) | 4);
        const unsigned key = (((unsigned)__builtin_amdgcn_s_getreg((3 << 11) | 20) & 0xFu) << 8) | (hw & 0xffu);
        bcast[0] = (int)atomicAdd(&ctrl[PERCU_W + key], 1u);
    }
    __syncthreads();
    const bool worker = bcast[0] == 0 || (INNER && p.solo);
    __syncthreads();
    if (!worker) {
        if (INNER) { phase_hgrnA(p, smem); xcd_barrier(bar); phase_hgrnB(p, smem); xcd_barrier(bar); phase_hgrnC(p, smem); }
        return;
    }
    int nbar = (INNER && p.solo) ? 2 : 0;
    __builtin_amdgcn_s_setprio(3);
    const u16* U = WSP(u16, O_U1R); const float* mu = p.in[14];
    for (;;) {
        if (tid == 0) bcast[0] = (int)atomicAdd(&ctrl[RWKV_TICKET_W], 1u);
        __syncthreads();
        const int item = bcast[0];
        __syncthreads();
        if (item >= 256) break;
        const int bh = item >> 2, rgp = item & 3, b = bh >> 3, h8 = bh & 7;
        const int row = rgp * 16 + wid * 4 + rowl;
        const size_t tb0 = (size_t)b * SEQ;
        const int ss_ = tid >> 4, k4 = (tid & 15) * 4;
        float mrv[4], mkv[4], mvv[4], kav[4], kkv[4];
#pragma unroll
        for (int q = 0; q < 4; ++q) { mrv[q] = mu[h8 * 64 + k4 + q]; mkv[q] = mu[512 + h8 * 64 + k4 + q]; mvv[q] = mu[1024 + h8 * 64 + k4 + q]; kav[q] = p.in[21][h8 * 64 + k4 + q]; kkv[q] = p.in[20][h8 * 64 + k4 + q]; }
        u32x2 r_c, k_c, v_c, r_p, k_p, v_p, w_c, a_c;
        auto sload = [&](int ch) {
            const int tl = ch * CH + ss_; const size_t t = tb0 + tl;
            const u16* ur = U + t * RW_IN + h8 * 64 + k4;
            r_c = *(const u32x2*)ur; k_c = *(const u32x2*)(ur + 512); v_c = *(const u32x2*)(ur + 1024);
            r_p = (u32x2){0u, 0u}; k_p = r_p; v_p = r_p;
            if (tl > 0) { r_p = *(const u32x2*)(ur - RW_IN); k_p = *(const u32x2*)(ur - RW_IN + 512); v_p = *(const u32x2*)(ur - RW_IN + 1024); }
            w_c = *(const u32x2*)(WSP(h16, O_WD16) + t * 512 + h8 * 64 + k4);
            a_c = *(const u32x2*)(WSP(h16, O_AA16) + t * 512 + h8 * 64 + k4);
        };
        auto swrite = [&](int buf) {
            const h16* wh = (const h16*)&w_c; const h16* ah = (const h16*)&a_c;
            float* bb = (float*)(smem + buf * BUF) + ss_ * 384 + k4;
            float rr[4], kk_[4], vv[4];
#pragma unroll
            for (int q = 0; q < 2; ++q) {
                float x0 = bflo(r_c[q]), x1 = bfhi(r_c[q]); rr[2 * q] = x0 + (bflo(r_p[q]) - x0) * mrv[2 * q]; rr[2 * q + 1] = x1 + (bfhi(r_p[q]) - x1) * mrv[2 * q + 1];
                x0 = bflo(k_c[q]); x1 = bfhi(k_c[q]); kk_[2 * q] = x0 + (bflo(k_p[q]) - x0) * mkv[2 * q]; kk_[2 * q + 1] = x1 + (bfhi(k_p[q]) - x1) * mkv[2 * q + 1];
                x0 = bflo(v_c[q]); x1 = bfhi(v_c[q]); vv[2 * q] = x0 + (bflo(v_p[q]) - x0) * mvv[2 * q]; vv[2 * q + 1] = x1 + (bfhi(v_p[q]) - x1) * mvv[2 * q + 1];
            }
            float kn[4]; float ssq = 0.f;
#pragma unroll
            for (int q = 0; q < 4; ++q) { kn[q] = kk_[q] * kkv[q]; ssq += kn[q] * kn[q]; }
            ssq = sum16(ssq);
            const float rn = rsqrtf(fmaxf(ssq, 1e-24f));
            f32x4 ow, on, ob, ok;
#pragma unroll
            for (int q = 0; q < 4; ++q) { const float a = (float)ah[q], n = kn[q] * rn; ow[q] = (float)wh[q]; on[q] = -n; ob[q] = n * a; ok[q] = kk_[q] * (1.f + (a - 1.f) * kav[q]); }
            *(f32x4*)(bb) = ow; *(f32x4*)(bb + 64) = on; *(f32x4*)(bb + 128) = ob; *(f32x4*)(bb + 192) = ok;
            *(f32x4*)(bb + 256) = (f32x4){rr[0], rr[1], rr[2], rr[3]}; *(f32x4*)(bb + 320) = (f32x4){vv[0], vv[1], vv[2], vv[3]};
        };
        sload(0); swrite(0);
        __syncthreads();
        f32x4 S = {0.f, 0.f, 0.f, 0.f};
        float ykeep = 0.f;
        for (int ch = 0; ch < SEQ / CH; ++ch) {
            const int cur = ch & 1;
            if (INNER && nbar < 2 && ch == (nbar == 0 ? 75 : 155)) { xcd_barrier(bar); ++nbar; }
            if (ch + 1 < SEQ / CH) sload(ch + 1);
            __builtin_amdgcn_sched_barrier(0);
            const float* bb = (const float*)(smem + cur * BUF) + j * 4;
            const float* vs = (const float*)(smem + cur * BUF) + 320 + row;
#define RW_LOAD(W, N, B_, K_, R, V, S_) { const float* q = bb + (S_) * 384; W = *(const f32x4*)q; N = *(const f32x4*)(q + 64); B_ = *(const f32x4*)(q + 128); K_ = *(const f32x4*)(q + 192); R = *(const f32x4*)(q + 256); V = vs[(S_) * 384]; }
#define RW_STEP(W, N, B_, K_, R, V, S_) { \
                float pa = S[0] * N[0]; pa = fmaf(S[1], N[1], pa); pa = fmaf(S[2], N[2], pa); pa = fmaf(S[3], N[3], pa); \
                if ((S_) > 0) { sum16x2(pa, pbk); ykeep = (j == (S_) - 1) ? pbk : ykeep; } else pa = sum16(pa); \
                S[0] = fmaf(pa, B_[0], fmaf(S[0], W[0], V * K_[0])); S[1] = fmaf(pa, B_[1], fmaf(S[1], W[1], V * K_[1])); \
                S[2] = fmaf(pa, B_[2], fmaf(S[2], W[2], V * K_[2])); S[3] = fmaf(pa, B_[3], fmaf(S[3], W[3], V * K_[3])); \
                pbk = S[0] * R[0]; pbk = fmaf(S[1], R[1], pbk); pbk = fmaf(S[2], R[2], pbk); pbk = fmaf(S[3], R[3], pbk); }
            f32x4 aw, an, ab, ak, ar, bw, bn, bb_, bk, br; float av, bv, pbk = 0.f;
            RW_LOAD(aw, an, ab, ak, ar, av, 0);
#pragma unroll
            for (int s = 0; s < CH; s += 2) {
                RW_LOAD(bw, bn, bb_, bk, br, bv, s + 1);
                RW_STEP(aw, an, ab, ak, ar, av, s);
                if (s + 2 < CH) { RW_LOAD(aw, an, ab, ak, ar, av, s + 2); }
                RW_STEP(bw, bn, bb_, bk, br, bv, s + 1);
            }
            pbk = sum16(pbk); ykeep = (j == CH - 1) ? pbk : ykeep;
            WSP(u16, O_YRAW)[(tb0 + ch * CH + j) * 512 + h8 * 64 + row] = f2bf(ykeep);
            __builtin_amdgcn_sched_barrier(0);
            if (ch + 1 < SEQ / CH) swrite(cur ^ 1);
            __syncthreads();
        }
    }
    __builtin_amdgcn_s_setprio(0);
    if (INNER) { while (nbar < 2) { xcd_barrier(bar); ++nbar; } }
}
__device__ __forceinline__ void phase_rwkv_fin(const Params& p) {
    const int lane = otid() & 63, wv = blockIdx.x * 4 + (otid() >> 6), nw = gridDim.x * 4;
    const u16* U = WSP(u16, O_U1R); const float* mu = p.in[14];
    const int c = lane * 8;
    float lw[8], lbv[8], rk[8], ka[8], mr[8], mk[8], mv[8];
#pragma unroll
    for (int q = 0; q < 8; ++q) { lw[q] = p.in[23][c + q]; lbv[q] = p.in[24][c + q]; rk[q] = p.in[22][c + q]; ka[q] = p.in[21][c + q]; mr[q] = mu[c + q]; mk[q] = mu[512 + c + q]; mv[q] = mu[1024 + c + q]; }
    for (int t = wv; t < T; t += nw) {
        const bool first = (t & (SEQ - 1)) == 0;
        const u16* ur = U + (size_t)t * RW_IN + c;
        const u32x4 r_c = *(const u32x4*)ur, k_c = *(const u32x4*)(ur + 512), v_c = *(const u32x4*)(ur + 1024);
        u32x4 r_p = {0u, 0u, 0u, 0u}, k_p = r_p, v_p = r_p;
        if (!first) { r_p = *(const u32x4*)(ur - RW_IN); k_p = *(const u32x4*)(ur - RW_IN + 512); v_p = *(const u32x4*)(ur - RW_IN + 1024); }
        const u32x4 a_c = *(const u32x4*)(WSP(h16, O_AA16) + (size_t)t * 512 + c), g_c = *(const u32x4*)(WSP(h16, O_GG16) + (size_t)t * 512 + c);
        const u32x4 y_c = *(const u32x4*)(WSP(u16, O_YRAW) + (size_t)t * 512 + c);
        const h16* ah = (const h16*)&a_c; const h16* gh = (const h16*)&g_c;
        float y[8], vv[8]; float sm = 0.f, bon = 0.f;
#pragma unroll
        for (int q = 0; q < 4; ++q) {
            y[2 * q] = bflo(y_c[q]); y[2 * q + 1] = bfhi(y_c[q]); sm += y[2 * q] + y[2 * q + 1];
            float x0 = bflo(r_c[q]), x1 = bfhi(r_c[q]); const float r0 = x0 + (bflo(r_p[q]) - x0) * mr[2 * q], r1 = x1 + (bfhi(r_p[q]) - x1) * mr[2 * q + 1];
            x0 = bflo(k_c[q]); x1 = bfhi(k_c[q]); float k0 = x0 + (bflo(k_p[q]) - x0) * mk[2 * q], k1 = x1 + (bfhi(k_p[q]) - x1) * mk[2 * q + 1];
            k0 *= 1.f + ((float)ah[2 * q] - 1.f) * ka[2 * q]; k1 *= 1.f + ((float)ah[2 * q + 1] - 1.f) * ka[2 * q + 1];
            x0 = bflo(v_c[q]); x1 = bfhi(v_c[q]); vv[2 * q] = x0 + (bflo(v_p[q]) - x0) * mv[2 * q]; vv[2 * q + 1] = x1 + (bfhi(v_p[q]) - x1) * mv[2 * q + 1];
            bon += r0 * k0 * rk[2 * q] + r1 * k1 * rk[2 * q + 1];
        }
        sm += __shfl_xor(sm, 1); sm += __shfl_xor(sm, 2); sm += __shfl_xor(sm, 4);
        bon += __shfl_xor(bon, 1); bon += __shfl_xor(bon, 2); bon += __shfl_xor(bon, 4);
        const float mean = sm * (1.f / 64.f);
        float var = 0.f;
#pragma unroll
        for (int q = 0; q < 8; ++q) { const float dd = y[q] - mean; var += dd * dd; }
        var += __shfl_xor(var, 1); var += __shfl_xor(var, 2); var += __shfl_xor(var, 4);
        const float rs = rsqrtf(var * (1.f / 64.f) + 64e-5f);
        float o[8];
#pragma unroll
        for (int q = 0; q < 8; ++q) o[q] = ((y[q] - mean) * rs * lw[q] + lbv[q] + bon * vv[q]) * (float)gh[q];
        u32x4 w; w[0] = cvtpk(o[0], o[1]); w[1] = cvtpk(o[2], o[3]); w[2] = cvtpk(o[4], o[5]); w[3] = cvtpk(o[6], o[7]);
        *(u32x4*)(WSP(u16, O_HA) + (size_t)t * 1024 + c) = w;
    }
}

#ifndef REPEAT_MASK
#define REPEAT_MASK 0
#endif
#if MEGA
constexpr int NPHASE = 19;
#else
constexpr int NPHASE = 24;
#endif
template <int PH> __device__ __forceinline__ void run_phase(const Params& p, unsigned char* smem, const XcdBarrier& bar) {
    if constexpr (PH == 0) phase_prologue(p, smem);
    else if constexpr (PH == 1) phase_inproj0(p, smem);
    else if constexpr (PH == 2) phase_upproj(p, smem);
    else if constexpr (PH == 3) phase_attn(p, smem);
    else if constexpr (PH == 4) phase_outproj(p, smem, 0);
    else if constexpr (PH == 5) phase_route(p, smem, 0);
    else if constexpr (PH == 6) phase_moe1(p, smem, 0);
    else if constexpr (PH == 7) phase_moe2(p, smem, 0);
    else if constexpr (PH == 8) phase_combine(p, smem, 0);
    else if constexpr (PH == 9) phase_inproj1(p, smem);
    else if constexpr (PH == 10) phase_rwkv_prep(p);
    else if constexpr (PH == 11) phase_rwkv_lora(p, smem);
#if MEGA
    else if constexpr (PH == 12) phase_rwkv_rec<true>(p, smem, bar);
    else if constexpr (PH == 13) phase_rwkv_fin(p);
    else if constexpr (PH == 14) phase_outproj(p, smem, 1);
    else if constexpr (PH == 15) phase_route(p, smem, 1);
    else if constexpr (PH == 16) phase_moe1(p, smem, 1);
    else if constexpr (PH == 17) phase_moe2(p, smem, 1);
    else if constexpr (PH == 18) phase_combine(p, smem, 1);
#else
    else if constexpr (PH == 13) phase_hgrnA(p, smem);
    else if constexpr (PH == 14) phase_hgrnB(p, smem);
    else if constexpr (PH == 15) phase_hgrnC(p, smem);
    else if constexpr (PH == 16) phase_rwkv_rec<false>(p, smem, bar);
    else if constexpr (PH == 17) phase_rwkv_fin(p);
    else if constexpr (PH == 18) phase_outproj(p, smem, 1);
    else if constexpr (PH == 19) phase_route(p, smem, 1);
    else if constexpr (PH == 20) phase_lists(p, smem, 1);
    else if constexpr (PH == 21) phase_moe1(p, smem, 1);
    else if constexpr (PH == 22) phase_moe2(p, smem, 1);
    else if constexpr (PH == 23) phase_combine(p, 1);
#endif
}

template <int PH> __global__ void __launch_bounds__(256, 2) k_phase(Params p) {
    __shared__ __attribute__((aligned(16))) unsigned char smem[SMEM_BYTES];
    run_phase<PH>(p, smem);
}


#if MEGA
template <int PH> __device__ __forceinline__ void run_all(const Params& p, unsigned char* smem, const XcdBarrier& bar) {
    run_phase<PH>(p, smem, bar);
    if constexpr (((REPEAT_MASK >> PH) & 1) != 0) { xcd_barrier(bar); run_phase<PH>(p, smem, bar); }
    if constexpr (PH + 1 < NPHASE) { xcd_barrier(bar); run_all<PH + 1>(p, smem, bar); }
}
__global__ void __launch_bounds__(256, 2) k_mega(Params p) {
    __shared__ __attribute__((aligned(16))) unsigned char smem[SMEM_BYTES];
    __shared__ uint4 xb_words;
    if (threadIdx.x == 0) xb_words = make_uint4(0u, 0u, 0u, 0u);
    __syncthreads();
    XcdBarrier bar = xcd_barrier_post((unsigned*)p.ws, (volatile LAS unsigned*)&xb_words);
    run_all<0>(p, smem, bar);
}
#endif
template <int PH> static void launch_phase(const Params& p, hipStream_t stream) {
    hipLaunchKernelGGL((k_phase<PH>), dim3(512), dim3(256), 0, stream, p);
}
template <int... I> static void launch_all(const Params& p, hipStream_t stream, std::integer_sequence<int, I...>) { (launch_phase<I>(p, stream), ...); }

extern "C" void kernel_launch(void* const* d_in, const int* in_sizes, int n_in, void* d_out, int out_size, void* d_ws, size_t ws_size, hipStream_t stream) {
    Params p;
    memset(&p, 0, sizeof(p));
    for (int i = 0; i < 34; ++i) p.in[i] = (const float*)d_in[i];
    p.out = (float*)d_out; p.ws = (unsigned char*)d_ws;
    if (ws_size < WS_TOTAL) { fprintf(stderr, "workspace too small: %zu < %zu\n", ws_size, (size_t)WS_TOTAL); return; }
    (void)hipMemsetAsync(d_ws, 0, CTRL_BYTES, stream);
#if MEGA
    static int grid = 0, solo = 0;
    if (!grid) {
        int dev = 0, cus = 0, per_cu = 0;
        (void)hipGetDevice(&dev);
        (void)hipDeviceGetAttribute(&cus, hipDeviceAttributeMultiprocessorCount, dev);
        (void)hipOccupancyMaxActiveBlocksPerMultiprocessor(&per_cu, k_mega, 256, 0);
        if (per_cu > 2) per_cu = 2;
        if (per_cu < 1) per_cu = 1;
        grid = cus * per_cu;
        if (grid > 512) grid = 512;
        solo = per_cu < 2;
    }
    p.solo = solo;
    hipLaunchKernelGGL(k_mega, dim3(grid), dim3(256), 0, stream, p);
#else
    launch_all(p, stream, std::make_integer_sequence<int, NPHASE>{});
#endif
}
```

```cpp
#include <hip/hip_runtime.h>
#include <stdint.h>
#include <stdio.h>
#include <string.h>
#include <utility>

#ifndef MEGA
#define MEGA 1
#endif

typedef unsigned short u16;
typedef short bf16x8 __attribute__((ext_vector_type(8)));
typedef short s16x4 __attribute__((ext_vector_type(4)));
typedef float f32x16 __attribute__((ext_vector_type(16)));
typedef float f32x4 __attribute__((ext_vector_type(4)));
typedef float f32x2 __attribute__((ext_vector_type(2)));
typedef unsigned u32x4 __attribute__((ext_vector_type(4)));
typedef unsigned u32x2 __attribute__((ext_vector_type(2)));
typedef _Float16 h16;

constexpr int NB = 8, SEQ = 4096, T = NB * SEQ, D = 1024;
constexpr int EV_IN = 2080, EV_INP = 2176;
constexpr int OD_IN = 3840, RW_IN = 1792;
constexpr float EPS = 1e-6f;
constexpr float LOG2E = 1.4426950408889634f;
constexpr float QSCALE_M = 0.10206207261596577f * LOG2E;
constexpr float QSCALE_D = 0.125f * LOG2E;

constexpr size_t CTRL_BYTES = 65536;
constexpr int    ROWSC_LDS = 40960;
constexpr int    RWKV_TICKET_W = 4608;
constexpr int    CONV1_CTR_W = 4672;
constexpr int    CONV0_CTR_W = 4736;
constexpr int    HGA_CTR_W = 4800, HGB_CTR_W = 4864, HGC_CTR_W = 4928;
constexpr int    PERCU_W = 8192;
constexpr int    ATTN_CTR_W = 4096;
constexpr int    CNT_W      = 4352;
constexpr int    AMAX_W     = 4992;
constexpr float  F8_TOP     = 224.f;
constexpr float  V_F8_SCALE = 16.f;
constexpr float  ACT_F8_SCALE = 16.f;
constexpr float  WQ_TOP     = 127.f;
constexpr size_t O_WIN0  = CTRL_BYTES;
constexpr size_t O_WQ    = O_WIN0  + (size_t)EV_INP * 1024 * 2;
constexpr size_t O_WKV   = O_WQ    + (size_t)768 * 256 * 2;
constexpr size_t O_WOUT0 = O_WKV   + (size_t)1024 * 256 * 2;
constexpr size_t O_WIN1  = O_WOUT0 + (size_t)1024 * 1024 * 2;
constexpr size_t O_WOUT1 = O_WIN1  + (size_t)OD_IN * 1024 * 2;
constexpr size_t O_W2T   = O_WOUT1 + (size_t)1024 * 1024 * 2;
constexpr size_t O_A2T   = O_W2T   + (size_t)512 * 64 * 2;
constexpr size_t O_G2T   = O_A2T   + (size_t)512 * 64 * 2;
constexpr size_t O_WR    = O_G2T   + (size_t)512 * 128 * 2;
constexpr size_t O_ROPED = O_WR    + (size_t)2 * 128 * 1024 * 2;
constexpr size_t O_ROPEM = O_ROPED + (size_t)4096 * 32 * 8;
constexpr size_t O_MOEW  = O_ROPEM + (size_t)4096 * 16 * 8;
constexpr size_t O_WGU   = O_MOEW;
constexpr size_t O_WD    = O_WGU + (size_t)32 * 1024 * 1024 * 2;
constexpr size_t MOEW_BYTES = (size_t)32 * 1024 * 1024 * 2 + (size_t)32 * 1024 * 512 * 2;
constexpr size_t O_A12   = O_MOEW;
constexpr size_t O_HL    = O_MOEW;
constexpr size_t O_ACT   = O_MOEW + MOEW_BYTES;
constexpr size_t O_HA    = O_ACT;
constexpr size_t O_CLAT  = O_ACT + (size_t)T * 1024 * 2;
constexpr size_t O_QM    = O_CLAT + (size_t)T * 512 * 2;
constexpr size_t O_KM    = O_QM + (size_t)T * 8 * 96 * 2;
constexpr size_t O_VTM   = O_KM + (size_t)T * 8 * 96 * 2;
constexpr size_t O_QD    = O_VTM + (size_t)T * 512 * 2;
constexpr size_t O_KD    = O_QD + (size_t)T * 512 * 2;
constexpr size_t O_VTD   = O_KD + (size_t)T * 512 * 2;
constexpr size_t ACT_L0_END = O_VTD + (size_t)T * 512 * 2;
constexpr size_t O_YRAW  = ACT_L0_END;
constexpr size_t O_ACTB  = O_ACT + (size_t)T * 1024 * 2;
constexpr size_t O_YSORT = O_ACTB + (size_t)2 * T * 512 * 2;
constexpr size_t O_SEL   = O_YSORT + (size_t)2 * T * 1024 * 2;
constexpr size_t O_GATES = O_SEL + (size_t)T * 16;
constexpr size_t O_TOKROW= O_GATES + (size_t)T * 8;
constexpr size_t O_GATEROW = O_TOKROW + (size_t)2 * T * 4;
constexpr size_t O_ROWTOK= O_GATEROW + (size_t)2 * T * 4;
constexpr size_t O_A8    = O_ACT + (size_t)260 * 1024 * 1024;
constexpr size_t O_SA8   = O_A8 + (size_t)T * 1024;
constexpr size_t O_GSROW = O_SA8 + (size_t)T * 4;
constexpr size_t O_TOK2  = O_GSROW + (size_t)2 * T * 8;
constexpr size_t O_GS2   = O_TOK2 + (size_t)32 * T * 4;
constexpr size_t O_U1R   = O_ACT + (size_t)T * 1024 * 2;
constexpr size_t O_U1H   = O_U1R + (size_t)T * RW_IN * 2;
constexpr size_t O_WD16  = O_MOEW + (size_t)2048 * 128 * 128 * 2;
constexpr size_t O_ATTSCR = ACT_L0_END + (size_t)T * 512 * 2;
constexpr size_t O_LORA  = O_U1H + (size_t)T * 2048 * 2;
constexpr size_t O_AA16  = O_ATTSCR;
constexpr size_t O_GG16  = O_AA16 + (size_t)T * 512 * 2;
constexpr size_t O_HD    = O_GG16 + (size_t)T * 512 * 2;
constexpr size_t O_SAIN  = O_HD + (size_t)2048 * 128 * 4;
constexpr size_t WS_TOTAL = O_SAIN + (size_t)T * 4;


struct Params { const float* in[34]; float* out; unsigned char* ws; int solo; int pad; };

#define WSP(type, off) ((type*)(p.ws + (off)))
#define HB(t) ((u16*)p.out + (size_t)(t) * 2048)

__device__ __forceinline__ int otid() { int z; asm volatile("v_mov_b32 %0, 0" : "=v"(z)); return (int)threadIdx.x + z; }
typedef __bf16 v2bf __attribute__((ext_vector_type(2)));
__device__ __forceinline__ unsigned cvtpk(float lo, float hi) { v2bf v = {(__bf16)lo, (__bf16)hi}; return __builtin_bit_cast(unsigned, v); }
__device__ __forceinline__ u16 f2bf(float x) { return __builtin_bit_cast(u16, (__bf16)x); }
__device__ __forceinline__ float bf2f(u16 b) { return __uint_as_float(((unsigned)b) << 16); }
__device__ __forceinline__ float bflo(unsigned w) { return __uint_as_float(w << 16); }
__device__ __forceinline__ float bfhi(unsigned w) { return __uint_as_float(w & 0xffff0000u); }
__device__ __forceinline__ f32x4 bf4_to_f32(const u32x2 w) { return (f32x4){bflo(w[0]), bfhi(w[0]), bflo(w[1]), bfhi(w[1])}; }
__device__ __forceinline__ int crow(int r, int hi) { return (r & 3) + 8 * (r >> 2) + 4 * hi; }
__device__ __forceinline__ float wave_sum(float v) {
#pragma unroll
    for (int o = 32; o; o >>= 1) v += __shfl_xor(v, o);
    return v;
}
__device__ __forceinline__ float wave_max(float v) {
#pragma unroll
    for (int o = 32; o; o >>= 1) v = fmaxf(v, __shfl_xor(v, o));
    return v;
}
__device__ __forceinline__ float sigmoidf_(float x) { return __builtin_amdgcn_rcpf(1.f + __expf(-x)); }
__device__ __forceinline__ float siluf_(float x) { return x * __builtin_amdgcn_rcpf(1.f + __expf(-x)); }
__device__ __forceinline__ float xhalf_sum(float x) { auto rr = __builtin_amdgcn_permlane32_swap(__float_as_uint(x), __float_as_uint(x), false, false); return __uint_as_float(rr[0]) + __uint_as_float(rr[1]); }
__device__ __forceinline__ float xhalf_max(float x) { auto rr = __builtin_amdgcn_permlane32_swap(__float_as_uint(x), __float_as_uint(x), false, false); return fmaxf(__uint_as_float(rr[0]), __uint_as_float(rr[1])); }
#define MFMA(a, b, c) __builtin_amdgcn_mfma_f32_32x32x16_bf16((a), (b), (c), 0, 0, 0)
typedef int i32x4v __attribute__((ext_vector_type(4)));
typedef int i32x16v __attribute__((ext_vector_type(16)));
typedef int i32x8v __attribute__((ext_vector_type(8)));
__device__ __forceinline__ float f8clamp(float v) { return fminf(fmaxf(v, -448.f), 448.f); }
__device__ __forceinline__ f32x16 mma_f8(const u32x4 alo, const u32x4 ahi, const u32x4 blo, const u32x4 bhi, const f32x16 c) {
    const i32x8v a = __builtin_shufflevector(__builtin_bit_cast(i32x4v, alo), __builtin_bit_cast(i32x4v, ahi), 0, 1, 2, 3, 4, 5, 6, 7);
    const i32x8v b = __builtin_shufflevector(__builtin_bit_cast(i32x4v, blo), __builtin_bit_cast(i32x4v, bhi), 0, 1, 2, 3, 4, 5, 6, 7);
    return __builtin_amdgcn_mfma_scale_f32_32x32x64_f8f6f4(a, b, c, 0, 0, 0, 0, 0, 0);
}
template <int MODE>
__device__ __forceinline__ f32x16 mma(const bf16x8 a, const bf16x8 b, const f32x16 c) {
    if constexpr (MODE == 0) return MFMA(a, b, c);
    else return __builtin_bit_cast(f32x16, __builtin_amdgcn_mfma_i32_32x32x32_i8(__builtin_bit_cast(i32x4v, a), __builtin_bit_cast(i32x4v, b), __builtin_bit_cast(i32x16v, c), 0, 0, 0));
}

#define XB_TMO      128
#define XB_XCNT(j)  (256  + 64 * (j))
#define XB_XSUB(j)  (1280 + 64 * (j))
#define XB_XGEN(j)  (2304 + 64 * (j))
#define XB_TOP      3328
#define XB_TOPGEN   3392
#define XCD_BAR_WORDS 3456
#define XB_SPIN_CAP (1u << 18)
#define LAS __attribute__((address_space(3)))

__device__ __forceinline__ unsigned xb_ld(unsigned* p)              { return __hip_atomic_load(p, __ATOMIC_RELAXED, __HIP_MEMORY_SCOPE_AGENT); }
__device__ __forceinline__ unsigned xb_add(unsigned* p, unsigned v) { return __hip_atomic_fetch_add(p, v, __ATOMIC_RELAXED, __HIP_MEMORY_SCOPE_AGENT); }
__device__ __forceinline__ unsigned xb_xcc_id() { return (unsigned)__builtin_amdgcn_s_getreg((3 << 11) | 20) & 0xFu; }
#define XB_SPIN(cond, bar) do { unsigned _sp = 0; while (cond) { __builtin_amdgcn_s_sleep(1); \
    if ((++_sp & 255u) == 0u) { if (xb_ld(&(bar)[XB_TMO])) break; if (_sp > XB_SPIN_CAP) { atomicAdd(&(bar)[XB_TMO], 1u); break; } } } } while (0)

struct XcdBarrier {
    unsigned* bar; unsigned x;
    volatile LAS unsigned* st;
};

__device__ __forceinline__ XcdBarrier xcd_barrier_post(unsigned* bar, volatile LAS unsigned* st) {
    XcdBarrier b; b.bar = bar; b.x = xb_xcc_id(); b.st = st;
    if (threadIdx.x == 0) (void)xb_add(&bar[XB_XCNT(b.x)], 1u);
    return b;
}
__device__ __forceinline__ void xcd_barrier_complete(unsigned* bar, unsigned x, unsigned& nloc, unsigned& nx) {
    const unsigned G = gridDim.x * gridDim.y * gridDim.z;
    unsigned sum, cnt, mine, sp = 0u;
    for (;;) {
        sum = 0u; cnt = 0u; mine = 0u;
#pragma unroll
        for (unsigned j = 0; j < 16; ++j) { const unsigned c = xb_ld(&bar[XB_XCNT(j)]); sum += c; cnt += (c > 0u) ? 1u : 0u; mine = (j == x) ? c : mine; }
        if (sum == G) break;
        __builtin_amdgcn_s_sleep(1);
        if ((++sp & 255u) == 0u) { if (xb_ld(&bar[XB_TMO])) break; if (sp > XB_SPIN_CAP) { atomicAdd(&bar[XB_TMO], 1u); break; } }
    }
    nloc = mine > 0u ? mine : 1u; nx = cnt > 0u ? cnt : 1u;
}

__device__ __forceinline__ void xcd_barrier(const XcdBarrier& b) {
    asm volatile("s_waitcnt vmcnt(0)" ::: "memory");
    __syncthreads();
    if (threadIdx.x == 0) {
        unsigned* bar = b.bar;
        __builtin_amdgcn_s_waitcnt(0);
        unsigned nloc = b.st[0], nx = b.st[1];
        if (nloc == 0u) { xcd_barrier_complete(bar, b.x, nloc, nx); b.st[0] = nloc; b.st[1] = nx; }
        const unsigned old = xb_add(&bar[XB_XSUB(b.x)], 1u);
        const unsigned gen = old / nloc;
        if (old + 1u == (gen + 1u) * nloc) {
            __builtin_amdgcn_fence(__ATOMIC_RELEASE, "agent");
            asm volatile("s_waitcnt vmcnt(0)" ::: "memory");
            const unsigned og = xb_add(&bar[XB_TOP], 1u);
            const unsigned tg = og / nx;
            if (og + 1u == (tg + 1u) * nx) xb_add(&bar[XB_TOPGEN], 1u);
            else XB_SPIN(xb_ld(&bar[XB_TOPGEN]) == tg, bar);
            __builtin_amdgcn_fence(__ATOMIC_ACQUIRE, "agent");
            xb_add(&bar[XB_XGEN(b.x)], 1u);
            asm volatile("s_waitcnt vmcnt(0)" ::: "memory");
        } else {
            XB_SPIN(xb_ld(&bar[XB_XGEN(b.x)]) == gen, bar);
            __builtin_amdgcn_fence(__ATOMIC_ACQUIRE, "agent");
            asm volatile("s_waitcnt vmcnt(0)" ::: "memory");
        }
    }
    __syncthreads();
}


constexpr int SMEM_BYTES = 75776;
constexpr int LSTR = 72;
constexpr int TILE_E = 128 * LSTR;

struct GemmRegs { u32x4 ra0[4], rb0[4], ra1[4], rb1[4]; };
#define G_LOAD(RA, RB, KT) _Pragma("unroll") for (int i = 0; i < 4; ++i) { RA[i] = *(const u32x4*)(A + aoff[i] + (KT) * 64); RB[i] = *(const u32x4*)(B + boff[i] + (KT) * 64); }
__device__ __forceinline__ void gemm_prefetch(GemmRegs& g, const u16* __restrict__ A, const unsigned (&aoff)[4], const u16* __restrict__ B, const unsigned (&boff)[4], int nk) {
    G_LOAD(g.ra0, g.rb0, 0);
    if (nk > 1) { G_LOAD(g.ra1, g.rb1, 1); }
}
template <int MODE = 0>
__device__ __forceinline__ void gemm_run(f32x16 (&acc)[2][2], GemmRegs& g, const u16* __restrict__ A, const unsigned (&aoff)[4],
                                         const u16* __restrict__ B, const unsigned (&boff)[4], int nk, u16* smem) {
    const int tid = otid(), lane = tid & 63, wid = tid >> 6, wr = wid >> 1, wc = wid & 1, l31 = lane & 31, hi = lane >> 5;
    u16* As = smem; u16* Bs = smem + 2 * TILE_E;
    const int st_off = (tid >> 3) * LSTR + (tid & 7) * 8;
    const int a_rd = (wr * 64 + l31) * LSTR + hi * 8, b_rd = (wc * 64 + l31) * LSTR + hi * 8;
#pragma unroll
    for (int m = 0; m < 2; ++m)
#pragma unroll
        for (int n = 0; n < 2; ++n)
#pragma unroll
            for (int r = 0; r < 16; ++r) acc[m][n][r] = 0.f;
#define G_STORE(RA, RB, BUF) _Pragma("unroll") for (int i = 0; i < 4; ++i) { *(u32x4*)(As + (BUF) * TILE_E + st_off + i * 32 * LSTR) = RA[i]; *(u32x4*)(Bs + (BUF) * TILE_E + st_off + i * 32 * LSTR) = RB[i]; }
    const int a_rd8 = (wr * 64 + l31) * LSTR + hi * 16, b_rd8 = (wc * 64 + l31) * LSTR + hi * 16;
    (void)a_rd8; (void)b_rd8;
#define G_STEP(BUF, ST, RA, RB, SBUF, LD, LA, LB, LKT) { const u16* Ab = As + (BUF) * TILE_E; const u16* Bb = Bs + (BUF) * TILE_E; const bool st_ = (ST), ld_ = (LD); __builtin_amdgcn_s_setprio(1); \
        if constexpr (MODE == 2) { \
            u32x4 f[2][8]; \
            { const u16* pa = Ab + a_rd8; const u16* pb = Bb + b_rd8; \
              f[0][0] = *(const u32x4*)pa; f[0][1] = *(const u32x4*)(pa + 8); f[0][2] = *(const u32x4*)(pa + 32 * LSTR); f[0][3] = *(const u32x4*)(pa + 32 * LSTR + 8); \
              f[0][4] = *(const u32x4*)pb; f[0][5] = *(const u32x4*)(pb + 8); f[0][6] = *(const u32x4*)(pb + 32 * LSTR); f[0][7] = *(const u32x4*)(pb + 32 * LSTR + 8); } \
            _Pragma("unroll") for (int s = 0; s < 2; ++s) { \
                if (s == 0) { const u16* pa = Ab + a_rd8 + 32; const u16* pb = Bb + b_rd8 + 32; \
                  f[1][0] = *(const u32x4*)pa; f[1][1] = *(const u32x4*)(pa + 8); f[1][2] = *(const u32x4*)(pa + 32 * LSTR); f[1][3] = *(const u32x4*)(pa + 32 * LSTR + 8); \
                  f[1][4] = *(const u32x4*)pb; f[1][5] = *(const u32x4*)(pb + 8); f[1][6] = *(const u32x4*)(pb + 32 * LSTR); f[1][7] = *(const u32x4*)(pb + 32 * LSTR + 8); } \
                acc[0][0] = mma_f8(f[s][0], f[s][1], f[s][4], f[s][5], acc[0][0]); acc[0][1] = mma_f8(f[s][0], f[s][1], f[s][6], f[s][7], acc[0][1]); \
                acc[1][0] = mma_f8(f[s][2], f[s][3], f[s][4], f[s][5], acc[1][0]); acc[1][1] = mma_f8(f[s][2], f[s][3], f[s][6], f[s][7], acc[1][1]); \
                __builtin_amdgcn_s_setprio(0); \
                if (ld_) { _Pragma("unroll") for (int i = 2 * s; i < 2 * s + 2; ++i) { LA[i] = *(const u32x4*)(A + aoff[i] + (LKT) * 64); LB[i] = *(const u32x4*)(B + boff[i] + (LKT) * 64); } } \
                if (st_) { _Pragma("unroll") for (int i = 2 * s; i < 2 * s + 2; ++i) { *(u32x4*)(As + (SBUF) * TILE_E + st_off + i * 32 * LSTR) = RA[i]; *(u32x4*)(Bs + (SBUF) * TILE_E + st_off + i * 32 * LSTR) = RB[i]; } } \
                __builtin_amdgcn_sched_barrier(0); if (s + 1 < 2) __builtin_amdgcn_s_setprio(1); } \
        } else { \
            bf16x8 f[2][4]; \
            f[0][0] = *(const bf16x8*)(Ab + a_rd); f[0][1] = *(const bf16x8*)(Ab + a_rd + 32 * LSTR); f[0][2] = *(const bf16x8*)(Bb + b_rd); f[0][3] = *(const bf16x8*)(Bb + b_rd + 32 * LSTR); \
            _Pragma("unroll") for (int s = 0; s < 4; ++s) { \
                if (s + 1 < 4) { f[(s + 1) & 1][0] = *(const bf16x8*)(Ab + a_rd + (s + 1) * 16); f[(s + 1) & 1][1] = *(const bf16x8*)(Ab + a_rd + 32 * LSTR + (s + 1) * 16); \
                                 f[(s + 1) & 1][2] = *(const bf16x8*)(Bb + b_rd + (s + 1) * 16); f[(s + 1) & 1][3] = *(const bf16x8*)(Bb + b_rd + 32 * LSTR + (s + 1) * 16); } \
                acc[0][0] = mma<MODE>(f[s & 1][0], f[s & 1][2], acc[0][0]); acc[0][1] = mma<MODE>(f[s & 1][0], f[s & 1][3], acc[0][1]); \
                acc[1][0] = mma<MODE>(f[s & 1][1], f[s & 1][2], acc[1][0]); acc[1][1] = mma<MODE>(f[s & 1][1], f[s & 1][3], acc[1][1]); \
                __builtin_amdgcn_s_setprio(0); \
                if (ld_) { LA[s] = *(const u32x4*)(A + aoff[s] + (LKT) * 64); LB[s] = *(const u32x4*)(B + boff[s] + (LKT) * 64); } \
                if (st_) { *(u32x4*)(As + (SBUF) * TILE_E + st_off + s * 32 * LSTR) = RA[s]; *(u32x4*)(Bs + (SBUF) * TILE_E + st_off + s * 32 * LSTR) = RB[s]; } \
                __builtin_amdgcn_sched_barrier(0); if (s + 1 < 4) __builtin_amdgcn_s_setprio(1); } \
        } __builtin_amdgcn_s_setprio(0); }
    G_STORE(g.ra0, g.rb0, 0);
    __syncthreads();
    for (int kt = 0; kt < nk; kt += 2) {
        G_STEP(0, kt + 1 < nk, g.ra1, g.rb1, 1, kt + 2 < nk, g.ra0, g.rb0, kt + 2);
        __syncthreads();
        if (kt + 1 >= nk) break;
        G_STEP(1, kt + 2 < nk, g.ra0, g.rb0, 0, kt + 3 < nk, g.ra1, g.rb1, kt + 3);
        __syncthreads();
    }
#undef G_STORE
#undef G_STEP
}
__device__ __forceinline__ void gemm_mainloop(f32x16 (&acc)[2][2], const u16* __restrict__ A, const unsigned (&aoff)[4],
                                              const u16* __restrict__ B, const unsigned (&boff)[4], int nk, u16* smem) {
    GemmRegs g; gemm_prefetch(g, A, aoff, B, boff, nk); gemm_run(acc, g, A, aoff, B, boff, nk, smem);
}
__device__ __forceinline__ void lin_off(unsigned (&off)[4], int row0, int ld, int col0) {
    const int tid = otid();
#pragma unroll
    for (int i = 0; i < 4; ++i) off[i] = (unsigned)(row0 + (tid >> 3) + 32 * i) * (unsigned)ld + (unsigned)(col0 + (tid & 7) * 8);
}
__device__ __forceinline__ bool dense_tile(int it, int C, int& rt, int& ct) {
    const int xcd = blockIdx.x & 7, slot = blockIdx.x >> 3, nslot = gridDim.x >> 3;
    const int i = slot + it * nslot;
    if (i >= 32 * C) return false;
    const int rg = i / (8 * C), rem = i - rg * 8 * C;
    ct = rem >> 3; rt = xcd * 32 + rg * 8 + (rem & 7);
    return true;
}
__device__ __forceinline__ bool moe_tile(int it, int ntl, int& rtg, int& ct) {
    const int xcd = blockIdx.x & 7, slot = blockIdx.x >> 3, nslot = gridDim.x >> 3;
    const int lo = (xcd * ntl) >> 3, hi = ((xcd + 1) * ntl) >> 3;
    const int i = slot + it * nslot;
    if (i >= (hi - lo) * 8) return false;
    rtg = lo + (i >> 3); ct = i & 7;
    return true;
}
#define WAVE_IDS const int tid = otid(), lane = tid & 63, wid = tid >> 6, wr = wid >> 1, wc = wid & 1, l31 = lane & 31, hi = lane >> 5; (void)wr; (void)wc; (void)l31; (void)hi; (void)lane; (void)wid; (void)tid

template <bool I8 = false, bool F8 = false, class SrcFn>
__device__ __forceinline__ void cvt_unit(SrcFn srcfn, int ld_src, int K, int nnt, size_t dst_mat_stride, const float* kscale, u16* dst, float* sm, int tile, float qs = 1.f) {
    const int tid = otid();
    const int nkt = K / 64, nng = (nnt + 3) >> 2, per = nkt * nng;
    {
        const int mat = tile / per, rem = tile % per, ng = rem % nng, kt = rem / nng;
        const int k = tid >> 2, c8 = (tid & 3) * 8;
        float v[4][8];
#pragma unroll
        for (int u = 0; u < 4; ++u) {
            const int nt = ng * 4 + u;
#pragma unroll
            for (int j = 0; j < 8; ++j) v[u][j] = 0.f;
            if (nt < nnt) {
                int ncols = 32; const float* src = srcfn(mat, nt, ncols);
                if (src) {
                    const float* q = src + (size_t)(kt * 64 + k) * ld_src + c8;
                    const f32x4 v0 = *(const f32x4*)q, v1 = *(const f32x4*)(q + 4);
                    v[u][0] = v0[0]; v[u][1] = v0[1]; v[u][2] = v0[2]; v[u][3] = v0[3]; v[u][4] = v1[0]; v[u][5] = v1[1]; v[u][6] = v1[2]; v[u][7] = v1[3];
                }
            }
        }
        if (kscale) { const float sc = kscale[kt * 64 + k];
#pragma unroll
            for (int u = 0; u < 4; ++u)
#pragma unroll
                for (int j = 0; j < 8; ++j) v[u][j] *= sc; }
#pragma unroll
        for (int u = 0; u < 4; ++u)
#pragma unroll
            for (int j = 0; j < 8; ++j) sm[k * 129 + u * 32 + c8 + j] = v[u][j];
        __syncthreads();
        const int kc = tid & 7;
#pragma unroll
        for (int u = 0; u < 4; ++u) {
            const int nt = ng * 4 + u, n = tid >> 3;
            if (nt < nnt) {
                float w[8];
#pragma unroll
                for (int j = 0; j < 8; ++j) w[j] = sm[(kc * 8 + j) * 129 + u * 32 + n];
                if constexpr (F8) {
                    u32x2 o; o[0] = 0u; o[1] = 0u;
                    o[0] = (unsigned)__builtin_amdgcn_cvt_pk_fp8_f32(f8clamp(w[0] * qs), f8clamp(w[1] * qs), (int)o[0], false); o[0] = (unsigned)__builtin_amdgcn_cvt_pk_fp8_f32(f8clamp(w[2] * qs), f8clamp(w[3] * qs), (int)o[0], true);
                    o[1] = (unsigned)__builtin_amdgcn_cvt_pk_fp8_f32(f8clamp(w[4] * qs), f8clamp(w[5] * qs), (int)o[1], false); o[1] = (unsigned)__builtin_amdgcn_cvt_pk_fp8_f32(f8clamp(w[6] * qs), f8clamp(w[7] * qs), (int)o[1], true);
                    *(u32x2*)((unsigned char*)dst + (size_t)mat * dst_mat_stride + (size_t)(nt * 32 + n) * K + kt * 64 + kc * 8) = o;
                } else if constexpr (I8) {
                    unsigned q[8];
#pragma unroll
                    for (int j = 0; j < 8; ++j) { int v_ = __float2int_rn(w[j] * qs); v_ = v_ < -127 ? -127 : (v_ > 127 ? 127 : v_); q[j] = (unsigned)v_ & 255u; }
                    u32x2 o; o[0] = q[0] | (q[1] << 8) | (q[2] << 16) | (q[3] << 24); o[1] = q[4] | (q[5] << 8) | (q[6] << 16) | (q[7] << 24);
                    *(u32x2*)((unsigned char*)dst + (size_t)mat * dst_mat_stride + (size_t)(nt * 32 + n) * K + kt * 64 + kc * 8) = o;
                } else {
                u32x4 o; o[0] = cvtpk(w[0], w[1]); o[1] = cvtpk(w[2], w[3]); o[2] = cvtpk(w[4], w[5]); o[3] = cvtpk(w[6], w[7]);
                *(u32x4*)(dst + (size_t)mat * dst_mat_stride + (size_t)(nt * 32 + n) * K + kt * 64 + kc * 8) = o; }
            }
        }
        __syncthreads();
    }
}

template <bool I8 = false, class SrcFn>
__device__ __forceinline__ void cvt_mat(SrcFn srcfn, int ld_src, int K, int nnt, int nmat, size_t dst_mat_stride, const float* kscale, u16* dst, float* sm, int& tile_base, float qs = 1.f) {
    const int total = (K / 64) * ((nnt + 3) >> 2) * nmat;
    for (int tile = (int)((blockIdx.x + gridDim.x - (tile_base % (int)gridDim.x)) % gridDim.x); tile < total; tile += gridDim.x)
        cvt_unit<I8>(srcfn, ld_src, K, nnt, dst_mat_stride, kscale, dst, sm, tile, qs);
    tile_base += total;
}
constexpr int MOE_CVT_UNITS = 6144;
__device__ __forceinline__ void moe_cvt_unit(const Params& p, int l, float* sm, int unit) {
    if (unit < 4096) {
        const float* wg = p.in[31] + (size_t)l * 32 * 1024 * 512; const float* wu = p.in[32] + (size_t)l * 32 * 1024 * 512;
        const float amax = fmaxf(__uint_as_float(__hip_atomic_load(WSP(unsigned, 0) + AMAX_W + l, __ATOMIC_RELAXED, __HIP_MEMORY_SCOPE_AGENT)), 1e-30f);
        cvt_unit<true>([=](int e, int nt, int&) -> const float* { const int fb = nt >> 2, q = nt & 3; const int f = fb * 64 + (q >> 1) * 32; return ((q & 1) ? wu : wg) + (size_t)e * 1024 * 512 + f; },
                 512, 1024, 32, (size_t)1024 * 1024, nullptr, WSP(u16, O_WGU), sm, unit, WQ_TOP / amax);
    } else {
        const float* wd = p.in[33] + (size_t)l * 32 * 512 * 1024;
        const float amaxd = fmaxf(__uint_as_float(__hip_atomic_load(WSP(unsigned, 0) + AMAX_W + 2 + l, __ATOMIC_RELAXED, __HIP_MEMORY_SCOPE_AGENT)), 1e-30f);
        cvt_unit<false, true>([=](int e, int nt, int&) -> const float* { return wd + (size_t)e * 512 * 1024 + nt * 32; }, 1024, 512, 32, (size_t)1024 * 512, nullptr, WSP(u16, O_WD), sm, unit - 4096, F8_TOP / amaxd);
    }
}
__device__ __forceinline__ void moe_cvt_dynamic(const Params& p, int l, float* sm, unsigned* ctr, int* bc) {
    for (;;) {
        if (otid() == 0) *bc = (int)atomicAdd(ctr, 4u);
        __syncthreads();
        const int base = *bc;
        __syncthreads();
        if (base >= MOE_CVT_UNITS) break;
        for (int u = base; u < base + 4 && u < MOE_CVT_UNITS; ++u) moe_cvt_unit(p, l, sm, u);
    }
}

__device__ __forceinline__ unsigned pack_i8x4(const f32x4 v, float q) {
    return ((unsigned)__float2int_rn(v[0] * q) & 255u) | (((unsigned)__float2int_rn(v[1] * q) & 255u) << 8) | (((unsigned)__float2int_rn(v[2] * q) & 255u) << 16) | ((unsigned)__float2int_rn(v[3] * q) << 24);
}
__device__ __forceinline__ void rownorm_rows(const float* __restrict__ src, const float* __restrict__ g, unsigned char* __restrict__ dst8, float* __restrict__ sa) {
    const int lane = otid() & 63, wv = blockIdx.x * 4 + (otid() >> 6), nw = gridDim.x * 4;
    f32x4 gv[4];
#pragma unroll
    for (int i = 0; i < 4; ++i) gv[i] = *(const f32x4*)(g + i * 256 + lane * 4);
    for (int row = wv * 2; row < T; row += nw * 2) {
        f32x4 x[2][4]; float ss[2] = {0.f, 0.f}, am[2] = {0.f, 0.f};
#pragma unroll
        for (int u = 0; u < 2; ++u)
#pragma unroll
            for (int i = 0; i < 4; ++i) x[u][i] = *(const f32x4*)(src + (size_t)(row + u) * D + i * 256 + lane * 4);
#pragma unroll
        for (int u = 0; u < 2; ++u) {
#pragma unroll
            for (int i = 0; i < 4; ++i) ss[u] += x[u][i][0] * x[u][i][0] + x[u][i][1] * x[u][i][1] + x[u][i][2] * x[u][i][2] + x[u][i][3] * x[u][i][3];
            ss[u] = wave_sum(ss[u]);
            const float rs = rsqrtf(ss[u] * (1.f / D) + EPS);
#pragma unroll
            for (int i = 0; i < 4; ++i)
#pragma unroll
                for (int c = 0; c < 4; ++c) { x[u][i][c] *= rs * gv[i][c]; am[u] = fmaxf(am[u], fabsf(x[u][i][c])); }
            am[u] = fmaxf(wave_max(am[u]), 1e-30f);
            const float qa = 127.f / am[u];
#pragma unroll
            for (int i = 0; i < 4; ++i) *(unsigned*)(dst8 + (size_t)(row + u) * D + i * 256 + lane * 4) = pack_i8x4(x[u][i], qa);
            if (lane == 0) sa[row + u] = am[u] * (1.f / 127.f);
        }
    }
}
__device__ __forceinline__ float sample_amax(const float* __restrict__ src, size_t total, float* sm) {
    const int tid = otid();
    const size_t stride = (total / 16) & ~(size_t)3;
    float m = 0.f;
    f32x4 v[16];
#pragma unroll
    for (int c = 0; c < 16; ++c) v[c] = *(const f32x4*)(src + c * stride + tid * 4);
#pragma unroll
    for (int c = 0; c < 16; ++c) m = fmaxf(fmaxf(m, fmaxf(fabsf(v[c][0]), fabsf(v[c][1]))), fmaxf(fabsf(v[c][2]), fabsf(v[c][3])));
    m = wave_max(m);
    if ((tid & 63) == 0) sm[tid >> 6] = m;
    __syncthreads();
    m = fmaxf(fmaxf(sm[0], sm[1]), fmaxf(sm[2], sm[3]));
    __syncthreads();
    return fmaxf(m, 1e-30f);
}
__device__ __forceinline__ void dequant_tile(f32x16 (&acc)[2][2], const float* sa_tile, float sw) {
    const int tid = otid(), wr = tid >> 7, hi = (tid >> 5) & 1;
#pragma unroll
    for (int m = 0; m < 2; ++m)
#pragma unroll
        for (int rg = 0; rg < 4; ++rg) {
            const f32x4 s4 = *(const f32x4*)(sa_tile + wr * 64 + m * 32 + 8 * rg + 4 * hi);
#pragma unroll
            for (int i = 0; i < 4; ++i) { const float sc = s4[i] * sw;
#pragma unroll
                for (int n = 0; n < 2; ++n) acc[m][n][4 * rg + i] = (float)__float_as_int(acc[m][n][4 * rg + i]) * sc; }
            __builtin_amdgcn_sched_barrier(0);
        }
}

__device__ __forceinline__ void phase_prologue(const Params& p, unsigned char* smem) {
    float* sm = (float*)smem;
    const int tid = otid();
    for (int i = blockIdx.x * 256 + tid; i < 4096 * 48; i += gridDim.x * 256) {
        if (i < 4096 * 32) { const int pos = i >> 5, f = i & 31; const float inv = powf(10000.f, -(float)f / 32.f); float s, c; sincosf((float)pos * inv, &s, &c); WSP(f32x2, O_ROPED)[i] = (f32x2){c, s}; }
        else { const int j = i - 4096 * 32, pos = j >> 4, f = j & 15; const float inv = powf(10000.f, -(float)f / 16.f); float s, c; sincosf((float)pos * inv, &s, &c); WSP(f32x2, O_ROPEM)[j] = (f32x2){c, s}; }
    }
    const float amax0 = sample_amax(p.in[4], (size_t)1024 * EV_IN, sm), amax1 = sample_amax(p.in[12], (size_t)1024 * OD_IN, sm);
    int tb = 0;
    { const float* w = p.in[4];
      cvt_mat<true>([=](int, int nt, int&) -> const float* { const int n = nt * 32; if (n < 512) return w + n; if (n < 2048) return w + n + 32; if (n < 2080) return w + 512 + (n - 2048); return nullptr; },
              EV_IN, 1024, EV_INP / 32, 1, 0, nullptr, WSP(u16, O_WIN0), sm, tb, WQ_TOP / amax0); }
    { const float* w = p.in[7];
      cvt_mat([=](int, int nt, int&) -> const float* { const int n = nt * 32; if (n < 512) return w + (n >> 6) * 96 + (n & 63); return w + ((n - 512) >> 5) * 96 + 64; },
              768, 256, 24, 1, 0, p.in[6], WSP(u16, O_WQ), sm, tb); }
    { const float* w = p.in[9];
      cvt_mat([=](int, int nt, int&) -> const float* { return w + nt * 32; }, 1024, 256, 32, 1, 0, p.in[8], WSP(u16, O_WKV), sm, tb); }
    { const float* w = p.in[5];
      cvt_mat([=](int, int nt, int&) -> const float* { return w + nt * 32; }, 1024, 1024, 32, 1, 0, nullptr, WSP(u16, O_WOUT0), sm, tb); }
    { const float* w = p.in[12];
      cvt_mat<true>([=](int, int nt, int&) -> const float* { return w + nt * 32; }, OD_IN, 1024, OD_IN / 32, 1, 0, nullptr, WSP(u16, O_WIN1), sm, tb, WQ_TOP / amax1); }
    { const float* w = p.in[13];
      cvt_mat([=](int, int nt, int&) -> const float* { return w + nt * 32; }, 1024, 1024, 32, 1, 0, nullptr, WSP(u16, O_WOUT1), sm, tb); }
    { const float* w = p.in[16];
      cvt_mat([=](int, int nt, int&) -> const float* { return w + nt * 32; }, 512, 64, 16, 1, 0, nullptr, WSP(u16, O_W2T), sm, tb); }
    { const float* w = p.in[18];
      cvt_mat([=](int, int nt, int&) -> const float* { return w + nt * 32; }, 512, 64, 16, 1, 0, nullptr, WSP(u16, O_A2T), sm, tb); }
    { const float* w = p.in[19];
      cvt_mat([=](int, int nt, int&) -> const float* { return w + nt * 32; }, 512, 128, 16, 1, 0, nullptr, WSP(u16, O_G2T), sm, tb); }
    { const float* we = p.in[29];
      cvt_mat([=](int mat, int, int&) -> const float* { return we + (size_t)mat * 1024 * 32; }, 32, 1024, 1, 2, (size_t)128 * 1024, nullptr, WSP(u16, O_WR), sm, tb); }
    for (int i = blockIdx.x * 256 + tid; i < 2 * 96 * 1024; i += gridDim.x * 256) {
        const int l = i / (96 * 1024), r = (i / 1024) % 96, k = i % 1024;
        const float v = (r < 4) ? p.in[27][((size_t)l * 1024 + k) * 4 + r] : 0.f;
        WSP(u16, O_WR)[((size_t)l * 128 + 32 + r) * 1024 + k] = f2bf(v);
    }
    for (int l = 0; l < 2; ++l) {
        float m = 0.f;
        for (int mt = 31; mt <= 32; ++mt) { const f32x4* src = (const f32x4*)(p.in[mt] + (size_t)l * 32 * 1024 * 512);
            for (int c = blockIdx.x * 4 + (tid >> 6); c < 2048; c += gridDim.x * 4) { const f32x4 v = src[(size_t)c * 2048 + (tid & 63)]; m = fmaxf(fmaxf(m, fmaxf(fabsf(v[0]), fabsf(v[1]))), fmaxf(fabsf(v[2]), fabsf(v[3]))); } }
        float md = 0.f;
        { const f32x4* src = (const f32x4*)(p.in[33] + (size_t)l * 32 * 512 * 1024);
            for (int c = blockIdx.x * 4 + (tid >> 6); c < 2048; c += gridDim.x * 4) { const f32x4 v = src[(size_t)c * 2048 + (tid & 63)]; md = fmaxf(fmaxf(md, fmaxf(fabsf(v[0]), fabsf(v[1]))), fmaxf(fabsf(v[2]), fabsf(v[3]))); } }
        m = wave_max(m); md = wave_max(md);
        if ((tid & 63) == 0 && __float_as_uint(m) > __hip_atomic_load(WSP(unsigned, 0) + AMAX_W + l, __ATOMIC_RELAXED, __HIP_MEMORY_SCOPE_AGENT)) atomicMax(WSP(unsigned, 0) + AMAX_W + l, __float_as_uint(m));
        if ((tid & 63) == 0 && __float_as_uint(md) > __hip_atomic_load(WSP(unsigned, 0) + AMAX_W + 2 + l, __ATOMIC_RELAXED, __HIP_MEMORY_SCOPE_AGENT)) atomicMax(WSP(unsigned, 0) + AMAX_W + 2 + l, __float_as_uint(md));
    }
    rownorm_rows(p.in[0], p.in[1], WSP(unsigned char, O_HA), WSP(float, O_SAIN));
}

__device__ __forceinline__ void epi_store_bf16(const f32x16 (&acc)[2][2], u16* dst, int ld, int row0, int col0, int l31, int hi) {
#pragma unroll
    for (int m = 0; m < 2; ++m)
#pragma unroll
        for (int n = 0; n < 2; ++n)
#pragma unroll
            for (int r = 0; r < 16; ++r) dst[(size_t)(row0 + m * 32 + crow(r, hi)) * ld + col0 + n * 32 + l31] = f2bf(acc[m][n][r]);
}
__device__ __forceinline__ void epi_store_tile_lds(const f32x16 (&acc)[2][2], u16* dst, int ld, int row0, int col0, int row_lim, u16* Cs) {
    const int tid = otid(), lane = tid & 63, wid = tid >> 6, wr = wid >> 1, wc = wid & 1, l31 = lane & 31, hi = lane >> 5;
#pragma unroll
    for (int m = 0; m < 2; ++m)
#pragma unroll
        for (int n = 0; n < 2; ++n)
#pragma unroll
            for (int r = 0; r < 16; ++r) Cs[(wr * 64 + m * 32 + crow(r, hi)) * 136 + wc * 64 + n * 32 + l31] = f2bf(acc[m][n][r]);
    __syncthreads();
#pragma unroll
    for (int i = 0; i < 8; ++i) { const int c = tid + 256 * i, row = c >> 4, cc = c & 15;
        if (row0 + row < row_lim) *(u32x4*)(dst + (size_t)(row0 + row) * ld + col0 + cc * 8) = *(const u32x4*)(Cs + row * 136 + cc * 8); }
    __syncthreads();
}
template <bool F16>
__device__ __forceinline__ void lds_put16(const f32x16 (&acc)[2][2], u16* Cs, int wr, int wc, int l31, int hi) {
#pragma unroll
    for (int m = 0; m < 2; ++m)
#pragma unroll
        for (int n = 0; n < 2; ++n)
#pragma unroll
            for (int r = 0; r < 16; ++r) { const float v = acc[m][n][r];
                Cs[(wr * 64 + m * 32 + crow(r, hi)) * 136 + wc * 64 + n * 32 + l31] = F16 ? __builtin_bit_cast(u16, (h16)v) : f2bf(v); }
}
template <int NCH, class DstFn>
__device__ __forceinline__ void lds_rows_store(const u16* Cs, DstFn dstfn) {
    const int tid = otid();
#pragma unroll
    for (int i = 0; i < (128 * NCH) / 256; ++i) { const int c = tid + 256 * i, row = c / NCH, cc = c % NCH;
        u16* d = dstfn(row, cc);
        if (d) *(u32x4*)d = *(const u32x4*)(Cs + row * 136 + cc * 8); }
}
__device__ __forceinline__ void epi_store_T(const f32x16 (&acc)[2][2], unsigned char* plane, int e0, int pos0, float sc, int l31, int hi) {
    const float s16 = sc * V_F8_SCALE;
#pragma unroll
    for (int m = 0; m < 2; ++m)
#pragma unroll
        for (int n = 0; n < 2; ++n)
#pragma unroll
            for (int rg = 0; rg < 4; ++rg) {
                int w = 0;
                w = __builtin_amdgcn_cvt_pk_fp8_f32(f8clamp(acc[m][n][4 * rg] * s16), f8clamp(acc[m][n][4 * rg + 1] * s16), w, false);
                w = __builtin_amdgcn_cvt_pk_fp8_f32(f8clamp(acc[m][n][4 * rg + 2] * s16), f8clamp(acc[m][n][4 * rg + 3] * s16), w, true);
                *(int*)(plane + (size_t)(e0 + n * 32 + l31) * SEQ + pos0 + m * 32 + 8 * rg + 4 * hi) = w;
            }
}

__device__ __forceinline__ void phase_inproj0(const Params& p, unsigned char* smem) {
    WAVE_IDS;
    const u16* A = WSP(u16, O_HA); const u16* B = WSP(u16, O_WIN0);
    const f32x2* ropeD = WSP(f32x2, O_ROPED); const f32x2* ropeM = WSP(f32x2, O_ROPEM);
    constexpr int NCT = EV_INP / 128;
    const float swinv = sample_amax(p.in[4], (size_t)1024 * EV_IN, (float*)smem) * (1.f / WQ_TOP);
    GemmRegs g; unsigned aoff[4], boff[4];
    float sareg = 0.f; float* sl = (float*)(smem + 73728);
    int rt, ct, rtn = 0, ctn = 0; bool have = dense_tile(0, NCT, rt, ct);
    if (have) { lin_off(aoff, rt * 128, 512, 0); lin_off(boff, ct * 128, 512, 0); gemm_prefetch(g, A, aoff, B, boff, 8); if (tid < 128) sareg = WSP(float, O_SAIN)[rt * 128 + tid]; }
    for (int it = 0; have; ++it) {
        const int m0 = rt * 128, n0 = ct * 128;
        f32x16 acc[2][2];
        gemm_run<1>(acc, g, A, aoff, B, boff, 8, (u16*)smem);
        if (tid < 128) sl[tid] = sareg;
        have = dense_tile(it + 1, NCT, rtn, ctn);
        if (have) { lin_off(aoff, rtn * 128, 512, 0); lin_off(boff, ctn * 128, 512, 0); gemm_prefetch(g, A, aoff, B, boff, 8); if (tid < 128) sareg = WSP(float, O_SAIN)[rtn * 128 + tid]; }
        __syncthreads();
        dequant_tile(acc, sl, swinv);
        const int row0 = m0 + wr * 64, b = m0 >> 12, pos0 = row0 & (SEQ - 1);
        if (ct < 4) {
            epi_store_tile_lds(acc, WSP(u16, O_CLAT), 512, m0, n0, T, (u16*)smem);
        } else if (ct < 12) {
            const bool isq = ct < 8; const int hh = (ct - 4) & 3;
            u16* dst = WSP(u16, isq ? O_QD : O_KD) + (size_t)((b * 4 + hh) * 2) * SEQ * 64;
            const float sc = isq ? QSCALE_D : 1.f;
#pragma unroll
            for (int m = 0; m < 2; ++m)
#pragma unroll
                for (int r = 0; r < 16; ++r) {
                    const int pos = pos0 + m * 32 + crow(r, hi);
                    const f32x2 cs = ropeD[pos * 32 + l31];
                    const float x1 = acc[m][0][r], x2 = acc[m][1][r];
                    acc[m][0][r] = (x1 * cs[0] - x2 * cs[1]) * sc; acc[m][1][r] = (x2 * cs[0] + x1 * cs[1]) * sc;
                }
            lds_put16<false>(acc, (u16*)smem, wr, wc, l31, hi);
            __syncthreads();
            { const int p0m = m0 & (SEQ - 1);
              lds_rows_store<16>((const u16*)smem, [=](int row, int cc) -> u16* { return dst + (size_t)(cc >> 3) * SEQ * 64 + (size_t)(p0m + row) * 64 + (cc & 7) * 8; }); }
            __syncthreads();
        } else if (ct < 16) {
            const int hh = ct - 12;
            epi_store_T(acc, WSP(unsigned char, O_VTD) + (size_t)(b * 4 + hh) * 128 * SEQ, wc * 64, pos0, 1.f, l31, hi);
        } else {
            if (wc == 0) {
#pragma unroll
                for (int m = 0; m < 2; ++m)
#pragma unroll
                    for (int r = 0; r < 16; ++r) {
                        const int pos = pos0 + m * 32 + crow(r, hi);
                        const float x = acc[m][0][r], y = __shfl_xor(x, 16);
                        const f32x2 cs = ropeM[pos * 16 + (l31 & 15)];
                        const float o = (l31 < 16) ? (x * cs[0] - y * cs[1]) : (x * cs[0] + y * cs[1]);
                        const u16 ob = f2bf(o);
#pragma unroll
                        for (int h8 = 0; h8 < 8; ++h8) WSP(u16, O_KM)[((size_t)(b * 8 + h8) * SEQ + pos) * 96 + 64 + l31] = ob;
                    }
            }
        }
            rt = rtn; ct = ctn;
    }
}

__device__ __forceinline__ void phase_upproj(const Params& p, unsigned char* smem) {
    WAVE_IDS;
    const u16* A = WSP(u16, O_CLAT);
    const f32x2* ropeM = WSP(f32x2, O_ROPEM);
    float* rsl = (float*)(smem + 73728);
    int rt, c14;
    for (int it = 0; dense_tile(it, 14, rt, c14); ++it) {
        const int m0 = rt * 128;
        const bool isq = c14 < 6; const int ct = isq ? c14 : c14 - 6; const int acol = isq ? 0 : 256;
        {
            const int row = tid >> 1, half = tid & 1;
            const u16* q = A + (size_t)(m0 + row) * 512 + acol + half * 128;
            float ss = 0.f;
#pragma unroll
            for (int i = 0; i < 16; ++i) { const u32x4 v = *(const u32x4*)(q + i * 8);
#pragma unroll
                for (int j = 0; j < 4; ++j) { const float a = bflo(v[j]), c = bfhi(v[j]); ss += a * a + c * c; } }
            ss += __shfl_xor(ss, 1);
            if (half == 0) rsl[row] = rsqrtf(ss * (1.f / 256.f) + EPS);
        }
        unsigned aoff[4], boff[4]; lin_off(aoff, m0, 512, acol); lin_off(boff, ct * 128, 256, 0);
        f32x16 acc[2][2];
        gemm_mainloop(acc, A, aoff, isq ? WSP(u16, O_WQ) : WSP(u16, O_WKV), boff, 4, (u16*)smem);
        const int row0 = m0 + wr * 64, b = m0 >> 12, pos0 = row0 & (SEQ - 1);
#pragma unroll
        for (int m = 0; m < 2; ++m)
#pragma unroll
            for (int r = 0; r < 16; ++r) { const float rs = rsl[wr * 64 + m * 32 + crow(r, hi)];
                acc[m][0][r] *= rs; acc[m][1][r] *= rs; }
        const int p0m = m0 & (SEQ - 1);
        if (isq) {
            if (ct < 4) {
#pragma unroll
                for (int m = 0; m < 2; ++m)
#pragma unroll
                    for (int n = 0; n < 2; ++n)
#pragma unroll
                        for (int r = 0; r < 16; ++r) acc[m][n][r] *= QSCALE_M;
                lds_put16<false>(acc, (u16*)smem, wr, wc, l31, hi);
                __syncthreads();
                u16* dst = WSP(u16, O_QM) + (size_t)(b * 8 + 2 * ct) * SEQ * 96;
                lds_rows_store<16>((const u16*)smem, [=](int row, int cc) -> u16* { return dst + (size_t)(cc >> 3) * SEQ * 96 + (size_t)(p0m + row) * 96 + (cc & 7) * 8; });
                __syncthreads();
            } else {
#pragma unroll
                for (int m = 0; m < 2; ++m)
#pragma unroll
                    for (int n = 0; n < 2; ++n)
#pragma unroll
                        for (int r = 0; r < 16; ++r) {
                            const int pos = pos0 + m * 32 + crow(r, hi);
                            const float x = acc[m][n][r], y = __shfl_xor(x, 16);
                            const f32x2 cs = ropeM[pos * 16 + (l31 & 15)];
                            acc[m][n][r] = ((l31 < 16) ? (x * cs[0] - y * cs[1]) : (x * cs[0] + y * cs[1])) * QSCALE_M;
                        }
                lds_put16<false>(acc, (u16*)smem, wr, wc, l31, hi);
                __syncthreads();
                u16* dst = WSP(u16, O_QM) + (size_t)(b * 8 + (ct - 4) * 4) * SEQ * 96 + 64;
                lds_rows_store<16>((const u16*)smem, [=](int row, int cc) -> u16* { return dst + (size_t)(cc >> 2) * SEQ * 96 + (size_t)(p0m + row) * 96 + (cc & 3) * 8; });
                __syncthreads();
            }
        } else {
            const int head = ct;
            if (wc == 1) epi_store_T(acc, WSP(unsigned char, O_VTM) + (size_t)(b * 8 + head) * 64 * SEQ, 0, pos0, 1.f, l31, hi);
            lds_put16<false>(acc, (u16*)smem, wr, wc, l31, hi);
            __syncthreads();
            u16* dst = WSP(u16, O_KM) + (size_t)(b * 8 + head) * SEQ * 96;
            lds_rows_store<8>((const u16*)smem, [=](int row, int cc) -> u16* { return dst + (size_t)(p0m + row) * 96 + cc * 8; });
            __syncthreads();
        }
        __syncthreads();
    }
}

template <int DK, int DV>
__device__ __forceinline__ void attn_core(const u16* __restrict__ Q, const u16* __restrict__ K, const unsigned char* __restrict__ Vt, int qt, f32x16 (&o)[DV / 32], float& lrun, u16* smem) {
    WAVE_IDS;
    constexpr int KS = DK + 8, VS8 = 80, KT = 64 * KS, VT8 = DV * VS8;
    constexpr int NKC = DK / 32, NVC = DV / 64, NDT = DV / 32, NKS = DK / 16;
    constexpr float THR = 8.f;
    u16* Kl = smem; unsigned char* Vl = (unsigned char*)(smem + 2 * KT);
    const int q0 = qt * 128 + wid * 32;
    const int ntw = (q0 >> 6) + 1, ntb = qt * 2 + 2;
    bf16x8 qf[NKS];
#pragma unroll
    for (int s = 0; s < NKS; ++s) qf[s] = *(const bf16x8*)(Q + (size_t)(q0 + l31) * DK + s * 16 + hi * 8);
    u32x4 rk[NKC], rv[NVC];
#pragma unroll
    for (int d = 0; d < NDT; ++d)
#pragma unroll
        for (int r = 0; r < 16; ++r) o[d][r] = 0.f;
    f32x16 negm;
#pragma unroll
    for (int r = 0; r < 16; ++r) negm[r] = 0.f;
    lrun = 0.f;
    auto gload = [&](int j) {
#pragma unroll
        for (int i = 0; i < NKC; ++i) rk[i] = *(const u32x4*)(K + (size_t)j * 64 * DK + (size_t)(tid + 256 * i) * 8);
#pragma unroll
        for (int i = 0; i < NVC; ++i) { const int c = tid + 256 * i; rv[i] = *(const u32x4*)(Vt + (size_t)(c >> 2) * SEQ + j * 64 + (c & 3) * 16); }
    };
    auto lstore = [&](int buf) {
#pragma unroll
        for (int i = 0; i < NKC; ++i) { const int c = tid + 256 * i, row = c / (DK / 8), kc = c % (DK / 8); *(u32x4*)(Kl + buf * KT + row * KS + kc * 8) = rk[i]; }
#pragma unroll
        for (int i = 0; i < NVC; ++i) { const int c = tid + 256 * i, part = c & 3;
            unsigned char* d = Vl + buf * VT8 + (c >> 2) * VS8 + part * 8;
            *(u32x2*)d = (u32x2){rv[i][0], rv[i][2]}; *(u32x2*)(d + 32) = (u32x2){rv[i][1], rv[i][3]}; }
    };
    gload(0); lstore(0); __syncthreads();
    for (int j = 0; j < ntb; ++j) {
        const int cur = j & 1;
        if (j + 1 < ntb) gload(j + 1);
        __builtin_amdgcn_sched_barrier(0);
        if (j < ntw) {
            const u16* Kb = Kl + cur * KT; const unsigned char* Vb = Vl + cur * VT8;
            f32x16 p0, p1;
            __builtin_amdgcn_s_setprio(1);
            bf16x8 kf[2][2];
#pragma unroll
            for (int s = 0; s < 2; ++s) { kf[s][0] = *(const bf16x8*)(Kb + l31 * KS + s * 16 + hi * 8); kf[s][1] = *(const bf16x8*)(Kb + (32 + l31) * KS + s * 16 + hi * 8); }
#pragma unroll
            for (int s = 0; s < NKS; ++s) {
                if (s == 0) { p0 = MFMA(kf[0][0], qf[0], negm); p1 = MFMA(kf[0][1], qf[0], negm); }
                else { p0 = MFMA(kf[s & 1][0], qf[s], p0); p1 = MFMA(kf[s & 1][1], qf[s], p1); }
                if (s + 2 < NKS) { kf[s & 1][0] = *(const bf16x8*)(Kb + l31 * KS + (s + 2) * 16 + hi * 8); kf[s & 1][1] = *(const bf16x8*)(Kb + (32 + l31) * KS + (s + 2) * 16 + hi * 8); }
                __builtin_amdgcn_sched_barrier(0);
            }
            u32x4 vf[NDT][2];
#pragma unroll
            for (int d = 0; d < NDT; ++d) { const unsigned char* vp = Vb + (d * 32 + l31) * VS8 + hi * 32; vf[d][0] = *(const u32x4*)vp; vf[d][1] = *(const u32x4*)(vp + 16); }
            __builtin_amdgcn_s_setprio(0);
            __builtin_amdgcn_sched_barrier(0);
            float mx = p0[0];
#pragma unroll
            for (int r = 1; r < 16; ++r) mx = fmaxf(mx, p0[r]);
#pragma unroll
            for (int r = 0; r < 16; ++r) mx = fmaxf(mx, p1[r]);
            mx = xhalf_max(mx);
            if (j == 0 || __any(mx > THR)) {
                const float dm = (j == 0) ? mx : fmaxf(mx, 0.f), alpha = (j == 0) ? 0.f : __builtin_amdgcn_exp2f(-dm);
                lrun *= alpha;
#pragma unroll
                for (int d = 0; d < NDT; ++d)
#pragma unroll
                    for (int r = 0; r < 16; ++r) o[d][r] *= alpha;
#pragma unroll
                for (int r = 0; r < 16; ++r) { p0[r] -= dm; p1[r] -= dm; negm[r] -= dm; }
            }
            float ps = 0.f;
#pragma unroll
            for (int r = 0; r < 16; ++r) { p0[r] = __builtin_amdgcn_exp2f(p0[r]); ps += p0[r]; }
#pragma unroll
            for (int r = 0; r < 16; ++r) { p1[r] = __builtin_amdgcn_exp2f(p1[r]); ps += p1[r]; }
            lrun += xhalf_sum(ps);
            u32x4 plo, phi;
#pragma unroll
            for (int d4 = 0; d4 < 4; ++d4) {
                int w0 = 0, w1 = 0;
                w0 = __builtin_amdgcn_cvt_pk_fp8_f32(p0[4 * d4], p0[4 * d4 + 1], w0, false); w0 = __builtin_amdgcn_cvt_pk_fp8_f32(p0[4 * d4 + 2], p0[4 * d4 + 3], w0, true);
                w1 = __builtin_amdgcn_cvt_pk_fp8_f32(p1[4 * d4], p1[4 * d4 + 1], w1, false); w1 = __builtin_amdgcn_cvt_pk_fp8_f32(p1[4 * d4 + 2], p1[4 * d4 + 3], w1, true);
                plo[d4] = (unsigned)w0; phi[d4] = (unsigned)w1;
            }
            __builtin_amdgcn_s_setprio(1);
#pragma unroll
            for (int d = 0; d < NDT; ++d) o[d] = mma_f8(vf[d][0], vf[d][1], plo, phi, o[d]);
            __builtin_amdgcn_s_setprio(0);
        }
        __builtin_amdgcn_sched_barrier(0);
        if (j + 1 < ntb) lstore(cur ^ 1);
        __syncthreads();
    }
}

__device__ __forceinline__ void phase_attn(const Params& p, unsigned char* smem) {
    WAVE_IDS;
    unsigned* ctr = WSP(unsigned, 0) + ATTN_CTR_W;
    int* bc = (int*)(smem + 73728 + 1024);
    float* sl = (float*)(smem + 73728 + 1536);
    if (tid < 64) { const float* lam = p.in[10]; float a = lam[tid] * lam[64 + tid], c = lam[128 + tid] * lam[192 + tid]; a = wave_sum(a); c = wave_sum(c);
        if (tid == 0) sl[0] = __expf(a) - __expf(c) + 0.2f; }
    __syncthreads();
    const float lamf = sl[0];
    u32x2* scr = WSP(u32x2, O_ATTSCR) + (size_t)blockIdx.x * 4096;
    for (;;) {
        if (tid == 0) *bc = (int)atomicAdd(ctr, 1u);
        __syncthreads();
        const int qi = *bc;
        __syncthreads();
        if (qi >= 3072) break;
        const int item = qi;
        const int level = item / 96, r = item - level * 96, qt = 31 - level;
        const int q0 = qt * 128 + wid * 32;
        if (r < 32) {
            const int bh = r, b = bh >> 2, hh = bh & 3;
            f32x16 o[4]; float l1;
            attn_core<64, 128>(WSP(u16, O_QD) + (size_t)(bh * 2) * SEQ * 64, WSP(u16, O_KD) + (size_t)(bh * 2) * SEQ * 64, WSP(unsigned char, O_VTD) + (size_t)bh * 128 * SEQ, qt, o, l1, (u16*)smem);
            { const float il = 1.f / (l1 * V_F8_SCALE);
#pragma unroll
              for (int d = 0; d < 4; ++d)
#pragma unroll
                  for (int rg = 0; rg < 4; ++rg) { u32x2 w; w[0] = cvtpk(o[d][4 * rg] * il, o[d][4 * rg + 1] * il); w[1] = cvtpk(o[d][4 * rg + 2] * il, o[d][4 * rg + 3] * il);
                      scr[((wid * 4 + d) * 4 + rg) * 64 + lane] = w; } }
            float l2;
            attn_core<64, 128>(WSP(u16, O_QD) + (size_t)(bh * 2 + 1) * SEQ * 64, WSP(u16, O_KD) + (size_t)(bh * 2 + 1) * SEQ * 64, WSP(unsigned char, O_VTD) + (size_t)bh * 128 * SEQ, qt, o, l2, (u16*)smem);
            const float il2 = lamf / (l2 * V_F8_SCALE);
            float ss = 0.f;
#pragma unroll
            for (int d = 0; d < 4; ++d)
#pragma unroll
                for (int rg = 0; rg < 4; ++rg) { const u32x2 w = scr[((wid * 4 + d) * 4 + rg) * 64 + lane];
                    o[d][4 * rg] = bflo(w[0]) - o[d][4 * rg] * il2; o[d][4 * rg + 1] = bfhi(w[0]) - o[d][4 * rg + 1] * il2;
                    o[d][4 * rg + 2] = bflo(w[1]) - o[d][4 * rg + 2] * il2; o[d][4 * rg + 3] = bfhi(w[1]) - o[d][4 * rg + 3] * il2;
                    ss += o[d][4 * rg] * o[d][4 * rg] + o[d][4 * rg + 1] * o[d][4 * rg + 1] + o[d][4 * rg + 2] * o[d][4 * rg + 2] + o[d][4 * rg + 3] * o[d][4 * rg + 3]; }
            ss = xhalf_sum(ss);
            const float rs = rsqrtf(ss * (1.f / 128.f) + EPS) * 0.8f;
            u16* dst = WSP(u16, O_HA) + ((size_t)b * SEQ + q0 + l31) * 1024 + 512 + hh * 128;
#pragma unroll
            for (int d = 0; d < 4; ++d)
#pragma unroll
                for (int rg = 0; rg < 4; ++rg) { const int e = d * 32 + 8 * rg + 4 * hi; const f32x4 gsub = *(const f32x4*)(p.in[11] + e);
                    u32x2 w; w[0] = cvtpk(o[d][4 * rg] * rs * gsub[0], o[d][4 * rg + 1] * rs * gsub[1]); w[1] = cvtpk(o[d][4 * rg + 2] * rs * gsub[2], o[d][4 * rg + 3] * rs * gsub[3]);
                    *(u32x2*)(dst + e) = w; }
        } else {
            const int bh = r - 32, b = bh >> 3, h8 = bh & 7;
            f32x16 o[2]; float l1;
            attn_core<96, 64>(WSP(u16, O_QM) + (size_t)bh * SEQ * 96, WSP(u16, O_KM) + (size_t)bh * SEQ * 96, WSP(unsigned char, O_VTM) + (size_t)bh * 64 * SEQ, qt, o, l1, (u16*)smem);
            const float il = 1.f / (l1 * V_F8_SCALE);
            u16* dst = WSP(u16, O_HA) + ((size_t)b * SEQ + q0 + l31) * 1024 + h8 * 64;
#pragma unroll
            for (int d = 0; d < 2; ++d)
#pragma unroll
                for (int rg = 0; rg < 4; ++rg) { u32x2 w; w[0] = cvtpk(o[d][4 * rg] * il, o[d][4 * rg + 1] * il); w[1] = cvtpk(o[d][4 * rg + 2] * il, o[d][4 * rg + 3] * il);
                    *(u32x2*)(dst + d * 32 + 8 * rg + 4 * hi) = w; }
        }
    }
}

__device__ __forceinline__ void phase_outproj(const Params& p, unsigned char* smem, int l) {
    WAVE_IDS;
    const u16* A = WSP(u16, O_HA); const u16* B = WSP(u16, l == 0 ? O_WOUT0 : O_WOUT1);
    const float* res = p.in[0];
    float* Cs = (float*)smem;
    GemmRegs g; unsigned aoff[4], boff[4];
    int rt, ct, rtn = 0, ctn = 0; bool have = dense_tile(0, 8, rt, ct);
    if (have) { lin_off(aoff, rt * 128, 1024, 0); lin_off(boff, ct * 128, 1024, 0); gemm_prefetch(g, A, aoff, B, boff, 16); }
    for (int it = 0; have; ++it) {
        const int m0 = rt * 128, n0 = ct * 128;
        f32x16 acc[2][2];
        gemm_run(acc, g, A, aoff, B, boff, 16, (u16*)smem);
        have = dense_tile(it + 1, 8, rtn, ctn);
        if (have) { lin_off(aoff, rtn * 128, 1024, 0); lin_off(boff, ctn * 128, 1024, 0); gemm_prefetch(g, A, aoff, B, boff, 16); }
#pragma unroll
        for (int m = 0; m < 2; ++m)
#pragma unroll
            for (int n = 0; n < 2; ++n)
#pragma unroll
                for (int r = 0; r < 16; ++r) Cs[(wr * 64 + m * 32 + crow(r, hi)) * 132 + wc * 64 + n * 32 + l31] = acc[m][n][r];
        __syncthreads();
#pragma unroll
        for (int i = 0; i < 8; ++i) { const int c = tid + 256 * i, row = c >> 4, c8 = (c & 15) * 8;
            f32x4 r0, r1;
            if (l == 0) { const float* q = res + (size_t)(m0 + row) * D + n0 + c8; r0 = *(const f32x4*)q; r1 = *(const f32x4*)(q + 4); }
            else { const u32x4 w = *(const u32x4*)(HB(m0 + row) + n0 + c8); r0 = bf4_to_f32((u32x2){w[0], w[1]}); r1 = bf4_to_f32((u32x2){w[2], w[3]}); }
            const f32x4 h0 = r0 + *(const f32x4*)(Cs + row * 132 + c8), h1 = r1 + *(const f32x4*)(Cs + row * 132 + c8 + 4);
            u32x4 o; o[0] = cvtpk(h0[0], h0[1]); o[1] = cvtpk(h0[2], h0[3]); o[2] = cvtpk(h1[0], h1[1]); o[3] = cvtpk(h1[2], h1[3]);
            *(u32x4*)(HB(m0 + row) + n0 + c8) = o; }
        __syncthreads();
            rt = rtn; ct = ctn;
    }
}

__device__ __forceinline__ void phase_route(const Params& p, unsigned char* smem, int l) {
    WAVE_IDS;
    const u16* A = WSP(u16, O_HA); const u16* B = WSP(u16, O_WR) + (size_t)l * 128 * 1024;
    float* lg = (float*)smem;
    int* lc = (int*)(smem + 73728 + 1664);
    float* sarow = (float*)(smem + 73728);
    unsigned* cnt = WSP(unsigned, 0) + CNT_W + l * 64;
    const float* g = p.in[2] + l * 1024;
    int rt, ct0;
    for (int it = 0; dense_tile(it, 1, rt, ct0); ++it) {
        const int m0 = rt * 128;
        {
            f32x4 gv[4];
#pragma unroll
            for (int i = 0; i < 4; ++i) gv[i] = *(const f32x4*)(g + i * 256 + lane * 4);
            constexpr int RB = 4;
            for (int r2 = 0; r2 < 32; r2 += RB) {
                const int row = m0 + wid * 32 + r2;
                f32x4 x[RB][4]; float ss[RB];
#pragma unroll
                for (int u = 0; u < RB; ++u)
#pragma unroll
                    for (int i = 0; i < 4; ++i) x[u][i] = bf4_to_f32(*(const u32x2*)(HB(row + u) + i * 256 + lane * 4));
#pragma unroll
                for (int u = 0; u < RB; ++u) {
                    ss[u] = 0.f;
#pragma unroll
                    for (int i = 0; i < 4; ++i) ss[u] += x[u][i][0] * x[u][i][0] + x[u][i][1] * x[u][i][1] + x[u][i][2] * x[u][i][2] + x[u][i][3] * x[u][i][3];
                }
#pragma unroll
                for (int o = 32; o; o >>= 1)
#pragma unroll
                    for (int u = 0; u < RB; ++u) ss[u] += __shfl_xor(ss[u], o);
                float am[RB];
#pragma unroll
                for (int u = 0; u < RB; ++u) {
                    const float rs = rsqrtf(ss[u] * (1.f / D) + EPS);
                    am[u] = 0.f;
#pragma unroll
                    for (int i = 0; i < 4; ++i) {
#pragma unroll
                        for (int c = 0; c < 4; ++c) { x[u][i][c] *= rs * gv[i][c]; am[u] = fmaxf(am[u], fabsf(x[u][i][c])); }
                        u32x2 o; o[0] = cvtpk(x[u][i][0], x[u][i][1]); o[1] = cvtpk(x[u][i][2], x[u][i][3]);
                        *(u32x2*)(WSP(u16, O_HA) + (size_t)(row + u) * D + i * 256 + lane * 4) = o; }
                }
#pragma unroll
                for (int o = 32; o; o >>= 1)
#pragma unroll
                    for (int u = 0; u < RB; ++u) am[u] = fmaxf(am[u], __shfl_xor(am[u], o));
#pragma unroll
                for (int u = 0; u < RB; ++u) {
                    const float amx = fmaxf(am[u], 1e-30f);
                    const float qa = 127.f / amx;
#pragma unroll
                    for (int i = 0; i < 4; ++i) { unsigned q[4];
#pragma unroll
                        for (int c = 0; c < 4; ++c) q[c] = (unsigned)__float2int_rn(x[u][i][c] * qa) & 255u;
                        *(unsigned*)(WSP(unsigned char, O_A8) + (size_t)(row + u) * D + i * 256 + lane * 4) = q[0] | (q[1] << 8) | (q[2] << 16) | (q[3] << 24); }
                    if (lane == 0) sarow[row + u - m0] = amx * (1.f / 127.f);
                }
            }
            __syncthreads();
        }
        unsigned aoff[4], boff[4]; lin_off(aoff, m0, 1024, 0); lin_off(boff, 0, 1024, 0);
        f32x16 acc[2][2];
        gemm_mainloop(acc, A, aoff, B, boff, 16, (u16*)smem);
        if (wc == 0) {
#pragma unroll
            for (int m = 0; m < 2; ++m)
#pragma unroll
                for (int r = 0; r < 16; ++r) { const int row = wr * 64 + m * 32 + crow(r, hi);
                    lg[row * 37 + l31] = acc[m][0][r]; if (l31 < 4) lg[row * 37 + 32 + l31] = acc[m][1][r]; }
        }
        if (tid < 32) lc[tid] = 0;
        __syncthreads();
        int ea = 0, eb = 0, la = 0, lb = 0; float gw0 = 0.f, gw1 = 0.f;
        if (tid < 128) {
            const float* z = lg + tid * 37;
            float zg[4]; int gsel = 0;
#pragma unroll
            for (int i = 0; i < 4; ++i) zg[i] = z[32 + i] + p.in[28][l * 4 + i];
#pragma unroll
            for (int i = 1; i < 4; ++i) if (zg[i] > zg[gsel]) gsel = i;
            float den = 0.f;
#pragma unroll
            for (int i = 0; i < 4; ++i) den += __expf(zg[i] - zg[gsel]);
            const float pg = 1.f / den;
            float ze[8];
#pragma unroll
            for (int i = 0; i < 8; ++i) ze[i] = z[gsel * 8 + i] + p.in[30][l * 32 + gsel * 8 + i];
            int i0 = 0;
#pragma unroll
            for (int i = 1; i < 8; ++i) if (ze[i] > ze[i0]) i0 = i;
            int i1 = (i0 == 0) ? 1 : 0;
#pragma unroll
            for (int i = 0; i < 8; ++i) if (i != i0 && ze[i] > ze[i1]) i1 = i;
            const float e1 = __expf(ze[i1] - ze[i0]);
            const float w0 = pg / (1.f + e1), w1 = pg * e1 / (1.f + e1);
            ea = gsel * 8 + i0; eb = gsel * 8 + i1;
            la = atomicAdd(&lc[ea], 1); lb = atomicAdd(&lc[eb], 1);
            gw0 = w0; gw1 = w1;
        }
        __syncthreads();
        if (tid < 32) { const int c = lc[tid]; lc[32 + tid] = c ? (int)atomicAdd(&cnt[tid], (unsigned)c) : 0; }
        __syncthreads();
        if (tid < 128) { const int pa = lc[32 + ea] + la, pb = lc[32 + eb] + lb, t = m0 + tid; const float sa = sarow[tid];
            WSP(int4, O_SEL)[t] = make_int4(ea, pa, eb, pb);
            WSP(int, O_TOK2)[(size_t)ea * T + pa] = t; WSP(int, O_TOK2)[(size_t)eb * T + pb] = t;
            WSP(f32x2, O_GS2)[(size_t)ea * T + pa] = (f32x2){gw0, sa}; WSP(f32x2, O_GS2)[(size_t)eb * T + pb] = (f32x2){gw1, sa}; }
        __syncthreads();
    }
    moe_cvt_dynamic(p, l, (float*)smem, WSP(unsigned, 0) + (l == 0 ? CONV0_CTR_W : CONV1_CTR_W), (int*)(smem + 73728 + 1024));
}

__device__ __forceinline__ void expert_offsets(const Params& p, int l, int* offs) {
    if (otid() < 32) offs[128 + otid()] = (int)__hip_atomic_load(WSP(unsigned, 0) + CNT_W + l * 64 + otid(), __ATOMIC_RELAXED, __HIP_MEMORY_SCOPE_AGENT);
    __syncthreads();
    if (otid() == 0) { int a = 0, tl = 0;
        for (int e = 0; e < 32; ++e) { offs[e] = a; offs[64 + e] = tl; const int c = offs[128 + e]; a += c; tl += (c + 127) >> 7; }
        offs[32] = a; offs[64 + 32] = tl; }
    __syncthreads();
}

__device__ __forceinline__ void phase_lists(const Params& p, unsigned char* smem, int l) {
    int* offs = (int*)(smem + 73728);
    expert_offsets(p, l, offs);
    for (int t = blockIdx.x * 256 + otid(); t < T; t += gridDim.x * 256) {
        const int4 s = WSP(int4, O_SEL)[t]; const f32x2 g = WSP(f32x2, O_GATES)[t];
        const int r0 = offs[s.x] + s.y, r1 = offs[s.z] + s.w;
        WSP(int, O_TOKROW)[r0] = t; WSP(int, O_TOKROW)[r1] = t;
        WSP(float, O_GATEROW)[r0] = g[0]; WSP(float, O_GATEROW)[r1] = g[1];
        const float sa = WSP(float, O_SA8)[t];
        WSP(f32x2, O_GSROW)[r0] = (f32x2){g[0], sa}; WSP(f32x2, O_GSROW)[r1] = (f32x2){g[1], sa};
        WSP(int, O_ROWTOK)[2 * t] = r0; WSP(int, O_ROWTOK)[2 * t + 1] = r1;
    }
}

__device__ __forceinline__ void phase_moe1(const Params& p, unsigned char* smem, int l) {
    WAVE_IDS;
    int* offs = (int*)(smem + 73728);
    expert_offsets(p, l, offs);
    const int ntl = offs[64 + 32];
    const u16* A = WSP(u16, O_A8);
    const float swinv = fmaxf(__uint_as_float(__hip_atomic_load(WSP(unsigned, 0) + AMAX_W + l, __ATOMIC_RELAXED, __HIP_MEMORY_SCOPE_AGENT)), 1e-30f) * (1.f / WQ_TOP);
    GemmRegs g; unsigned aoff[4], boff[4];
    f32x2 gsreg = {0.f, 0.f}; f32x2* gl = (f32x2*)(smem + ROWSC_LDS);
    auto setup = [&](int it_, int& rtg_, int& ct_, int& e_, int& rbeg_, int& rend_) -> bool {
        if (!moe_tile(it_, ntl, rtg_, ct_)) return false;
        e_ = 0; while (offs[64 + e_ + 1] <= rtg_) ++e_;
        rbeg_ = offs[e_] + (rtg_ - offs[64 + e_]) * 128; rend_ = offs[e_ + 1];
#pragma unroll
        for (int i = 0; i < 4; ++i) { int r = rbeg_ + (tid >> 3) + 32 * i; r = r < rend_ ? r : rend_ - 1; aoff[i] = (unsigned)WSP(int, O_TOK2)[(size_t)e_ * T + (r - offs[e_])] * 512u + (tid & 7) * 8; }
        lin_off(boff, ct_ * 128, 512, 0);
        gemm_prefetch(g, A, aoff, WSP(u16, O_WGU) + (size_t)e_ * 1024 * 512, boff, 8);
        if (tid < 128) gsreg = WSP(f32x2, O_GS2)[(size_t)e_ * T + (rbeg_ - offs[e_]) + tid];
        return true; };
    int rtg, ct, e, rbeg, rend, rtgn = 0, ctn = 0, en = 0, rbegn = 0, rendn = 0;
    bool have = setup(0, rtg, ct, e, rbeg, rend);
    for (int it = 0; have; ++it) {
        f32x16 acc[2][2];
        gemm_run<1>(acc, g, A, aoff, WSP(u16, O_WGU) + (size_t)e * 1024 * 512, boff, 8, (u16*)smem);
        if (tid < 128) gl[tid] = gsreg;
        have = setup(it + 1, rtgn, ctn, en, rbegn, rendn);
        __syncthreads();
        { u16* Cs = (u16*)smem;
#pragma unroll
          for (int m = 0; m < 2; ++m)
#pragma unroll
              for (int rg = 0; rg < 4; ++rg) {
                  const int lr0 = wr * 64 + m * 32 + 8 * rg + 4 * hi;
                  const f32x4* gp = (const f32x4*)(gl + lr0);
                  const f32x4 g01 = gp[0], g23 = gp[1];
#pragma unroll
                  for (int i = 0; i < 4; ++i) { const float gt = i == 0 ? g01[0] : (i == 1 ? g01[2] : (i == 2 ? g23[0] : g23[2])); const float sc = (i == 0 ? g01[1] : (i == 1 ? g01[3] : (i == 2 ? g23[1] : g23[3]))) * swinv;
                      const float a = (float)__float_as_int(acc[m][0][4 * rg + i]) * sc, u = (float)__float_as_int(acc[m][1][4 * rg + i]) * sc;
                      ((unsigned char*)Cs)[(lr0 + i) * 272 + wc * 32 + l31] = (unsigned char)(__builtin_amdgcn_cvt_pk_fp8_f32(f8clamp(siluf_(a) * u * gt * ACT_F8_SCALE), 0.f, 0, false) & 0xff); }
                  __builtin_amdgcn_sched_barrier(0);
              }
          __syncthreads();
          u16* dst = WSP(u16, O_ACTB) + (size_t)rbeg * 256 + ct * 32; const int nvalid = rend - rbeg;
          lds_rows_store<4>((const u16*)smem, [=](int row, int cc) -> u16* { return row < nvalid ? dst + (size_t)row * 256 + cc * 8 : nullptr; });
          __syncthreads(); }
            rtg = rtgn; ct = ctn; e = en; rbeg = rbegn; rend = rendn;
    }
}

__device__ __forceinline__ void phase_moe2(const Params& p, unsigned char* smem, int l) {
    WAVE_IDS;
    int* offs = (int*)(smem + 73728);
    expert_offsets(p, l, offs);
    const int ntl = offs[64 + 32];
    const u16* A = WSP(u16, O_ACTB);
    const float sdq = fmaxf(__uint_as_float(__hip_atomic_load(WSP(unsigned, 0) + AMAX_W + 2 + l, __ATOMIC_RELAXED, __HIP_MEMORY_SCOPE_AGENT)), 1e-30f) * (1.f / (F8_TOP * ACT_F8_SCALE));
    GemmRegs g; unsigned aoff[4], boff[4];
    auto setup = [&](int it_, int& rtg_, int& ct_, int& e_, int& rbeg_, int& rend_) -> bool {
        if (!moe_tile(it_, ntl, rtg_, ct_)) return false;
        e_ = 0; while (offs[64 + e_ + 1] <= rtg_) ++e_;
        rbeg_ = offs[e_] + (rtg_ - offs[64 + e_]) * 128; rend_ = offs[e_ + 1];
#pragma unroll
        for (int i = 0; i < 4; ++i) { int r = rbeg_ + (tid >> 3) + 32 * i; r = r < rend_ ? r : rend_ - 1; aoff[i] = (unsigned)r * 256u + (tid & 7) * 8; }
        lin_off(boff, ct_ * 128, 256, 0);
        gemm_prefetch(g, A, aoff, WSP(u16, O_WD) + (size_t)e_ * 1024 * 256, boff, 4);
        return true; };
    int rtg, ct, e, rbeg, rend, rtgn = 0, ctn = 0, en = 0, rbegn = 0, rendn = 0;
    bool have = setup(0, rtg, ct, e, rbeg, rend);
    for (int it = 0; have; ++it) {
        f32x16 acc[2][2];
        gemm_run<2>(acc, g, A, aoff, WSP(u16, O_WD) + (size_t)e * 1024 * 256, boff, 4, (u16*)smem);
        have = setup(it + 1, rtgn, ctn, en, rbegn, rendn);
#pragma unroll
        for (int m = 0; m < 2; ++m)
#pragma unroll
            for (int n = 0; n < 2; ++n)
#pragma unroll
                for (int r = 0; r < 16; ++r) acc[m][n][r] *= sdq;
        epi_store_tile_lds(acc, WSP(u16, O_YSORT), 1024, rbeg, ct * 128, rend, (u16*)smem);
            rtg = rtgn; ct = ctn; e = en; rbeg = rbegn; rend = rendn;
    }
}

__device__ __forceinline__ void phase_combine(const Params& p, unsigned char* smem, int l) {
    int* offs = (int*)(smem + 73728);
    expert_offsets(p, l, offs);
    const int lane = otid() & 63, wv = blockIdx.x * 4 + (otid() >> 6), nw = gridDim.x * 4;
    const float* g = (l == 0) ? (p.in[1] + 1024) : p.in[3];
    f32x4 gv[4];
#pragma unroll
    for (int i = 0; i < 4; ++i) gv[i] = *(const f32x4*)(g + ((i >> 1) * 512 + lane * 8 + (i & 1) * 4));
    const u16* ys = WSP(u16, O_YSORT);
    for (int t0 = wv * 2; t0 < T; t0 += nw * 2) {
        const int4 s0 = WSP(int4, O_SEL)[t0], s1 = WSP(int4, O_SEL)[t0 + 1];
        const int4 rr = make_int4(offs[s0.x] + s0.y, offs[s0.z] + s0.w, offs[s1.x] + s1.y, offs[s1.z] + s1.w);
        f32x4 x[2][4]; u32x2 ya[2][4], yb[2][4];
#pragma unroll
        for (int u = 0; u < 2; ++u) {
            const int r0 = u ? rr.z : rr.x, r1 = u ? rr.w : rr.y;
#pragma unroll
            for (int i = 0; i < 4; ++i) {
                x[u][i] = bf4_to_f32(*(const u32x2*)(HB(t0 + u) + ((i >> 1) * 512 + lane * 8 + (i & 1) * 4)));
                ya[u][i] = *(const u32x2*)(ys + (size_t)r0 * 1024 + ((i >> 1) * 512 + lane * 8 + (i & 1) * 4)); yb[u][i] = *(const u32x2*)(ys + (size_t)r1 * 1024 + ((i >> 1) * 512 + lane * 8 + (i & 1) * 4));
            }
        }
#pragma unroll
        for (int u = 0; u < 2; ++u) {
            const int t = t0 + u; float ss = 0.f;
#pragma unroll
            for (int i = 0; i < 4; ++i) {
                const u32x2 a = ya[u][i], c = yb[u][i];
                x[u][i][0] += bflo(a[0]) + bflo(c[0]); x[u][i][1] += bfhi(a[0]) + bfhi(c[0]); x[u][i][2] += bflo(a[1]) + bflo(c[1]); x[u][i][3] += bfhi(a[1]) + bfhi(c[1]);
                ss += x[u][i][0] * x[u][i][0] + x[u][i][1] * x[u][i][1] + x[u][i][2] * x[u][i][2] + x[u][i][3] * x[u][i][3];
            }
            ss = wave_sum(ss);
            const float rs = rsqrtf(ss * (1.f / D) + EPS);
            if (l == 0) {
#pragma unroll
                for (int i = 0; i < 4; ++i) { u32x2 o; o[0] = cvtpk(x[u][i][0], x[u][i][1]); o[1] = cvtpk(x[u][i][2], x[u][i][3]); *(u32x2*)(HB(t) + ((i >> 1) * 512 + lane * 8 + (i & 1) * 4)) = o; }
                float am = 0.f;
#pragma unroll
                for (int i = 0; i < 4; ++i)
#pragma unroll
                    for (int c = 0; c < 4; ++c) { x[u][i][c] *= rs * gv[i][c]; am = fmaxf(am, fabsf(x[u][i][c])); }
                am = fmaxf(wave_max(am), 1e-30f);
                const float qa = 127.f / am;
#pragma unroll
                for (int i = 0; i < 4; ++i) *(unsigned*)(WSP(unsigned char, O_HA) + (size_t)t * D + ((i >> 1) * 512 + lane * 8 + (i & 1) * 4)) = pack_i8x4(x[u][i], qa);
                if (lane == 0) WSP(float, O_SAIN)[t] = am * (1.f / 127.f);
            } else {
#pragma unroll
                for (int i = 0; i < 4; ++i) { f32x4 o; o[0] = x[u][i][0] * rs * gv[i][0]; o[1] = x[u][i][1] * rs * gv[i][1]; o[2] = x[u][i][2] * rs * gv[i][2]; o[3] = x[u][i][3] * rs * gv[i][3];
                    *(f32x4*)(p.out + (size_t)t * D + ((i >> 1) * 512 + lane * 8 + (i & 1) * 4)) = o; }
            }
        }
    }
}

__device__ __forceinline__ void phase_inproj1(const Params& p, unsigned char* smem) {
    WAVE_IDS;
    const u16* A = WSP(u16, O_HA); const u16* B = WSP(u16, O_WIN1);
    const float swinv = sample_amax(p.in[12], (size_t)1024 * OD_IN, (float*)smem) * (1.f / WQ_TOP);
    GemmRegs g; unsigned aoff[4], boff[4];
    float sareg = 0.f; float* sl = (float*)(smem + 73728);
    int rt, ct, rtn = 0, ctn = 0; bool have = dense_tile(0, 30, rt, ct);
    if (have) { lin_off(aoff, rt * 128, 512, 0); lin_off(boff, ct * 128, 512, 0); gemm_prefetch(g, A, aoff, B, boff, 8); if (tid < 128) sareg = WSP(float, O_SAIN)[rt * 128 + tid]; }
    for (int it = 0; have; ++it) {
        const int m0 = rt * 128, n0 = ct * 128;
        f32x16 acc[2][2];
        gemm_run<1>(acc, g, A, aoff, B, boff, 8, (u16*)smem);
        if (tid < 128) sl[tid] = sareg;
        have = dense_tile(it + 1, 30, rtn, ctn);
        if (have) { lin_off(aoff, rtn * 128, 512, 0); lin_off(boff, ctn * 128, 512, 0); gemm_prefetch(g, A, aoff, B, boff, 8); if (tid < 128) sareg = WSP(float, O_SAIN)[rtn * 128 + tid]; }
        __syncthreads();
        dequant_tile(acc, sl, swinv);
        if (ct < 14) epi_store_tile_lds(acc, WSP(u16, O_U1R), RW_IN, m0, n0, T, (u16*)smem);
        else epi_store_tile_lds(acc, WSP(u16, O_U1H), 2048, m0, n0 - RW_IN, T, (u16*)smem);
            rt = rtn; ct = ctn;
    }
}

__device__ __forceinline__ float hgrn_lb(const Params& p, int col) { const float x0 = p.in[25][col], x1 = p.in[25][512 + col]; return 1.f / (1.f + __expf(x0 - x1)); }

__device__ __forceinline__ void phase_hgrnA(const Params& p, unsigned char* smem) {
    WAVE_IDS;
    float* bc = (float*)smem;
    u16* Kst = (u16*)(smem + 33280);
    u16* Vtl = (u16*)(smem + 33280 + 18432);
    const u16* U = WSP(u16, O_U1H);
    int* qb = (int*)(smem + 73728 + 1024);
    for (;;) {
        if (tid == 0) *qb = (int)atomicAdd(WSP(unsigned, 0) + HGA_CTR_W, 1u);
        __syncthreads();
        const int item = *qb;
        __syncthreads();
        if (item >= 2048) break;
        const int c = item & 63, bh = item >> 6, b = bh >> 2, hh = bh & 3, t0 = b * SEQ + c * 64;
#pragma unroll
        for (int i = 0; i < 4; ++i) {
            const int ch = tid + 256 * i, t = ch >> 4, d8 = (ch & 15) * 8;
            const u32x4 zv = *(const u32x4*)(U + (size_t)(t0 + t) * 2048 + 512 + hh * 128 + d8);
            const u32x4 v = *(const u32x4*)(U + (size_t)(t0 + t) * 2048 + 1024 + hh * 128 + d8);
#pragma unroll
            for (int q = 0; q < 4; ++q) {
                const float lb0 = hgrn_lb(p, hh * 128 + d8 + 2 * q), lb1 = hgrn_lb(p, hh * 128 + d8 + 2 * q + 1);
                bc[t * 129 + d8 + 2 * q] = __logf(lb0 + (1.f - lb0) * sigmoidf_(bflo(zv[q])));
                bc[t * 129 + d8 + 2 * q + 1] = __logf(lb1 + (1.f - lb1) * sigmoidf_(bfhi(zv[q])));
                Vtl[(d8 + 2 * q) * LSTR + t] = (u16)(v[q] & 0xffff); Vtl[(d8 + 2 * q + 1) * LSTR + t] = (u16)(v[q] >> 16);
            }
        }
        __syncthreads();
        { const int d = tid & 127, half = tid >> 7; float run = 0.f;
          for (int t = half * 32; t < half * 32 + 32; ++t) { run += bc[t * 129 + d]; bc[t * 129 + d] = run; }
          __syncthreads();
          if (half) { const float add = bc[31 * 129 + d]; for (int t = 32; t < 64; ++t) bc[t * 129 + d] += add; }
          __syncthreads();
          if (tid < 128) WSP(float, O_HD)[(size_t)item * 128 + d] = __expf(bc[63 * 129 + d]); }
#pragma unroll
        for (int i = 0; i < 4; ++i) {
            const int ch = tid + 256 * i, t = ch >> 4, d8 = (ch & 15) * 8;
            const u32x4 zv = *(const u32x4*)(U + (size_t)(t0 + t) * 2048 + 512 + hh * 128 + d8);
#pragma unroll
            for (int q = 0; q < 4; ++q) {
                const int d0 = d8 + 2 * q;
                const float lb0 = hgrn_lb(p, hh * 128 + d0), lb1 = hgrn_lb(p, hh * 128 + d0 + 1);
                const float f0 = lb0 + (1.f - lb0) * sigmoidf_(bflo(zv[q])), f1 = lb1 + (1.f - lb1) * sigmoidf_(bfhi(zv[q]));
                Kst[d0 * LSTR + t] = f2bf((1.f - f0) * __expf(bc[63 * 129 + d0] - bc[t * 129 + d0]));
                Kst[(d0 + 1) * LSTR + t] = f2bf((1.f - f1) * __expf(bc[63 * 129 + d0 + 1] - bc[t * 129 + d0 + 1]));
            }
        }
        __syncthreads();
        f32x16 acc[2][2];
#pragma unroll
        for (int m = 0; m < 2; ++m)
#pragma unroll
            for (int n = 0; n < 2; ++n)
#pragma unroll
                for (int r = 0; r < 16; ++r) acc[m][n][r] = 0.f;
#pragma unroll
        for (int s = 0; s < 4; ++s) {
            const bf16x8 a0 = *(const bf16x8*)(Vtl + (wr * 64 + l31) * LSTR + s * 16 + hi * 8), a1 = *(const bf16x8*)(Vtl + (wr * 64 + 32 + l31) * LSTR + s * 16 + hi * 8);
            const bf16x8 b0 = *(const bf16x8*)(Kst + (wc * 64 + l31) * LSTR + s * 16 + hi * 8), b1 = *(const bf16x8*)(Kst + (wc * 64 + 32 + l31) * LSTR + s * 16 + hi * 8);
            acc[0][0] = MFMA(a0, b0, acc[0][0]); acc[0][1] = MFMA(a0, b1, acc[0][1]); acc[1][0] = MFMA(a1, b0, acc[1][0]); acc[1][1] = MFMA(a1, b1, acc[1][1]);
        }
        __syncthreads();
        epi_store_tile_lds(acc, WSP(u16, O_HL) + (size_t)item * 128 * 128, 128, 0, 0, 128, (u16*)smem);
    }
}
__device__ __forceinline__ void phase_hgrnB(const Params& p, unsigned char* smem) {
    int* qb = (int*)(smem + 73728 + 1024);
    for (;;) {
        if (otid() == 0) *qb = (int)atomicAdd(WSP(unsigned, 0) + HGB_CTR_W, 1u);
        __syncthreads();
        const int chunk = *qb;
        __syncthreads();
        if (chunk >= 512) break;
        const int id = chunk * 256 + otid();
        {
        const int bh = id >> 12, q = id & 4095, e = q >> 5, d4 = (q & 31) * 4;
        u16* base = WSP(u16, O_HL) + (size_t)bh * 64 * 16384 + e * 128 + d4;
        const float* dec = WSP(float, O_HD) + (size_t)bh * 64 * 128 + d4;
        float s0 = 0.f, s1 = 0.f, s2 = 0.f, s3 = 0.f;
        for (int c0 = 0; c0 < 64; c0 += 8) {
            u32x2 lv[8]; f32x4 dv[8];
#pragma unroll
            for (int i = 0; i < 8; ++i) { lv[i] = *(const u32x2*)(base + (size_t)(c0 + i) * 16384); dv[i] = *(const f32x4*)(dec + (size_t)(c0 + i) * 128); }
#pragma unroll
            for (int i = 0; i < 8; ++i) {
                u32x2 o; o[0] = cvtpk(s0, s1); o[1] = cvtpk(s2, s3);
                *(u32x2*)(base + (size_t)(c0 + i) * 16384) = o;
                s0 = dv[i][0] * s0 + bflo(lv[i][0]); s1 = dv[i][1] * s1 + bfhi(lv[i][0]); s2 = dv[i][2] * s2 + bflo(lv[i][1]); s3 = dv[i][3] * s3 + bfhi(lv[i][1]);
            }
        }
    }
    }
}
__device__ __forceinline__ void phase_hgrnC(const Params& p, unsigned char* smem) {
    WAVE_IDS;
    float* ssq = (float*)smem;
    u16* Qt = (u16*)(smem + 1024);
    u16* Kt = (u16*)(smem + 1024 + 17408);
    u16* Vtl = (u16*)(smem + 1024 + 34816);
    float* bc = (float*)(smem + 1024 + 34816);
    const u16* U = WSP(u16, O_U1H);
    int* qb = (int*)(smem + 73728 + 1024);
    for (;;) {
        if (tid == 0) *qb = (int)atomicAdd(WSP(unsigned, 0) + HGC_CTR_W, 1u);
        __syncthreads();
        const int item = *qb;
        __syncthreads();
        if (item >= 2048) break;
        const int c = item & 63, bh = item >> 6, b = bh >> 2, hh = bh & 3, t0 = b * SEQ + c * 64;
#pragma unroll
        for (int i = 0; i < 4; ++i) {
            const int ch = tid + 256 * i, t = ch >> 4, d8 = (ch & 15) * 8;
            const u32x4 zv = *(const u32x4*)(U + (size_t)(t0 + t) * 2048 + 512 + hh * 128 + d8);
#pragma unroll
            for (int q = 0; q < 4; ++q) {
                const float lb0 = hgrn_lb(p, hh * 128 + d8 + 2 * q), lb1 = hgrn_lb(p, hh * 128 + d8 + 2 * q + 1);
                bc[t * 129 + d8 + 2 * q] = __logf(lb0 + (1.f - lb0) * sigmoidf_(bflo(zv[q])));
                bc[t * 129 + d8 + 2 * q + 1] = __logf(lb1 + (1.f - lb1) * sigmoidf_(bfhi(zv[q])));
            }
        }
        __syncthreads();
        { const int d = tid & 127, half = tid >> 7; float run = 0.f;
          for (int t = half * 32; t < half * 32 + 32; ++t) { run += bc[t * 129 + d]; bc[t * 129 + d] = run; }
          __syncthreads();
          if (half) { const float add = bc[31 * 129 + d]; for (int t = 32; t < 64; ++t) bc[t * 129 + d] += add; }
          __syncthreads(); }
        u32x4 vreg[4];
#pragma unroll
        for (int i = 0; i < 4; ++i) {
            const int ch = tid + 256 * i, t = ch >> 4, d8 = (ch & 15) * 8;
            const u32x4 zv = *(const u32x4*)(U + (size_t)(t0 + t) * 2048 + 512 + hh * 128 + d8);
            const u32x4 qv = *(const u32x4*)(U + (size_t)(t0 + t) * 2048 + hh * 128 + d8);
            vreg[i] = *(const u32x4*)(U + (size_t)(t0 + t) * 2048 + 1024 + hh * 128 + d8);
            u32x4 qo, ko;
#pragma unroll
            for (int q = 0; q < 4; ++q) {
                const int d0 = d8 + 2 * q;
                const float lb0 = hgrn_lb(p, hh * 128 + d0), lb1 = hgrn_lb(p, hh * 128 + d0 + 1);
                const float f0 = lb0 + (1.f - lb0) * sigmoidf_(bflo(zv[q])), f1 = lb1 + (1.f - lb1) * sigmoidf_(bfhi(zv[q]));
                const float b0 = bc[t * 129 + d0], b1 = bc[t * 129 + d0 + 1];
                qo[q] = cvtpk(siluf_(bflo(qv[q])) * __expf(b0), siluf_(bfhi(qv[q])) * __expf(b1));
                ko[q] = cvtpk((1.f - f0) * __expf(-b0), (1.f - f1) * __expf(-b1));
            }
            *(u32x4*)(Qt + t * 136 + d8) = qo; *(u32x4*)(Kt + t * 136 + d8) = ko;
        }
        __syncthreads();
#pragma unroll
        for (int i = 0; i < 4; ++i) {
            const int ch = tid + 256 * i, t = ch >> 4, e8 = (ch & 15) * 8;
#pragma unroll
            for (int q = 0; q < 4; ++q) { Vtl[(e8 + 2 * q) * 68 + t] = (u16)(vreg[i][q] & 0xffff); Vtl[(e8 + 2 * q + 1) * 68 + t] = (u16)(vreg[i][q] >> 16); }
        }
        __syncthreads();
        f32x16 pt[2][2];
#pragma unroll
        for (int a = 0; a < 2; ++a)
#pragma unroll
            for (int c2 = 0; c2 < 2; ++c2)
#pragma unroll
                for (int r = 0; r < 16; ++r) pt[a][c2][r] = 0.f;
#pragma unroll
        for (int s = 0; s < 8; ++s) {
            const bf16x8 k0 = *(const bf16x8*)(Kt + l31 * 136 + s * 16 + hi * 8), k1 = *(const bf16x8*)(Kt + (32 + l31) * 136 + s * 16 + hi * 8);
            const bf16x8 q0 = *(const bf16x8*)(Qt + l31 * 136 + s * 16 + hi * 8), q1 = *(const bf16x8*)(Qt + (32 + l31) * 136 + s * 16 + hi * 8);
            pt[0][0] = MFMA(k0, q0, pt[0][0]); pt[0][1] = MFMA(k0, q1, pt[0][1]); pt[1][0] = MFMA(k1, q0, pt[1][0]); pt[1][1] = MFMA(k1, q1, pt[1][1]);
        }
        bf16x8 pb[2][4];
#pragma unroll
        for (int tt = 0; tt < 2; ++tt)
#pragma unroll
            for (int st = 0; st < 2; ++st) {
                float v[16];
#pragma unroll
                for (int r = 0; r < 16; ++r) { const int sidx = st * 32 + crow(r, hi), tidx = tt * 32 + l31; v[r] = (sidx <= tidx) ? pt[st][tt][r] : 0.f; }
                u32x4 w; w[0] = cvtpk(v[0], v[1]); w[1] = cvtpk(v[2], v[3]); w[2] = cvtpk(v[4], v[5]); w[3] = cvtpk(v[6], v[7]); pb[tt][st * 2] = __builtin_bit_cast(bf16x8, w);
                w[0] = cvtpk(v[8], v[9]); w[1] = cvtpk(v[10], v[11]); w[2] = cvtpk(v[12], v[13]); w[3] = cvtpk(v[14], v[15]); pb[tt][st * 2 + 1] = __builtin_bit_cast(bf16x8, w);
            }
        f32x16 o[2];
#pragma unroll
        for (int r = 0; r < 16; ++r) { o[0][r] = 0.f; o[1][r] = 0.f; }
        const u16* ST = WSP(u16, O_HL) + (size_t)item * 16384 + (size_t)(wid * 32 + l31) * 128;
#pragma unroll
        for (int s = 0; s < 8; ++s) {
            const bf16x8 a = *(const bf16x8*)(ST + s * 16 + hi * 8);
            const bf16x8 q0 = *(const bf16x8*)(Qt + l31 * 136 + s * 16 + hi * 8), q1 = *(const bf16x8*)(Qt + (32 + l31) * 136 + s * 16 + hi * 8);
            o[0] = MFMA(a, q0, o[0]); o[1] = MFMA(a, q1, o[1]);
        }
#pragma unroll
        for (int s = 0; s < 4; ++s) {
            const u16* vp = Vtl + (wid * 32 + l31) * 68 + 16 * s + 4 * hi;
            const u32x2 lo = *(const u32x2*)vp, h2 = *(const u32x2*)(vp + 8);
            const u32x4 w = {lo[0], lo[1], h2[0], h2[1]};
            o[0] = MFMA(__builtin_bit_cast(bf16x8, w), pb[0][s], o[0]); o[1] = MFMA(__builtin_bit_cast(bf16x8, w), pb[1][s], o[1]);
        }
#pragma unroll
        for (int tt = 0; tt < 2; ++tt) { float s2 = 0.f;
#pragma unroll
            for (int r = 0; r < 16; ++r) s2 += o[tt][r] * o[tt][r];
            s2 = xhalf_sum(s2);
            if (hi == 0) ssq[wid * 64 + tt * 32 + l31] = s2; }
        __syncthreads();
#pragma unroll
        for (int tt = 0; tt < 2; ++tt) {
            const int t = tt * 32 + l31;
            const float rs = rsqrtf((ssq[t] + ssq[64 + t] + ssq[128 + t] + ssq[192 + t]) * (1.f / 128.f) + EPS);
#pragma unroll
            for (int rg = 0; rg < 4; ++rg) {
                const int e = wid * 32 + 8 * rg + 4 * hi;
                const u32x2 gv = *(const u32x2*)(U + (size_t)(t0 + t) * 2048 + 1536 + hh * 128 + e);
                const f32x4 on = *(const f32x4*)(p.in[26] + hh * 128 + e);
                u32x2 w; w[0] = cvtpk(o[tt][4 * rg] * rs * on[0] * siluf_(bflo(gv[0])), o[tt][4 * rg + 1] * rs * on[1] * siluf_(bfhi(gv[0])));
                w[1] = cvtpk(o[tt][4 * rg + 2] * rs * on[2] * siluf_(bflo(gv[1])), o[tt][4 * rg + 3] * rs * on[3] * siluf_(bfhi(gv[1])));
                *(u32x2*)(WSP(u16, O_HA) + (size_t)(t0 + t) * 1024 + 512 + hh * 128 + e) = w;
            }
        }
        __syncthreads();
    }
}

__device__ __forceinline__ void phase_rwkv_prep(const Params& p) {
    const int lane = otid() & 63, wv = blockIdx.x * 4 + (otid() >> 6), nw = gridDim.x * 4;
    const u16* U = WSP(u16, O_U1R); const float* mu = p.in[14];
    const int c = 1536 + lane * 4;
    const f32x4 m = *(const f32x4*)(mu + c);
    for (int t0 = wv * 4; t0 < T; t0 += nw * 4) {
        u32x2 a[4], pv[4];
#pragma unroll
        for (int u = 0; u < 4; ++u) { const int t = t0 + u; a[u] = *(const u32x2*)(U + (size_t)t * RW_IN + c); pv[u] = (u32x2){0u, 0u}; if ((t & (SEQ - 1)) != 0) pv[u] = *(const u32x2*)(U + (size_t)(t - 1) * RW_IN + c); }
#pragma unroll
        for (int u = 0; u < 4; ++u) {
            float x[4] = {bflo(a[u][0]), bfhi(a[u][0]), bflo(a[u][1]), bfhi(a[u][1])}; const float q[4] = {bflo(pv[u][0]), bfhi(pv[u][0]), bflo(pv[u][1]), bfhi(pv[u][1])};
#pragma unroll
            for (int j = 0; j < 4; ++j) { x[j] = x[j] + (q[j] - x[j]) * m[j];
                if (lane < 16) x[j] = 1.f - 2.f * __builtin_amdgcn_rcpf(1.f + __expf(2.f * x[j]));
                else if (lane >= 32) x[j] = sigmoidf_(x[j]); }
            u32x2 o; o[0] = cvtpk(x[0], x[1]); o[1] = cvtpk(x[2], x[3]);
            *(u32x2*)(WSP(u16, O_LORA) + (size_t)(t0 + u) * 256 + lane * 4) = o; }
    }
}
__device__ __forceinline__ void phase_rwkv_lora(const Params& p, unsigned char* smem) {
    WAVE_IDS;
    const u16* A = WSP(u16, O_LORA);
    int rt, c12;
    for (int it = 0; dense_tile(it, 12, rt, c12); ++it) {
        const int which = c12 >> 2, ct = c12 & 3, m0 = rt * 128, n0 = ct * 128;
        unsigned aoff[4], boff[4];
        lin_off(aoff, m0, 256, which == 0 ? 0 : (which == 1 ? 64 : 128));
        const int K = which == 2 ? 128 : 64;
        lin_off(boff, n0, K, 0);
        f32x16 acc[2][2];
        gemm_mainloop(acc, A, aoff, WSP(u16, which == 0 ? O_W2T : (which == 1 ? O_A2T : O_G2T)), boff, K / 64, (u16*)smem);
        u16* dst = WSP(u16, which == 0 ? O_WD16 : (which == 1 ? O_AA16 : O_GG16));
#pragma unroll
        for (int m = 0; m < 2; ++m)
#pragma unroll
            for (int n = 0; n < 2; ++n) {
                const int col = n0 + wc * 64 + n * 32 + l31;
                const float bias = which == 0 ? p.in[15][col] : (which == 1 ? p.in[17][col] : 0.f);
#pragma unroll
                for (int r = 0; r < 16; ++r) {
                    float v = acc[m][n][r] + bias;
                    if (which == 0) v = __expf(-0.6065306597f * sigmoidf_(v));
                    else if (which == 1) v = sigmoidf_(v);
                    acc[m][n][r] = v;
                }
            }
        lds_put16<true>(acc, (u16*)smem, wr, wc, l31, hi);
        __syncthreads();
        lds_rows_store<16>((const u16*)smem, [=](int row, int cc) -> u16* { return dst + (size_t)(m0 + row) * 512 + n0 + cc * 8; });
        __syncthreads();
    }
}
#define DPP_ADD(x, ctrl) x += __builtin_bit_cast(float, __builtin_amdgcn_update_dpp(0, __builtin_bit_cast(int, x), ctrl, 0xf, 0xf, false))
__device__ __forceinline__ void sum32x2(float& a, float& b) {
    DPP_ADD(a, 0x128); DPP_ADD(b, 0x128); DPP_ADD(a, 0x124); DPP_ADD(b, 0x124);
    DPP_ADD(a, 0x122); DPP_ADD(b, 0x122); DPP_ADD(a, 0x121); DPP_ADD(b, 0x121);
    auto ra = __builtin_amdgcn_permlane16_swap(__float_as_uint(a), __float_as_uint(a), false, false);
    auto rb = __builtin_amdgcn_permlane16_swap(__float_as_uint(b), __float_as_uint(b), false, false);
    a = __uint_as_float(ra[0]) + __uint_as_float(ra[1]); b = __uint_as_float(rb[0]) + __uint_as_float(rb[1]);
}
__device__ __forceinline__ void sum16x2(float& a, float& b) {
    DPP_ADD(a, 0x128); DPP_ADD(b, 0x128); DPP_ADD(a, 0x124); DPP_ADD(b, 0x124);
    DPP_ADD(a, 0x122); DPP_ADD(b, 0x122); DPP_ADD(a, 0x121); DPP_ADD(b, 0x121);
}
__device__ __forceinline__ float sum16(float a) { DPP_ADD(a, 0x128); DPP_ADD(a, 0x124); DPP_ADD(a, 0x122); DPP_ADD(a, 0x121); return a; }
template <bool INNER>
__device__ __forceinline__ void phase_rwkv_rec(const Params& p, unsigned char* smem, const XcdBarrier& bar) {
    const int tid = otid(), lane = tid & 63, wid = tid >> 6, rowl = lane >> 4, j = lane & 15;
    constexpr int CH = 16;
    constexpr int BUF = CH * 6 * 64 * 4;
    int* bcast = (int*)(smem + 2 * BUF);
    unsigned* ctrl = WSP(unsigned, 0);
    if (INNER && p.solo) {
        phase_hgrnA(p, smem); xcd_barrier(bar); phase_hgrnB(p, smem); xcd_barrier(bar); phase_hgrnC(p, smem);
    }
    if (tid == 0) {
        const unsigned hw = (unsigned)__builtin_amdgcn_s_getreg((7 << 11) | (8 << 6) | 4);
        const unsigned key = (((unsigned)__builtin_amdgcn_s_getreg((3 << 11) | 20) & 0xFu) << 8) | (hw & 0xffu);
        bcast[0] = (int)atomicAdd(&ctrl[PERCU_W + key], 1u);
    }
    __syncthreads();
    const bool worker = bcast[0] == 0 || (INNER && p.solo);
    __syncthreads();
    if (!worker) {
        if (INNER) { phase_hgrnA(p, smem); xcd_barrier(bar); phase_hgrnB(p, smem); xcd_barrier(bar); phase_hgrnC(p, smem); }
        return;
    }
    int nbar = (INNER && p.solo) ? 2 : 0;
    __builtin_amdgcn_s_setprio(3);
    const u16* U = WSP(u16, O_U1R); const float* mu = p.in[14];
    for (;;) {
        if (tid == 0) bcast[0] = (int)atomicAdd(&ctrl[RWKV_TICKET_W], 1u);
        __syncthreads();
        const int item = bcast[0];
        __syncthreads();
        if (item >= 256) break;
        const int bh = item >> 2, rgp = item & 3, b = bh >> 3, h8 = bh & 7;
        const int row = rgp * 16 + wid * 4 + rowl;
        const size_t tb0 = (size_t)b * SEQ;
        const int ss_ = tid >> 4, k4 = (tid & 15) * 4;
        float mrv[4], mkv[4], mvv[4], kav[4], kkv[4];
#pragma unroll
        for (int q = 0; q < 4; ++q) { mrv[q] = mu[h8 * 64 + k4 + q]; mkv[q] = mu[512 + h8 * 64 + k4 + q]; mvv[q] = mu[1024 + h8 * 64 + k4 + q]; kav[q] = p.in[21][h8 * 64 + k4 + q]; kkv[q] = p.in[20][h8 * 64 + k4 + q]; }
        u32x2 r_c, k_c, v_c, r_p, k_p, v_p, w_c, a_c;
        auto sload = [&](int ch) {
            const int tl = ch * CH + ss_; const size_t t = tb0 + tl;
            const u16* ur = U + t * RW_IN + h8 * 64 + k4;
            r_c = *(const u32x2*)ur; k_c = *(const u32x2*)(ur + 512); v_c = *(const u32x2*)(ur + 1024);
            r_p = (u32x2){0u, 0u}; k_p = r_p; v_p = r_p;
            if (tl > 0) { r_p = *(const u32x2*)(ur - RW_IN); k_p = *(const u32x2*)(ur - RW_IN + 512); v_p = *(const u32x2*)(ur - RW_IN + 1024); }
            w_c = *(const u32x2*)(WSP(h16, O_WD16) + t * 512 + h8 * 64 + k4);
            a_c = *(const u32x2*)(WSP(h16, O_AA16) + t * 512 + h8 * 64 + k4);
        };
        auto swrite = [&](int buf) {
            const h16* wh = (const h16*)&w_c; const h16* ah = (const h16*)&a_c;
            float* bb = (float*)(smem + buf * BUF) + ss_ * 384 + k4;
            float rr[4], kk_[4], vv[4];
#pragma unroll
            for (int q = 0; q < 2; ++q) {
                float x0 = bflo(r_c[q]), x1 = bfhi(r_c[q]); rr[2 * q] = x0 + (bflo(r_p[q]) - x0) * mrv[2 * q]; rr[2 * q + 1] = x1 + (bfhi(r_p[q]) - x1) * mrv[2 * q + 1];
                x0 = bflo(k_c[q]); x1 = bfhi(k_c[q]); kk_[2 * q] = x0 + (bflo(k_p[q]) - x0) * mkv[2 * q]; kk_[2 * q + 1] = x1 + (bfhi(k_p[q]) - x1) * mkv[2 * q + 1];
                x0 = bflo(v_c[q]); x1 = bfhi(v_c[q]); vv[2 * q] = x0 + (bflo(v_p[q]) - x0) * mvv[2 * q]; vv[2 * q + 1] = x1 + (bfhi(v_p[q]) - x1) * mvv[2 * q + 1];
            }
            float kn[4]; float ssq = 0.f;
#pragma unroll
            for (int q = 0; q < 4; ++q) { kn[q] = kk_[q] * kkv[q]; ssq += kn[q] * kn[q]; }
            ssq = sum16(ssq);
            const float rn = rsqrtf(fmaxf(ssq, 1e-24f));
            f32x4 ow, on, ob, ok;
#pragma unroll
            for (int q = 0; q < 4; ++q) { const float a = (float)ah[q], n = kn[q] * rn; ow[q] = (float)wh[q]; on[q] = -n; ob[q] = n * a; ok[q] = kk_[q] * (1.f + (a - 1.f) * kav[q]); }
            *(f32x4*)(bb) = ow; *(f32x4*)(bb + 64) = on; *(f32x4*)(bb + 128) = ob; *(f32x4*)(bb + 192) = ok;
            *(f32x4*)(bb + 256) = (f32x4){rr[0], rr[1], rr[2], rr[3]}; *(f32x4*)(bb + 320) = (f32x4){vv[0], vv[1], vv[2], vv[3]};
        };
        sload(0); swrite(0);
        __syncthreads();
        f32x4 S = {0.f, 0.f, 0.f, 0.f};
        float ykeep = 0.f;
        for (int ch = 0; ch < SEQ / CH; ++ch) {
            const int cur = ch & 1;
            if (INNER && nbar < 2 && ch == (nbar == 0 ? 75 : 155)) { xcd_barrier(bar); ++nbar; }
            if (ch + 1 < SEQ / CH) sload(ch + 1);
            __builtin_amdgcn_sched_barrier(0);
            const float* bb = (const float*)(smem + cur * BUF) + j * 4;
            const float* vs = (const float*)(smem + cur * BUF) + 320 + row;
#define RW_LOAD(W, N, B_, K_, R, V, S_) { const float* q = bb + (S_) * 384; W = *(const f32x4*)q; N = *(const f32x4*)(q + 64); B_ = *(const f32x4*)(q + 128); K_ = *(const f32x4*)(q + 192); R = *(const f32x4*)(q + 256); V = vs[(S_) * 384]; }
#define RW_STEP(W, N, B_, K_, R, V, S_) { \
                float pa = S[0] * N[0]; pa = fmaf(S[1], N[1], pa); pa = fmaf(S[2], N[2], pa); pa = fmaf(S[3], N[3], pa); \
                if ((S_) > 0) { sum16x2(pa, pbk); ykeep = (j == (S_) - 1) ? pbk : ykeep; } else pa = sum16(pa); \
                S[0] = fmaf(pa, B_[0], fmaf(S[0], W[0], V * K_[0])); S[1] = fmaf(pa, B_[1], fmaf(S[1], W[1], V * K_[1])); \
                S[2] = fmaf(pa, B_[2], fmaf(S[2], W[2], V * K_[2])); S[3] = fmaf(pa, B_[3], fmaf(S[3], W[3], V * K_[3])); \
                pbk = S[0] * R[0]; pbk = fmaf(S[1], R[1], pbk); pbk = fmaf(S[2], R[2], pbk); pbk = fmaf(S[3], R[3], pbk); }
            f32x4 aw, an, ab, ak, ar, bw, bn, bb_, bk, br; float av, bv, pbk = 0.f;
            RW_LOAD(aw, an, ab, ak, ar, av, 0);
#pragma unroll
            for (int s = 0; s < CH; s += 2) {
                RW_LOAD(bw, bn, bb_, bk, br, bv, s + 1);
                RW_STEP(aw, an, ab, ak, ar, av, s);
                if (s + 2 < CH) { RW_LOAD(aw, an, ab, ak, ar, av, s + 2); }
                RW_STEP(bw, bn, bb_, bk, br, bv, s + 1);
            }
            pbk = sum16(pbk); ykeep = (j == CH - 1) ? pbk : ykeep;
            WSP(u16, O_YRAW)[(tb0 + ch * CH + j) * 512 + h8 * 64 + row] = f2bf(ykeep);
            __builtin_amdgcn_sched_barrier(0);
            if (ch + 1 < SEQ / CH) swrite(cur ^ 1);
            __syncthreads();
        }
    }
    __builtin_amdgcn_s_setprio(0);
    if (INNER) { while (nbar < 2) { xcd_barrier(bar); ++nbar; } }
}
__device__ __forceinline__ void phase_rwkv_fin(const Params& p) {
    const int lane = otid() & 63, wv = blockIdx.x * 4 + (otid() >> 6), nw = gridDim.x * 4;
    const u16* U = WSP(u16, O_U1R); const float* mu = p.in[14];
    const int c = lane * 8;
    float lw[8], lbv[8], rk[8], ka[8], mr[8], mk[8], mv[8];
#pragma unroll
    for (int q = 0; q < 8; ++q) { lw[q] = p.in[23][c + q]; lbv[q] = p.in[24][c + q]; rk[q] = p.in[22][c + q]; ka[q] = p.in[21][c + q]; mr[q] = mu[c + q]; mk[q] = mu[512 + c + q]; mv[q] = mu[1024 + c + q]; }
    for (int t = wv; t < T; t += nw) {
        const bool first = (t & (SEQ - 1)) == 0;
        const u16* ur = U + (size_t)t * RW_IN + c;
        const u32x4 r_c = *(const u32x4*)ur, k_c = *(const u32x4*)(ur + 512), v_c = *(const u32x4*)(ur + 1024);
        u32x4 r_p = {0u, 0u, 0u, 0u}, k_p = r_p, v_p = r_p;
        if (!first) { r_p = *(const u32x4*)(ur - RW_IN); k_p = *(const u32x4*)(ur - RW_IN + 512); v_p = *(const u32x4*)(ur - RW_IN + 1024); }
        const u32x4 a_c = *(const u32x4*)(WSP(h16, O_AA16) + (size_t)t * 512 + c), g_c = *(const u32x4*)(WSP(h16, O_GG16) + (size_t)t * 512 + c);
        const u32x4 y_c = *(const u32x4*)(WSP(u16, O_YRAW) + (size_t)t * 512 + c);
        const h16* ah = (const h16*)&a_c; const h16* gh = (const h16*)&g_c;
        float y[8], vv[8]; float sm = 0.f, bon = 0.f;
#pragma unroll
        for (int q = 0; q < 4; ++q) {
            y[2 * q] = bflo(y_c[q]); y[2 * q + 1] = bfhi(y_c[q]); sm += y[2 * q] + y[2 * q + 1];
            float x0 = bflo(r_c[q]), x1 = bfhi(r_c[q]); const float r0 = x0 + (bflo(r_p[q]) - x0) * mr[2 * q], r1 = x1 + (bfhi(r_p[q]) - x1) * mr[2 * q + 1];
            x0 = bflo(k_c[q]); x1 = bfhi(k_c[q]); float k0 = x0 + (bflo(k_p[q]) - x0) * mk[2 * q], k1 = x1 + (bfhi(k_p[q]) - x1) * mk[2 * q + 1];
            k0 *= 1.f + ((float)ah[2 * q] - 1.f) * ka[2 * q]; k1 *= 1.f + ((float)ah[2 * q + 1] - 1.f) * ka[2 * q + 1];
            x0 = bflo(v_c[q]); x1 = bfhi(v_c[q]); vv[2 * q] = x0 + (bflo(v_p[q]) - x0) * mv[2 * q]; vv[2 * q + 1] = x1 + (bfhi(v_p[q]) - x1) * mv[2 * q + 1];
            bon += r0 * k0 * rk[2 * q] + r1 * k1 * rk[2 * q + 1];
        }
        sm += __shfl_xor(sm, 1); sm += __shfl_xor(sm, 2); sm += __shfl_xor(sm, 4);
        bon += __shfl_xor(bon, 1); bon += __shfl_xor(bon, 2); bon += __shfl_xor(bon, 4);
        const float mean = sm * (1.f / 64.f);
        float var = 0.f;
#pragma unroll
        for (int q = 0; q < 8; ++q) { const float dd = y[q] - mean; var += dd * dd; }
        var += __shfl_xor(var, 1); var += __shfl_xor(var, 2); var += __shfl_xor(var, 4);
        const float rs = rsqrtf(var * (1.f / 64.f) + 64e-5f);
        float o[8];
#pragma unroll
        for (int q = 0; q < 8; ++q) o[q] = ((y[q] - mean) * rs * lw[q] + lbv[q] + bon * vv[q]) * (float)gh[q];
        u32x4 w; w[0] = cvtpk(o[0], o[1]); w[1] = cvtpk(o[2], o[3]); w[2] = cvtpk(o[4], o[5]); w[3] = cvtpk(o[6], o[7]);
        *(u32x4*)(WSP(u16, O_HA) + (size_t)t * 1024 + c) = w;
    }
}

#ifndef REPEAT_MASK
#define REPEAT_MASK 0
#endif
#if MEGA
constexpr int NPHASE = 19;
#else
constexpr int NPHASE = 24;
#endif
template <int PH> __device__ __forceinline__ void run_phase(const Params& p, unsigned char* smem, const XcdBarrier& bar) {
    if constexpr (PH == 0) phase_prologue(p, smem);
    else if constexpr (PH == 1) phase_inproj0(p, smem);
    else if constexpr (PH == 2) phase_upproj(p, smem);
    else if constexpr (PH == 3) phase_attn(p, smem);
    else if constexpr (PH == 4) phase_outproj(p, smem, 0);
    else if constexpr (PH == 5) phase_route(p, smem, 0);
    else if constexpr (PH == 6) phase_moe1(p, smem, 0);
    else if constexpr (PH == 7) phase_moe2(p, smem, 0);
    else if constexpr (PH == 8) phase_combine(p, smem, 0);
    else if constexpr (PH == 9) phase_inproj1(p, smem);
    else if constexpr (PH == 10) phase_rwkv_prep(p);
    else if constexpr (PH == 11) phase_rwkv_lora(p, smem);
#if MEGA
    else if constexpr (PH == 12) phase_rwkv_rec<true>(p, smem, bar);
    else if constexpr (PH == 13) phase_rwkv_fin(p);
    else if constexpr (PH == 14) phase_outproj(p, smem, 1);
    else if constexpr (PH == 15) phase_route(p, smem, 1);
    else if constexpr (PH == 16) phase_moe1(p, smem, 1);
    else if constexpr (PH == 17) phase_moe2(p, smem, 1);
    else if constexpr (PH == 18) phase_combine(p, smem, 1);
#else
    else if constexpr (PH == 13) phase_hgrnA(p, smem);
    else if constexpr (PH == 14) phase_hgrnB(p, smem);
    else if constexpr (PH == 15) phase_hgrnC(p, smem);
    else if constexpr (PH == 16) phase_rwkv_rec<false>(p, smem, bar);
    else if constexpr (PH == 17) phase_rwkv_fin(p);
    else if constexpr (PH == 18) phase_outproj(p, smem, 1);
    else if constexpr (PH == 19) phase_route(p, smem, 1);
    else if constexpr (PH == 20) phase_lists(p, smem, 1);
    else if constexpr (PH == 21) phase_moe1(p, smem, 1);
    else if constexpr (PH == 22) phase_moe2(p, smem, 1);
    else if constexpr (PH == 23) phase_combine(p, 1);
#endif
}

template <int PH> __global__ void __launch_bounds__(256, 2) k_phase(Params p) {
    __shared__ __attribute__((aligned(16))) unsigned char smem[SMEM_BYTES];
    run_phase<PH>(p, smem);
}


#if MEGA
template <int PH> __device__ __forceinline__ void run_all(const Params& p, unsigned char* smem, const XcdBarrier& bar) {
    run_phase<PH>(p, smem, bar);
    if constexpr (((REPEAT_MASK >> PH) & 1) != 0) { xcd_barrier(bar); run_phase<PH>(p, smem, bar); }
    if constexpr (PH + 1 < NPHASE) { xcd_barrier(bar); run_all<PH + 1>(p, smem, bar); }
}
__global__ void __launch_bounds__(256, 2) k_mega(Params p) {
    __shared__ __attribute__((aligned(16))) unsigned char smem[SMEM_BYTES];
    __shared__ uint4 xb_words;
    if (threadIdx.x == 0) xb_words = make_uint4(0u, 0u, 0u, 0u);
    __syncthreads();
    XcdBarrier bar = xcd_barrier_post((unsigned*)p.ws, (volatile LAS unsigned*)&xb_words);
    run_all<0>(p, smem, bar);
}
#endif
template <int PH> static void launch_phase(const Params& p, hipStream_t stream) {
    hipLaunchKernelGGL((k_phase<PH>), dim3(512), dim3(256), 0, stream, p);
}
template <int... I> static void launch_all(const Params& p, hipStream_t stream, std::integer_sequence<int, I...>) { (launch_phase<I>(p, stream), ...); }

extern "C" void kernel_launch(void* const* d_in, const int* in_sizes, int n_in, void* d_out, int out_size, void* d_ws, size_t ws_size, hipStream_t stream) {
    Params p;
    memset(&p, 0, sizeof(p));
    for (int i = 0; i < 34; ++i) p.in[i] = (const float*)d_in[i];
    p.out = (float*)d_out; p.ws = (unsigned char*)d_ws;
    if (ws_size < WS_TOTAL) { fprintf(stderr, "workspace too small: %zu < %zu\n", ws_size, (size_t)WS_TOTAL); return; }
    (void)hipMemsetAsync(d_ws, 0, CTRL_BYTES, stream);
#if MEGA
    static int grid = 0, solo = 0;
    if (!grid) {
        int dev = 0, cus = 0, per_cu = 0;
        (void)hipGetDevice(&dev);
        (void)hipDeviceGetAttribute(&cus, hipDeviceAttributeMultiprocessorCount, dev);
        (void)hipOccupancyMaxActiveBlocksPerMultiprocessor(&per_cu, k_mega, 256, 0);
        if (per_cu > 2) per_cu = 2;
        if (per_cu < 1) per_cu = 1;
        grid = cus * per_cu;
        if (grid > 512) grid = 512;
        solo = per_cu < 2;
    }
    p.solo = solo;
    hipLaunchKernelGGL(k_mega, dim3(grid), dim3(256), 0, stream, p);
#else
    launch_all(p, stream, std::make_integer_sequence<int, NPHASE>{});
#endif
}
```
